# Optimizing an MI355X kernel written in HIP

```python
import jax, jax.numpy as jnp
from jax import lax
import numpy as np

D_MODEL = 4096
BATCH = 2
SEQ = 4096
DEPTH = 4

D_BRANCH = D_MODEL // 4
D_MIX = 4 * D_BRANCH
NORM_EPS = 1e-6

RET_HEADS = 4
RET_HEAD_DIM = D_BRANCH // RET_HEADS
RET_CHUNK = 256

MOBA_HEADS = 8
MOBA_HEAD_DIM = D_BRANCH // MOBA_HEADS
MOBA_BLOCK = 256
MOBA_TOPK = 3
MOBA_Q_BLOCK = 32

SSM_HEAD_DIM = 64
SSM_HEADS = D_BRANCH // SSM_HEAD_DIM
SSM_GROUPS = 4
SSM_HPG = SSM_HEADS // SSM_GROUPS
SSM_STATE = 128
SSM_CONV = 4
SSM_CHUNK = 256
SSM_CONV_DIM = D_BRANCH + 2 * SSM_GROUPS * SSM_STATE

LRU_BLOCKS = 8
LRU_BLOCK_DIM = D_BRANCH // LRU_BLOCKS
LRU_CONV = 4
LRU_C = 8.0

IN_SIZES = (D_BRANCH, D_BRANCH, D_BRANCH, D_BRANCH,
            D_BRANCH, D_BRANCH, D_BRANCH, D_BRANCH,
            D_BRANCH, SSM_CONV_DIM, SSM_HEADS,
            D_BRANCH, D_BRANCH)
D_IN = 8 * D_BRANCH + D_BRANCH + SSM_CONV_DIM + SSM_HEADS + 2 * D_BRANCH

kernel_name = 'hymba_style_retention_moba_ssd_rglru_trunk'


def rms_norm(x, g):
    xf = x.astype(jnp.float32)
    y = xf * lax.rsqrt(jnp.mean(xf * xf, axis=-1, keepdims=True) + NORM_EPS)
    return (y * g.astype(jnp.float32)).astype(x.dtype)


def pad_seq(t, mult):
    pad = (-t.shape[1]) % mult
    return jnp.pad(t, [(0, 0), (0, pad)] + [(0, 0)] * (t.ndim - 2))


def causal_depthwise_conv(x, w, b):
    width = w.shape[0]
    s = x.shape[1]
    xp = jnp.pad(x, ((0, 0), (width - 1, 0), (0, 0)))
    y = b
    for k in range(width):
        y = y + xp[:, k:k + s] * w[k]
    return y


def retention(q, k, v, gn_w):
    b_, s, _ = q.shape
    H, dh, C = RET_HEADS, RET_HEAD_DIM, RET_CHUNK
    q, k, v = (pad_seq(t.astype(jnp.float32), C) for t in (q, k, v))
    sp = q.shape[1]
    n = sp // C

    def heads(t):
        return t.reshape(b_, n, C, H, dh).transpose(1, 0, 3, 2, 4)

    q, k, v = heads(q), heads(k) * (dh ** -0.5), heads(v)
    log_g = jnp.log1p(-jnp.exp2(-5.0 - jnp.arange(H, dtype=jnp.float32)))
    idx = jnp.arange(C, dtype=jnp.float32)
    diff = idx[:, None] - idx[None, :]
    causal = diff >= 0
    dmat = jnp.where(causal, jnp.exp(log_g[:, None, None] * jnp.where(causal, diff, 0.0)), 0.0)
    q_decay = jnp.exp(log_g[:, None] * (idx + 1.0))[None, :, :, None]
    k_decay = jnp.exp(log_g[:, None] * (C - 1.0 - idx))[None, :, :, None]
    chunk_decay = jnp.exp(log_g * C)[None, :, None, None]

    def step(state, qkv):
        qc, kc, vc = qkv
        inner = jnp.einsum('bhid,bhjd->bhij', qc, kc) * dmat
        y = jnp.einsum('bhij,bhjv->bhiv', inner, vc)
        y = y + jnp.einsum('bhid,bhdv->bhiv', qc, state) * q_decay
        state = chunk_decay * state + jnp.einsum('bhjd,bhjv->bhdv', kc * k_decay, vc)
        return state, y

    state0 = jnp.zeros((b_, H, dh, dh), jnp.float32)
    _, y = lax.scan(step, state0, (q, k, v))
    y = y.transpose(1, 0, 3, 2, 4).reshape(b_, sp, H, dh)[:, :s]
    y = rms_norm(y, gn_w)
    return y.reshape(b_, s, H * dh)


def moba_attention(q, k, v):
    b_, s, _ = q.shape
    H, dh, L, QB = MOBA_HEADS, MOBA_HEAD_DIM, MOBA_BLOCK, MOBA_Q_BLOCK
    scale = dh ** -0.5
    slopes = jnp.exp2(-8.0 * (jnp.arange(H, dtype=jnp.float32) + 1.0) / H)
    qh = q.astype(jnp.float32).reshape(b_, s, H, dh).transpose(0, 2, 1, 3)
    kh = pad_seq(k.astype(jnp.float32), L).reshape(b_, -1, H, dh).transpose(0, 2, 1, 3)
    vh = pad_seq(v.astype(jnp.float32), L).reshape(b_, -1, H, dh).transpose(0, 2, 1, 3)
    nb = kh.shape[2] // L
    ks = min(MOBA_TOPK, nb)
    kb = kh.reshape(b_, H, nb, L, dh)
    vb = vh.reshape(b_, H, nb, L, dh)

    k_mean = kb.mean(axis=3)
    gate = jnp.einsum('bhsd,bhnd->bhsn', qh, k_mean)
    q_blk = jnp.arange(s) // L
    past = jnp.arange(nb)[None, :] < q_blk[:, None]
    gate = jnp.where(past, gate, -jnp.inf)
    _, sel = lax.top_k(gate, ks)
    sel_valid = sel < q_blk[:, None]

    nq = s // QB
    qc = qh.reshape(b_, H, nq, QB, dh).transpose(2, 0, 1, 3, 4)
    selc = sel.reshape(b_, H, nq, QB, ks).transpose(2, 0, 1, 3, 4)
    validc = sel_valid.reshape(b_, H, nq, QB, ks).transpose(2, 0, 1, 3, 4)
    gather_blocks = jax.vmap(jax.vmap(lambda blocks, ids: blocks[ids]))
    offs = jnp.arange(L)

    def one_chunk(args):
        ci, qi, si, vi = args
        qpos = ci * QB + jnp.arange(QB)
        own = (ci * QB) // L
        ksel = gather_blocks(kb, si)
        vsel = gather_blocks(vb, si)
        kpos_sel = si[..., None] * L + offs
        dist_sel = (qpos[:, None, None] - kpos_sel).astype(jnp.float32)
        s_sel = jnp.einsum('bhqd,bhqkld->bhqkl', qi, ksel) * scale - slopes[:, None, None, None] * dist_sel
        s_sel = jnp.where(vi[..., None], s_sel, -jnp.inf)
        kown = lax.dynamic_slice_in_dim(kb, own, 1, axis=2)[:, :, 0]
        vown = lax.dynamic_slice_in_dim(vb, own, 1, axis=2)[:, :, 0]
        kpos_own = own * L + offs
        dist_own = (qpos[:, None] - kpos_own[None, :]).astype(jnp.float32)
        s_own = jnp.einsum('bhqd,bhld->bhql', qi, kown) * scale - slopes[:, None, None] * dist_own
        s_own = jnp.where(kpos_own[None, :] <= qpos[:, None], s_own, -jnp.inf)
        scores = jnp.concatenate([s_sel.reshape(b_, H, QB, ks * L), s_own], axis=-1)
        p = jax.nn.softmax(scores, axis=-1)
        p_sel = p[..., :ks * L].reshape(b_, H, QB, ks, L)
        out = jnp.einsum('bhqkl,bhqkld->bhqd', p_sel, vsel)
        out = out + jnp.einsum('bhql,bhld->bhqd', p[..., ks * L:], vown)
        return out

    o = lax.map(one_chunk, (jnp.arange(nq), qc, selc, validc))
    return o.transpose(1, 0, 3, 2, 4).reshape(b_, s, H * dh)


def mamba2_ssd(z, xbc, dt_raw, conv_w, conv_b, dt_bias, a_log, d_skip, norm_w):
    b_, s, _ = z.shape
    G, R, P, N, Q = SSM_GROUPS, SSM_HPG, SSM_HEAD_DIM, SSM_STATE, SSM_CHUNK
    xbc = jax.nn.silu(causal_depthwise_conv(xbc, conv_w, conv_b)).astype(jnp.float32)
    xs, bm, cm = jnp.split(xbc, [D_BRANCH, D_BRANCH + G * N], axis=-1)
    dt = jax.nn.softplus(dt_raw.astype(jnp.float32) + dt_bias.astype(jnp.float32))
    a = -jnp.exp(a_log.astype(jnp.float32)).reshape(G, R)
    xs = pad_seq(xs.reshape(b_, s, G, R, P), Q)
    bm = pad_seq(bm.reshape(b_, s, G, N), Q)
    cm = pad_seq(cm.reshape(b_, s, G, N), Q)
    dt = pad_seq(dt.reshape(b_, s, G, R), Q)
    sp = xs.shape[1]
    c = sp // Q
    xs = xs.reshape(b_, c, Q, G, R, P)
    bm = bm.reshape(b_, c, Q, G, N)
    cm = cm.reshape(b_, c, Q, G, N)
    dt = dt.reshape(b_, c, Q, G, R)
    da_cs = jnp.cumsum(dt * a, axis=2)

    tri = (jnp.arange(Q)[:, None] >= jnp.arange(Q)[None, :])[None, None, :, :, None, None]
    seg = da_cs[:, :, :, None] - da_cs[:, :, None]
    lmat = jnp.exp(jnp.where(tri, seg, -jnp.inf))
    cb = jnp.einsum('bcign,bcjgn->bcijg', cm, bm)
    wmat = cb[..., None] * lmat * dt[:, :, None]
    y_diag = jnp.einsum('bcijgr,bcjgrp->bcigrp', wmat, xs)

    decay_states = jnp.exp(da_cs[:, :, -1:] - da_cs)
    x_w = xs * (decay_states * dt)[..., None]
    states = jnp.einsum('bclgn,bclgrp->bcgrpn', bm, x_w)
    chunk_decay = jnp.exp(da_cs[:, :, -1])

    def step(h, inp):
        st, dec = inp
        return h * dec[..., None, None] + st, h

    h0 = jnp.zeros((b_, G, R, P, N), jnp.float32)
    _, h_prev = lax.scan(step, h0, (states.swapaxes(0, 1), chunk_decay.swapaxes(0, 1)))
    h_prev = h_prev.swapaxes(0, 1)
    y_off = jnp.einsum('bclgn,bcgrpn->bclgrp', cm, h_prev) * jnp.exp(da_cs)[..., None]
    y = y_diag + y_off + d_skip.astype(jnp.float32).reshape(G, R)[..., None] * xs
    y = y.reshape(b_, sp, D_BRANCH)[:, :s]
    y = y * jax.nn.silu(z.astype(jnp.float32))
    y = rms_norm(y.reshape(b_, s, G, D_BRANCH // G), norm_w.reshape(G, D_BRANCH // G))
    return y.reshape(b_, s, D_BRANCH)


def rg_lru(x, conv_w, conv_b, w_a, b_a, w_x, b_x, lam):
    b_, s, _ = x.shape
    xc = causal_depthwise_conv(x, conv_w, conv_b).astype(jnp.float32)
    xb = xc.reshape(b_, s, LRU_BLOCKS, LRU_BLOCK_DIM)
    r = jax.nn.sigmoid(jnp.einsum('bsnd,nde->bsne', xb, w_a.astype(jnp.float32)).reshape(b_, s, D_BRANCH) + b_a)
    i = jax.nn.sigmoid(jnp.einsum('bsnd,nde->bsne', xb, w_x.astype(jnp.float32)).reshape(b_, s, D_BRANCH) + b_x)
    log_a = -LRU_C * r * jax.nn.softplus(-lam.astype(jnp.float32))
    a = jnp.exp(log_a)
    u = jnp.sqrt(-jnp.expm1(2.0 * log_a)) * (i * xc)

    def combine(left, right):
        a1, b1 = left
        a2, b2 = right
        return a1 * a2, a2 * b1 + b2

    _, h = lax.associative_scan(combine, (a, u), axis=1)
    return h


def hybrid_layer(x, norm_w, w_in, ret_gn_w, ssm_conv_w, ssm_conv_b, ssm_dt_bias, ssm_a_log, ssm_d,
                 ssm_norm_w, lru_conv_w, lru_conv_b, lru_w_a, lru_b_a, lru_w_x, lru_b_x, lru_lambda, w_out):
    h = rms_norm(x, norm_w)
    proj = jnp.einsum('bsd,de->bse', h, w_in)
    (rq, rk, rv, rg, mq, mk, mv, mg, sz, sxbc, sdt, lx, lg) = jnp.split(
        proj, np.cumsum(IN_SIZES)[:-1].tolist(), axis=-1)
    dt_ = h.dtype
    y_ret = (retention(rq, rk, rv, ret_gn_w) * jax.nn.silu(rg.astype(jnp.float32))).astype(dt_)
    y_moba = (moba_attention(mq, mk, mv) * jax.nn.silu(mg.astype(jnp.float32))).astype(dt_)
    y_ssm = mamba2_ssd(sz, sxbc, sdt, ssm_conv_w, ssm_conv_b, ssm_dt_bias, ssm_a_log, ssm_d,
                       ssm_norm_w).astype(dt_)
    y_lru = (rg_lru(lx, lru_conv_w, lru_conv_b, lru_w_a, lru_b_a, lru_w_x, lru_b_x, lru_lambda)
             * jax.nn.silu(lg.astype(jnp.float32))).astype(dt_)
    y = jnp.concatenate([y_ret, y_moba, y_ssm, y_lru], axis=-1)
    return x + jnp.einsum('bse,ed->bsd', y, w_out)


def setup_inputs(seed: int = 0) -> dict:
    key = jax.random.key(seed)
    ks = jax.random.split(key, 24)
    f32 = jnp.float32
    nrm = lambda k, shape, sc: jax.random.normal(k, shape, f32) * sc
    x = nrm(ks[0], (BATCH, SEQ, D_MODEL), 1.0)
    norm_w = 1.0 + nrm(ks[1], (DEPTH, D_MODEL), 0.02)
    w_in = nrm(ks[2], (DEPTH, D_MODEL, D_IN), D_MODEL ** -0.5)
    ret_gn_w = 1.0 + nrm(ks[3], (DEPTH, RET_HEADS, RET_HEAD_DIM), 0.02)
    ssm_conv_w = nrm(ks[4], (DEPTH, SSM_CONV, SSM_CONV_DIM), SSM_CONV ** -0.5)
    ssm_conv_b = nrm(ks[5], (DEPTH, SSM_CONV_DIM), 0.02)
    dt0 = jnp.exp(jax.random.uniform(ks[6], (DEPTH, SSM_HEADS), f32, np.log(1e-3), np.log(1e-1)))
    ssm_dt_bias = dt0 + jnp.log(-jnp.expm1(-dt0))
    ssm_a_log = jnp.log(jax.random.uniform(ks[7], (DEPTH, SSM_HEADS), f32, 1.0, 16.0))
    ssm_d = 1.0 + nrm(ks[8], (DEPTH, SSM_HEADS), 0.1)
    ssm_norm_w = 1.0 + nrm(ks[9], (DEPTH, D_BRANCH), 0.02)
    lru_conv_w = nrm(ks[10], (DEPTH, LRU_CONV, D_BRANCH), LRU_CONV ** -0.5)
    lru_conv_b = nrm(ks[11], (DEPTH, D_BRANCH), 0.02)
    lru_w_a = nrm(ks[12], (DEPTH, LRU_BLOCKS, LRU_BLOCK_DIM, LRU_BLOCK_DIM), LRU_BLOCK_DIM ** -0.5)
    lru_b_a = nrm(ks[13], (DEPTH, D_BRANCH), 0.02)
    lru_w_x = nrm(ks[14], (DEPTH, LRU_BLOCKS, LRU_BLOCK_DIM, LRU_BLOCK_DIM), LRU_BLOCK_DIM ** -0.5)
    lru_b_x = nrm(ks[15], (DEPTH, D_BRANCH), 0.02)
    a_c = jax.random.uniform(ks[16], (DEPTH, D_BRANCH), f32, 0.9, 0.999)
    a_base = a_c ** (1.0 / LRU_C)
    lru_lambda = jnp.log(a_base) - jnp.log1p(-a_base)
    w_out = nrm(ks[17], (DEPTH, D_MIX, D_MODEL), D_MIX ** -0.5)
    final_norm_w = 1.0 + nrm(ks[18], (D_MODEL,), 0.02)
    return {'x': x, 'norm_w': norm_w, 'w_in': w_in, 'ret_gn_w': ret_gn_w,
            'ssm_conv_w': ssm_conv_w, 'ssm_conv_b': ssm_conv_b, 'ssm_dt_bias': ssm_dt_bias,
            'ssm_a_log': ssm_a_log, 'ssm_d': ssm_d, 'ssm_norm_w': ssm_norm_w,
            'lru_conv_w': lru_conv_w, 'lru_conv_b': lru_conv_b, 'lru_w_a': lru_w_a, 'lru_b_a': lru_b_a,
            'lru_w_x': lru_w_x, 'lru_b_x': lru_b_x, 'lru_lambda': lru_lambda,
            'w_out': w_out, 'final_norm_w': final_norm_w}


def reference(x, norm_w, w_in, ret_gn_w, ssm_conv_w, ssm_conv_b, ssm_dt_bias, ssm_a_log, ssm_d,
              ssm_norm_w, lru_conv_w, lru_conv_b, lru_w_a, lru_b_a, lru_w_x, lru_b_x, lru_lambda,
              w_out, final_norm_w):
    for l in range(DEPTH):
        x = hybrid_layer(x, norm_w[l], w_in[l], ret_gn_w[l], ssm_conv_w[l], ssm_conv_b[l],
                         ssm_dt_bias[l], ssm_a_log[l], ssm_d[l], ssm_norm_w[l], lru_conv_w[l],
                         lru_conv_b[l], lru_w_a[l], lru_b_a[l], lru_w_x[l], lru_b_x[l],
                         lru_lambda[l], w_out[l])
    return rms_norm(x, final_norm_w)
```

```cpp
#include <hip/hip_runtime.h>
#include <cstdio>
#include <cstdint>
#include <cmath>
namespace pg8 {
#define PG8_LAS __attribute__((address_space(3)))
typedef unsigned short bf16_t;
typedef short bf16x8 __attribute__((ext_vector_type(8)));
typedef float f32x4 __attribute__((ext_vector_type(4)));
typedef unsigned u32x4 __attribute__((ext_vector_type(4)));
constexpr int BM = 256, BK = 64, HALF = 128, HTB = HALF * BK * 2  , STAGE_BYTES = 8 * HTB, NXCD = 8, WGM = 8;

__host__ __device__ __forceinline__ int lds_byte(int r, int c) { const int st = (r >> 4) * 2 + (c >> 5), rr = r & 15, cc = c & 31, ob = rr * 64 + cc * 2; return st * 1024 + (ob ^ (((ob >> 9) & 1) << 5)); }
__host__ __device__ __forceinline__ void stage_rc(int b, int& R, int& C) { const int st = b / 1024, sb = b % 1024, swz = sb ^ (((sb >> 9) & 1) << 5); R = (st >> 1) * 16 + swz / 64; C = (st & 1) * 32 + (swz % 64) / 2; }
__host__ __device__ __forceinline__ int perm32(int rho) { const int n = rho >> 4, i = rho & 15; return 8 * (i >> 2) + 4 * n + (i & 3); }

struct Unit { int pm, pn; };
struct Gemm { const bf16_t* A; const bf16_t* Bt; int M, N, K; };

struct StaticOrder {
    int nM, nN, nwg, G, c;
    __host__ __device__ void init(int M, int N, int G_, int c_) { nM = M / BM; nN = N / BM; nwg = nM * nN; G = G_; c = c_; }
    __host__ __device__ bool next(int i, Unit& u) const {
        const long L = (long)i * G + c; if (L >= nwg) return false;
        int wgid = (int)L; { const int q = nwg / NXCD, r = nwg % NXCD, xcd = wgid % NXCD, off = wgid / NXCD; wgid = (xcd < r ? xcd * (q + 1) : r * (q + 1) + (xcd - r) * q) + off; }
        const int nig = WGM * nN, gid = wgid / nig, fm = gid * WGM, gsz = (nM - fm) < WGM ? (nM - fm) : WGM;
        u.pm = fm + ((wgid % nig) % gsz); u.pn = (wgid % nig) / gsz; return true;
    }
    __device__ __forceinline__ void a_ready(const Unit&) const {}
    __device__ __forceinline__ void done(const Unit&) const {}
};

__device__ __forceinline__ unsigned cvt_pk_bf16(float lo, float hi) { unsigned r; asm volatile("v_cvt_pk_bf16_f32 %0, %1, %2" : "=v"(r) : "v"(lo), "v"(hi)); return r; }
typedef float f32x2 __attribute__((ext_vector_type(2)));
template <class Epi, class Sched, bool ALIGN_EPI = false, bool SP2 = false>
__device__ __forceinline__ void gemm_phase(PG8_LAS unsigned char* lds, const Gemm g, const Sched& S, const Epi& E) {
    int tid_l = threadIdx.x; asm volatile("" : "+v"(tid_l));
    const int tid = tid_l, wid = __builtin_amdgcn_readfirstlane(tid >> 6), lane = tid & 63, wr = wid >> 2, wc = wid & 3, fr = lane & 15, fq = lane >> 4;
    const int K = g.K, nt = K / BK;
    unsigned voffA[2], voffB[2];
#pragma unroll
    for (int i = 0; i < 2; ++i) { int R, C; stage_rc(tid * 16 + i * 8192, R, C); const int Rb = Epi::PERM ? ((R & ~31) + perm32(R & 31)) : R;
        voffA[i] = (unsigned)(R * K + C) * 2u; voffB[i] = (unsigned)(Rb * K + C) * 2u; }
    const size_t kstep = (size_t)(BK * 2);
    const size_t hstep = (size_t)HALF * K * 2;
    const size_t tstep = 2 * hstep;
    const unsigned ldsw = (unsigned)wid * 1024u;
    const int aoff = lds_byte(wr * 64 + fr, fq * 8), boff = lds_byte(wc * 32 + fr, fq * 8);
#define PG8_SA(b, h) (((b) * 2 + (h)) * HTB)
#define PG8_SB(b, h) ((4 + (b) * 2 + (h)) * HTB)
#define PG8_STAGE(bufoff, gbase, voff) do { _Pragma("unroll") for (int _i = 0; _i < 2; ++_i) \
        __builtin_amdgcn_global_load_lds((const unsigned*)((const char*)(gbase) + (voff)[_i]), (PG8_LAS unsigned*)(lds + (bufoff) + ldsw + _i * 8192), 16, 0, 0); } while (0)
#define PG8_LDA(dst, b, h) do { _Pragma("unroll") for (int m = 0; m < 4; ++m) _Pragma("unroll") for (int k = 0; k < 2; ++k) dst[m][k] = *(const PG8_LAS bf16x8*)(lds + PG8_SA(b, h) + aoff + m * 2048 + k * 1024); } while (0)
#define PG8_LDB(dst, b, h) do { _Pragma("unroll") for (int n = 0; n < 2; ++n) _Pragma("unroll") for (int k = 0; k < 2; ++k) dst[n][k] = *(const PG8_LAS bf16x8*)(lds + PG8_SB(b, h) + boff + n * 2048 + k * 1024); } while (0)
#define PG8_MMA(ai, bj, At, Bt) do { __builtin_amdgcn_s_setprio(1); _Pragma("unroll") for (int m = 0; m < 4; ++m) _Pragma("unroll") for (int n = 0; n < 2; ++n) _Pragma("unroll") for (int k = 0; k < 2; ++k) \
        acc[ai][bj][m][n] = __builtin_amdgcn_mfma_f32_16x16x32_bf16(Bt[n][k], At[m][k], acc[ai][bj][m][n], 0, 0, 0); __builtin_amdgcn_s_setprio(0); } while (0)
#define PG8_WAIT_V(n) asm volatile("s_waitcnt vmcnt(" #n ")" ::: "memory")
#define PG8_WAIT_L(n) asm volatile("s_waitcnt lgkmcnt(" #n ")" ::: "memory")
#define PG8_BAR __builtin_amdgcn_s_barrier()
#define PG8_SCHED __builtin_amdgcn_sched_barrier(0)
    Unit cur, nxt; int ui = 0;
    if (!S.next(0, cur)) return;
    f32x4 acc[2][2][4][2];
#pragma unroll
    for (int a = 0; a < 2; ++a)
#pragma unroll
        for (int b = 0; b < 2; ++b)
#pragma unroll
            for (int m = 0; m < 4; ++m)
#pragma unroll
                for (int n = 0; n < 2; ++n) acc[a][b][m][n] = (f32x4){0.f, 0.f, 0.f, 0.f};
    bf16x8 At[4][2], B0[2][2], B1[2][2];
    const char* cA = (const char*)g.A + (size_t)cur.pm * tstep; const char* cB = (const char*)g.Bt + (size_t)cur.pn * tstep;
    S.a_ready(cur);
    if constexpr (SP2) {
        PG8_STAGE(PG8_SB(0, 0), cB, voffB); PG8_STAGE(PG8_SB(0, 1), cB + hstep, voffB); PG8_STAGE(PG8_SA(0, 0), cA, voffA); PG8_STAGE(PG8_SA(0, 1), cA + hstep, voffA);
        if (wr == 1) PG8_BAR;
        PG8_WAIT_V(2); PG8_BAR;
        PG8_STAGE(PG8_SB(1, 0), cB + kstep, voffB); PG8_STAGE(PG8_SA(1, 0), cA + kstep, voffA); PG8_STAGE(PG8_SB(1, 1), cB + hstep + kstep, voffB);
        PG8_WAIT_V(6); PG8_BAR;
    } else {
        PG8_STAGE(PG8_SB(0, 0), cB, voffB); PG8_STAGE(PG8_SA(0, 0), cA, voffA); PG8_STAGE(PG8_SB(0, 1), cB + hstep, voffB); PG8_STAGE(PG8_SA(0, 1), cA + hstep, voffA);
        if (wr == 1) PG8_BAR;
        PG8_WAIT_V(4); PG8_BAR;
        PG8_STAGE(PG8_SB(1, 0), cB + kstep, voffB); PG8_STAGE(PG8_SA(1, 0), cA + kstep, voffA); PG8_STAGE(PG8_SB(1, 1), cB + hstep + kstep, voffB);
        PG8_WAIT_V(6); PG8_BAR;
    }
    for (;;) {
        const bool has_next = S.next(ui + 1, nxt);
        const char* nA = has_next ? (const char*)g.A + (size_t)nxt.pm * tstep : cA; const char* nB = has_next ? (const char*)g.Bt + (size_t)nxt.pn * tstep : cB;
        for (int t = 0; t < nt; t += 2) {
            const bool last = (t == nt - 2);
            const char* a1 = cA + (size_t)(t + 1) * kstep;
            const char* a2 = last ? nA : cA + (size_t)(t + 2) * kstep; const char* b2 = last ? nB : cB + (size_t)(t + 2) * kstep;
            const char* a3 = a2 + kstep; const char* b3 = b2 + kstep;
            if (last && has_next) S.a_ready(nxt);
            if constexpr (SP2) {
            PG8_LDB(B0, 0, 0); PG8_LDB(B1, 0, 1); PG8_SCHED; PG8_LDA(At, 0, 0); PG8_STAGE(PG8_SA(1, 1), a1 + hstep, voffA);
            PG8_WAIT_V(8); PG8_WAIT_L(0); PG8_BAR; PG8_MMA(0, 0, At, B0); PG8_MMA(0, 1, At, B1); PG8_BAR; PG8_SCHED;
            PG8_LDA(At, 0, 1); PG8_STAGE(PG8_SB(0, 0), b2, voffB); PG8_STAGE(PG8_SB(0, 1), b2 + hstep, voffB); PG8_STAGE(PG8_SA(0, 0), a2, voffA);
            PG8_WAIT_V(8); PG8_WAIT_L(0); PG8_BAR; PG8_MMA(1, 0, At, B0); PG8_MMA(1, 1, At, B1); PG8_BAR; PG8_SCHED;
            PG8_LDB(B0, 1, 0); PG8_LDB(B1, 1, 1); PG8_SCHED; PG8_LDA(At, 1, 0); PG8_STAGE(PG8_SA(0, 1), a2 + hstep, voffA);
            PG8_WAIT_V(8); PG8_WAIT_L(0); PG8_BAR; PG8_MMA(0, 0, At, B0); PG8_MMA(0, 1, At, B1); PG8_BAR; PG8_SCHED;
            PG8_LDA(At, 1, 1); PG8_STAGE(PG8_SB(1, 0), b3, voffB); PG8_STAGE(PG8_SB(1, 1), b3 + hstep, voffB); PG8_STAGE(PG8_SA(1, 0), a3, voffA);
            PG8_WAIT_V(8); PG8_WAIT_L(0); PG8_BAR; PG8_MMA(1, 0, At, B0); PG8_MMA(1, 1, At, B1); PG8_BAR; PG8_SCHED;
            } else {
            PG8_LDB(B0, 0, 0); PG8_SCHED; PG8_LDA(At, 0, 0); PG8_STAGE(PG8_SA(1, 1), a1 + hstep, voffA);
            PG8_WAIT_L(8); PG8_BAR; PG8_WAIT_L(0); PG8_MMA(0, 0, At, B0); PG8_BAR; PG8_SCHED;
            PG8_LDB(B1, 0, 1); PG8_STAGE(PG8_SB(0, 0), b2, voffB);
            PG8_BAR; PG8_WAIT_L(0); PG8_MMA(0, 1, At, B1); PG8_BAR;
            PG8_LDA(At, 0, 1); PG8_STAGE(PG8_SA(0, 0), a2, voffA);
            PG8_BAR; PG8_WAIT_L(0); PG8_MMA(1, 0, At, B0); PG8_BAR; PG8_SCHED;
            PG8_STAGE(PG8_SB(0, 1), b2 + hstep, voffB);
            PG8_WAIT_V(6); PG8_BAR; PG8_MMA(1, 1, At, B1); PG8_BAR;
            PG8_LDB(B0, 1, 0); PG8_SCHED; PG8_LDA(At, 1, 0); PG8_STAGE(PG8_SA(0, 1), a2 + hstep, voffA);
            PG8_WAIT_L(8); PG8_BAR; PG8_WAIT_L(0); PG8_MMA(0, 0, At, B0); PG8_BAR; PG8_SCHED;
            PG8_LDB(B1, 1, 1); PG8_STAGE(PG8_SB(1, 0), b3, voffB);
            PG8_BAR; PG8_WAIT_L(0); PG8_MMA(0, 1, At, B1); PG8_BAR;
            PG8_LDA(At, 1, 1); PG8_STAGE(PG8_SA(1, 0), a3, voffA);
            PG8_BAR; PG8_WAIT_L(0); PG8_MMA(1, 0, At, B0); PG8_BAR; PG8_SCHED;
            PG8_STAGE(PG8_SB(1, 1), b3 + hstep, voffB);
            PG8_WAIT_V(6); PG8_BAR; PG8_MMA(1, 1, At, B1); PG8_BAR;
            }
        }
        if constexpr (ALIGN_EPI) { if (wr == 0) PG8_BAR; }
        if constexpr (!Epi::AFTER_DRAIN) { E(acc, cur, wr, wc, fr, fq); S.done(cur); }
        if (!has_next) break;
#pragma unroll
        for (int a = 0; a < 2; ++a)
#pragma unroll
            for (int b = 0; b < 2; ++b)
#pragma unroll
                for (int m = 0; m < 4; ++m)
#pragma unroll
                    for (int n = 0; n < 2; ++n) acc[a][b][m][n] = (f32x4){0.f, 0.f, 0.f, 0.f};
        cur = nxt; cA = nA; cB = nB; ++ui;
        if constexpr (ALIGN_EPI) { if (wr == 1) PG8_BAR; }
    }
    PG8_WAIT_V(0);
    if constexpr (!ALIGN_EPI) { if (wr == 0) PG8_BAR; }
    PG8_BAR;
    if constexpr (Epi::AFTER_DRAIN) { E.fused(acc, cur, wr, wc, fr, fq, lds, wid, lane); S.done(cur); }
#undef PG8_SA
#undef PG8_SB
#undef PG8_STAGE
#undef PG8_LDA
#undef PG8_LDB
#undef PG8_MMA
#undef PG8_WAIT_V
#undef PG8_WAIT_L
#undef PG8_BAR
#undef PG8_SCHED
}
}

#define GAS __attribute__((address_space(1)))
#define LAS __attribute__((address_space(3)))
#define DI __device__ __forceinline__
typedef unsigned short bf16;
typedef unsigned v4u __attribute__((ext_vector_type(4)));
typedef unsigned v2u __attribute__((ext_vector_type(2)));
typedef float f32x4 __attribute__((ext_vector_type(4)));
typedef short bf16x8 __attribute__((ext_vector_type(8)));
typedef short s16x4 __attribute__((ext_vector_type(4)));
typedef GAS unsigned gu32;
typedef GAS unsigned long long gu64;
#define RLX_AGENT __ATOMIC_RELAXED, __HIP_MEMORY_SCOPE_AGENT
#define LDS_WAIT() asm volatile("s_waitcnt lgkmcnt(0)" ::: "memory")
#define VM_WAIT() asm volatile("s_waitcnt vmcnt(0)" ::: "memory")
DI unsigned f2bf(float f) { unsigned u = __builtin_bit_cast(unsigned, f); return (u + 0x7fffu + ((u >> 16) & 1u)) >> 16; }
__device__ __forceinline__ unsigned pk2(float lo, float hi) { return f2bf(lo) | (f2bf(hi) << 16); }

#define XB_TMO      128
#define XB_XCNT(j)  (256  + 64 * (j))
#define XB_XSUB(j)  (1280 + 64 * (j))
#define XB_XGEN(j)  (2304 + 64 * (j))
#define XB_TOP      3328
#define XB_TOPGEN   3392
#define XCD_BAR_WORDS 3456
#define XB_SPIN_CAP (1u << 18)

__device__ __forceinline__ unsigned xb_ld(unsigned* p)              { return __hip_atomic_load(p, __ATOMIC_RELAXED, __HIP_MEMORY_SCOPE_AGENT); }
__device__ __forceinline__ unsigned xb_add(unsigned* p, unsigned v) { return __hip_atomic_fetch_add(p, v, __ATOMIC_RELAXED, __HIP_MEMORY_SCOPE_AGENT); }
__device__ __forceinline__ unsigned xb_xcc_id() { return (unsigned)__builtin_amdgcn_s_getreg((3 << 11) | 20) & 0xFu; }
#define XB_SPIN(cond, bar) do { unsigned _sp = 0; while (cond) { __builtin_amdgcn_s_sleep(1); \
    if ((++_sp & 255u) == 0u) { if (xb_ld(&(bar)[XB_TMO])) break; if (_sp > XB_SPIN_CAP) { atomicAdd(&(bar)[XB_TMO], 1u); break; } } } } while (0)

struct XcdBarrier {
    unsigned* bar; unsigned x;
    volatile LAS unsigned* st;
};

__device__ __forceinline__ XcdBarrier xcd_barrier_post(unsigned* bar, volatile LAS unsigned* st) {
    XcdBarrier b; b.bar = bar; b.x = xb_xcc_id(); b.st = st;
    if (threadIdx.x == 0) (void)xb_add(&bar[XB_XCNT(b.x)], 1u);
    return b;
}
__device__ __forceinline__ void xcd_barrier_complete(unsigned* bar, unsigned x, unsigned& nloc, unsigned& nx) {
    const unsigned G = gridDim.x * gridDim.y * gridDim.z;
    unsigned sum, cnt, mine, sp = 0u;
    for (;;) {
        sum = 0u; cnt = 0u; mine = 0u;
#pragma unroll 1
        for (unsigned j = 0; j < 16; ++j) { const unsigned c = xb_ld(&bar[XB_XCNT(j)]); sum += c; cnt += (c > 0u) ? 1u : 0u; mine = (j == x) ? c : mine; }
        if (sum == G) break;
        __builtin_amdgcn_s_sleep(1);
        if ((++sp & 255u) == 0u) { if (xb_ld(&bar[XB_TMO])) break; if (sp > XB_SPIN_CAP) { atomicAdd(&bar[XB_TMO], 1u); break; } }
    }
    nloc = mine > 0u ? mine : 1u; nx = cnt > 0u ? cnt : 1u;
}

__device__ __forceinline__ void xcd_barrier(const XcdBarrier& b) {
    asm volatile("s_waitcnt vmcnt(0)" ::: "memory");
    __syncthreads();
    if (threadIdx.x == 0) {
        unsigned* bar = b.bar;
        __builtin_amdgcn_s_waitcnt(0);
        unsigned nloc = b.st[0], nx = b.st[1];
        if (nloc == 0u) { xcd_barrier_complete(bar, b.x, nloc, nx); b.st[0] = nloc; b.st[1] = nx; }
        const unsigned old = xb_add(&bar[XB_XSUB(b.x)], 1u);
        const unsigned gen = old / nloc;
        if (old + 1u == (gen + 1u) * nloc) {
            __builtin_amdgcn_fence(__ATOMIC_RELEASE, "agent");
            asm volatile("s_waitcnt vmcnt(0)" ::: "memory");
            const unsigned og = xb_add(&bar[XB_TOP], 1u);
            const unsigned tg = og / nx;
            if (og + 1u == (tg + 1u) * nx) xb_add(&bar[XB_TOPGEN], 1u);
            else XB_SPIN(xb_ld(&bar[XB_TOPGEN]) == tg, bar);
            __builtin_amdgcn_fence(__ATOMIC_ACQUIRE, "agent");
            xb_add(&bar[XB_XGEN(b.x)], 1u);
            asm volatile("s_waitcnt vmcnt(0)" ::: "memory");
        } else {
            XB_SPIN(xb_ld(&bar[XB_XGEN(b.x)]) == gen, bar);
            __builtin_amdgcn_fence(__ATOMIC_ACQUIRE, "agent");
            asm volatile("s_waitcnt vmcnt(0)" ::: "memory");
        }
    }
    __syncthreads();
}

constexpr int BATCH = 2, SEQ = 4096, DM = 4096, DEPTH = 4, MTOK = BATCH * SEQ;
constexpr int DIN = 13328;
constexpr int NPJ = 13568;
constexpr int C_RQ = 0, C_RK = 1024, C_RV = 2048, C_RG = 3072, C_MQ = 4096, C_MK = 5120, C_MV = 6144, C_MG = 7168, C_SZ = 8192, C_SX = 9216, C_LX = 11264, C_LG = 12288, C_DT = 13312;
constexpr float EPS = 1e-6f;
constexpr int NWAVES = 8, NTHR = 512;
constexpr int NPHASE = 2 + 5 * DEPTH;

constexpr size_t MiB = 1u << 20;
constexpr size_t WS_CTL = 0, CTL_ZERO_BYTES = 1 * MiB;
constexpr size_t WS_SSQ = 2 * MiB, WS_LRUW = 4 * MiB, WS_KMEAN = 6 * MiB, WS_DT = 7 * MiB, WS_DTRAW = 8 * MiB, WS_DACS = 9 * MiB, WS_HEND = 10 * MiB, WS_AEND = 11 * MiB, WS_CARRY = 12 * MiB;
constexpr size_t WS_WIN = 16 * MiB, WIN_LAYER = (size_t)NPJ * DM * 2;
constexpr size_t WS_WOUT = 440 * MiB, WOUT_LAYER = (size_t)DM * DM * 2;
constexpr size_t WS_X = 568 * MiB, WS_XB = 696 * MiB, WS_P = 760 * MiB, WS_Y = 972 * MiB, WS_RU = 1036 * MiB, WS_RS = 1068 * MiB, WS_XBC = 1084 * MiB, WS_SST = 1116 * MiB, WS_SHP = 1132 * MiB,
                 WS_HLOC = 1140 * MiB, WS_ACUM = 1172 * MiB, WS_END = 1204 * MiB;
static_assert(WS_WIN + 4 * WIN_LAYER <= WS_WOUT && WS_P + (size_t)MTOK * NPJ * 2 <= WS_Y, "ws map");
constexpr int CW_BAR = 4096;
constexpr int CW_WQ = 16384;

constexpr int RING_BYTES = 131072, LDSCTL_OFF = RING_BYTES, MISC_OFF = LDSCTL_OFF + 320, LDS_BYTES = 147456;
constexpr int SB256 = 528, SB128 = 272;

struct Args { const float* in[19]; float* out; unsigned char* ws; int ph_lo, ph_hi; };
struct Frame {
    LAS unsigned char* lds; const Args* a; int z, tid_;
    DI int tid() const { return tid_; }
    DI int lane() const { return tid_ & 63; }
    DI int wave() const { return __builtin_amdgcn_readfirstlane(tid_ >> 6); }
    DI int G() const { return (int)gridDim.x; }
    DI volatile LAS unsigned* MISC() const { return (volatile LAS unsigned*)(lds + MISC_OFF); }
    DI unsigned char* ws() const { return a->ws + z; }
    DI unsigned* ctl() const { return (unsigned*)(a->ws + z + WS_CTL); }
    DI const float* in(int k) const { return a->in[k] + z; }
    DI float* out() const { return a->out + z; }
#define FV(T, name, off) DI T* name() const { return (T*)(a->ws + z + (off)); }
    FV(bf16, WIN, WS_WIN) FV(bf16, WOUT, WS_WOUT) FV(bf16, XB, WS_XB) FV(bf16, P, WS_P) FV(bf16, Y, WS_Y) FV(bf16, RS, WS_RS) FV(bf16, XBC, WS_XBC) FV(bf16, SHP, WS_SHP) FV(bf16, LRUW, WS_LRUW)
    FV(float, X, WS_X) FV(float, SSQ, WS_SSQ) FV(bf16, KMH, WS_KMEAN) FV(bf16, KML, WS_KMEAN + 65536) FV(float, KMX, WS_KMEAN + 131072) FV(float, DT, WS_DT) FV(float, DTRAW, WS_DTRAW) FV(float, DACS, WS_DACS) FV(float, HEND, WS_HEND) FV(float, AEND, WS_AEND)
    FV(float, CARRY, WS_CARRY) FV(bf16, RU, WS_RU) FV(float, SST, WS_SST) FV(bf16, HLOC, WS_HLOC) FV(bf16, ACUM, WS_ACUM)
#undef FV
};

DI Frame mk_frame(LAS unsigned char* lds, const Args* a) { Frame F; F.lds = lds; F.a = a; int z = 0; asm volatile("" : "+s"(z)); int t = (int)threadIdx.x; asm volatile("" : "+v"(t)); F.z = z; F.tid_ = t; return F; }
DI float bf_lo(unsigned u) { return __uint_as_float(u << 16); }
DI float bf_hi(unsigned u) { return __uint_as_float(u & 0xffff0000u); }
typedef float f32x2_t __attribute__((ext_vector_type(2))); typedef __bf16 bf16x2_t __attribute__((ext_vector_type(2)));
DI unsigned pkbf(float lo, float hi) { f32x2_t v = {lo, hi}; bf16x2_t b = __builtin_convertvector(v, bf16x2_t); return __builtin_bit_cast(unsigned, b); }
DI float wave_sum(float v) {
#pragma unroll
    for (int o = 1; o < 64; o <<= 1) v += __shfl_xor(v, o);
    return v;
}
DI float sigm(float x) { return __builtin_amdgcn_rcpf(1.f + __expf(-x)); }
DI float silu(float x) { return x * __builtin_amdgcn_rcpf(1.f + __expf(-x)); }
DI float one_minus_exp(float x) { const float p = -x * (1.0f + x * (0.5f + x * (0.16666667f + x * (0.041666668f + x * 0.008333334f)))); return x > -0.25f ? p : 1.0f - __expf(x); }
DI float softplus(float x) { return x > 20.f ? x : log1pf(__expf(x)); }
DI f32x4 mfma16(bf16x8 a, bf16x8 b, f32x4 c) { return __builtin_amdgcn_mfma_f32_16x16x32_bf16(a, b, c, 0, 0, 0); }
DI void unpack8(const v4u v, float (&f)[8]) { f[0] = bf_lo(v.x); f[1] = bf_hi(v.x); f[2] = bf_lo(v.y); f[3] = bf_hi(v.y); f[4] = bf_lo(v.z); f[5] = bf_hi(v.z); f[6] = bf_lo(v.w); f[7] = bf_hi(v.w); }
DI v4u pack8(const float (&f)[8]) { v4u v; v.x = pkbf(f[0], f[1]); v.y = pkbf(f[2], f[3]); v.z = pkbf(f[4], f[5]); v.w = pkbf(f[6], f[7]); return v; }
DI bf16x8 pack8f(const float (&f)[8]) { return __builtin_bit_cast(bf16x8, pack8(f)); }
DI bf16x8 frag_row(const LAS unsigned char* t, int sb, int r0, int k0, int lane) { return *(const LAS bf16x8*)(t + (r0 + (lane & 15)) * sb + (k0 + 8 * (lane >> 4)) * 2); }
typedef short v4i16_t __attribute__((ext_vector_type(4)));
DI bf16x8 frag_tr(const LAS unsigned char* t, int sb, int ra, int rb, int c0, int lane) {
    const int q = (lane & 15) >> 2, p = lane & 3;
    const s16x4 lo = __builtin_bit_cast(s16x4, __builtin_amdgcn_ds_read_tr16_b64_v4i16((LAS v4i16_t*)(t + (ra + q) * sb + (c0 + 4 * p) * 2)));
    const s16x4 hi = __builtin_bit_cast(s16x4, __builtin_amdgcn_ds_read_tr16_b64_v4i16((LAS v4i16_t*)(t + (rb + q) * sb + (c0 + 4 * p) * 2)));
    bf16x8 r; r[0] = lo[0]; r[1] = lo[1]; r[2] = lo[2]; r[3] = lo[3]; r[4] = hi[0]; r[5] = hi[1]; r[6] = hi[2]; r[7] = hi[3]; return r;
}
template <int COLS> DI void stage_bf16(LAS unsigned char* dst, int sb, const bf16* src, size_t gp, int rows, int tid) {
    constexpr int CPR = COLS / 8; const int total = rows * CPR;
    for (int c = tid; c < total; c += NTHR) { const int r = c / CPR, ch = c % CPR; const v4u v = *(const v4u*)(src + (size_t)r * gp + ch * 8); *(LAS v4u*)(dst + r * sb + ch * 16) = v; }
}
#define WG_BAR_LDS() do { asm volatile("s_waitcnt lgkmcnt(0)" ::: "memory"); __builtin_amdgcn_s_barrier(); asm volatile("" ::: "memory"); } while (0)
DI unsigned wq_issue(Frame& F, int ctr) { unsigned v = 0u; if (F.tid() == 0) v = __hip_atomic_fetch_add(F.ctl() + CW_WQ + 64 * ctr, 1u, RLX_AGENT); return v; }
DI int wq_publish(Frame& F, unsigned v) { __syncthreads(); if (F.tid() == 0) F.MISC()[0] = v; __syncthreads(); return __builtin_amdgcn_readfirstlane((int)F.MISC()[0]); }
DI int next_unit(Frame& F, int ctr) {
    __syncthreads();
    if (F.tid() == 0) F.MISC()[0] = __hip_atomic_fetch_add(F.ctl() + CW_WQ + 64 * ctr, 1u, RLX_AGENT);
    __syncthreads();
    return __builtin_amdgcn_readfirstlane((int)F.MISC()[0]);
}

namespace pg8 {
struct EpiProj {
    static constexpr bool PERM = true, AFTER_DRAIN = false;
    bf16_t* O; float* dtraw; const float* ssq;
    const PG8_LAS float* rtab; int fm;
    __device__ __forceinline__ void operator()(const f32x4 (&acc)[2][2][4][2], const Unit& u, int wr, int wc, int fr, int fq) const {
        asm volatile("" : "+v"(fr), "+v"(fq));
        const int row0 = u.pm * BM + wr * 64 + fr;
        const bool dt_tile = u.pn >= 52;
        const int col0 = u.pn * BM + wc * 32 + 8 * fq;
        const bool tab = rtab != nullptr && (unsigned)(u.pm - fm) < 8u;
        float rs[2][4];
        if (tab) { const PG8_LAS float* t = rtab + (u.pm - fm) * BM + wr * 64 + fr;
#pragma unroll
            for (int ai = 0; ai < 2; ++ai)
#pragma unroll
                for (int m = 0; m < 4; ++m) rs[ai][m] = t[ai * HALF + m * 16];
        } else { f32x4 pv[2][4];
#pragma unroll
            for (int ai = 0; ai < 2; ++ai)
#pragma unroll
                for (int m = 0; m < 4; ++m) pv[ai][m] = *(const f32x4*)(ssq + (size_t)(row0 + ai * HALF + m * 16) * 16 + 4 * fq);
#pragma unroll
            for (int ai = 0; ai < 2; ++ai)
#pragma unroll
                for (int m = 0; m < 4; ++m) { float s = (pv[ai][m][0] + pv[ai][m][1]) + (pv[ai][m][2] + pv[ai][m][3]); s += __shfl_xor(s, 16); s += __shfl_xor(s, 32); rs[ai][m] = rsqrtf(s * (1.0f / 4096.0f) + 1e-6f); } }
#pragma unroll
        for (int ai = 0; ai < 2; ++ai)
#pragma unroll
            for (int m = 0; m < 4; ++m) { const int r = row0 + ai * HALF + m * 16; const float s = rs[ai][m];
                if (!dt_tile) { bf16_t* rowp = O + (size_t)r * 13568 + col0;
#pragma unroll
                    for (int bj = 0; bj < 2; ++bj) { const f32x4 v0 = acc[ai][bj][m][0] * s, v1 = acc[ai][bj][m][1] * s;
                        u32x4 w; w.x = cvt_pk_bf16(v0[0], v0[1]); w.y = cvt_pk_bf16(v0[2], v0[3]); w.z = cvt_pk_bf16(v1[0], v1[1]); w.w = cvt_pk_bf16(v1[2], v1[3]);
                        *(u32x4*)(rowp + bj * HALF) = w; }
                } else if (wc == 0 && fq < 2) { float* rowp = dtraw + (size_t)r * 16 + 8 * fq; *(f32x4*)(rowp) = acc[ai][0][m][0] * s; *(f32x4*)(rowp + 4) = acc[ai][0][m][1] * s; } }
    }
};
struct EpiOut {
    static constexpr bool PERM = false, AFTER_DRAIN = false;
    bf16_t* xb; float* ssq; PG8_LAS float* red;
    __device__ __forceinline__ void operator()(const f32x4 (&acc)[2][2][4][2], const Unit& u, int wr, int wc, int fr, int fq) const {
        asm volatile("" : "+v"(fr), "+v"(fq));
        const int row0 = u.pm * BM + wr * 64 + fr, col0 = u.pn * BM + wc * 32 + 4 * fq;
#pragma unroll
        for (int ai = 0; ai < 2; ++ai) {
            unsigned long long xo[4][2][2];
#pragma unroll
            for (int m = 0; m < 4; ++m)
#pragma unroll
                for (int bj = 0; bj < 2; ++bj)
#pragma unroll
                    for (int n = 0; n < 2; ++n) xo[m][bj][n] = *(const unsigned long long*)(xb + (size_t)(row0 + ai * HALF + m * 16) * 4096 + col0 + bj * HALF + n * 16);
#pragma unroll
            for (int m = 0; m < 4; ++m) { const int r = row0 + ai * HALF + m * 16; const size_t off = (size_t)r * 4096 + col0; float ss = 0.f;
#pragma unroll
                for (int bj = 0; bj < 2; ++bj)
#pragma unroll
                    for (int n = 0; n < 2; ++n) { const unsigned lo = (unsigned)xo[m][bj][n], hi = (unsigned)(xo[m][bj][n] >> 32);
                        f32x4 o = acc[ai][bj][m][n]; o[0] += __uint_as_float(lo << 16); o[1] += __uint_as_float(lo & 0xffff0000u); o[2] += __uint_as_float(hi << 16); o[3] += __uint_as_float(hi & 0xffff0000u);
                        ss += (o[0] * o[0] + o[1] * o[1]) + (o[2] * o[2] + o[3] * o[3]);
                        const unsigned w0 = cvt_pk_bf16(o[0], o[1]), w1 = cvt_pk_bf16(o[2], o[3]);
                        *(unsigned long long*)(xb + off + bj * HALF + n * 16) = (unsigned long long)w0 | ((unsigned long long)w1 << 32); }
                ss += __shfl_xor(ss, 16); ss += __shfl_xor(ss, 32);
                if (fq == 0) red[(ai * HALF + wr * 64 + m * 16 + fr) * 4 + wc] = ss; }
            asm volatile("" ::: "memory"); }
        asm volatile("s_waitcnt lgkmcnt(0)" ::: "memory"); __builtin_amdgcn_s_barrier(); asm volatile("" ::: "memory");
        { const int t = (wr * 4 + wc) * 64 + fq * 16 + fr;
          if (t < 256) { const f32x4 p4 = *(const PG8_LAS f32x4*)(red + t * 4); ssq[(size_t)(u.pm * BM + t) * 16 + u.pn] = (p4[0] + p4[1]) + (p4[2] + p4[3]); } }
    }
};
struct RemapOrder : StaticOrder {
    __device__ __forceinline__ bool next(int i, Unit& u) const { if (!StaticOrder::next(i, u)) return false; if (u.pn == 35) u.pn = 52; return true; }
};
struct OneUnit {
    int pm, pn;
    __device__ __forceinline__ bool next(int i, Unit& u) const { if (i != 0) return false; u.pm = pm; u.pn = pn; return true; }
    __device__ __forceinline__ void a_ready(const Unit&) const {}
    __device__ __forceinline__ void done(const Unit&) const {}
};
}

DI int map_in_col(int n) { return n < 11264 ? n : (n < 11280 ? C_DT + (n - 11264) : n - 16); }
constexpr int TR_SB = 272;
struct TrItem { const float* W; const float* ks; bf16* WT; int N, k0, n0, is_in; };
constexpr int TR_NB_IN = (DIN + 127) / 128, TR_I_IN = 32 * TR_NB_IN, TR_I_OUT = 32 * 32, TR_I_L = TR_I_IN + TR_I_OUT;
DI bool tr_item(Frame& F, int l, int r, TrItem& t) {
    constexpr int NB_IN = TR_NB_IN, I_IN = TR_I_IN;
    if (r >= TR_I_L) return false;
    if (r < I_IN) { t.W = F.in(2) + (size_t)l * DM * DIN; t.ks = F.in(1) + l * DM; t.WT = F.WIN() + (size_t)l * NPJ * DM; t.N = DIN; t.k0 = 128 * (r / NB_IN); t.n0 = 128 * (r % NB_IN); t.is_in = 1; }
    else { const int q = r - I_IN; t.W = F.in(17) + (size_t)l * DM * DM; t.ks = nullptr; t.WT = F.WOUT() + (size_t)l * DM * DM; t.N = DM; t.k0 = 128 * (q / 32); t.n0 = 128 * (q % 32); t.is_in = 0; }
    return true;
}
DI void tr_load(const TrItem& t, int tid, f32x4 (&v)[8]) {
    const int c4 = tid & 31, n = t.n0 + 4 * c4; const bool ok = n < t.N;
#pragma unroll
    for (int p = 0; p < 8; ++p) { const int k = t.k0 + p * 16 + (tid >> 5); f32x4 x = ok ? *(const f32x4*)(t.W + (size_t)k * t.N + n) : (f32x4){0.f, 0.f, 0.f, 0.f}; if (t.ks) x *= t.ks[k]; v[p] = x; }
}
DI void tr_step(Frame& F, const TrItem& cur, f32x4 (&v)[8], int l, int r_next, TrItem& nxt, bool& hn, LAS unsigned char* tile, int tid, int lane, int w) {
    const int gq = lane >> 4, l15 = lane & 15, c4 = tid & 31;
    __syncthreads();
#pragma unroll
    for (int p = 0; p < 8; ++p) { const int kr = p * 16 + (tid >> 5); v2u o; o.x = pkbf(v[p][0], v[p][1]); o.y = pkbf(v[p][2], v[p][3]); *(LAS v2u*)(tile + kr * TR_SB + c4 * 8) = o; }
    __syncthreads();
    hn = tr_item(F, l, r_next, nxt);
    if (hn) tr_load(nxt, tid, v);
    const int n = cur.n0 + 16 * w + l15; const bool okn = n < cur.N; const int row = cur.is_in ? map_in_col(okn ? n : 0) : n; bf16* dst = cur.WT + (size_t)row * DM + cur.k0 + 8 * gq;
#pragma unroll
    for (int ks = 0; ks < 4; ++ks) { const bf16x8 f = frag_tr(tile, TR_SB, 32 * ks + 8 * gq, 32 * ks + 8 * gq + 4, 16 * w, lane); if (okn) *(bf16x8*)(dst + 32 * ks) = f; }
}
DI void tr_unit(Frame& F, int l, int r0, int cnt) {
    const int tid = F.tid(), lane = F.lane(), w = F.wave();
    TrItem ia, ib, dummy; f32x4 va[8], vb[8]; bool hn;
    tr_item(F, l, r0, ia); tr_item(F, l, r0 + 1, ib);
    tr_load(ia, tid, va); tr_load(ib, tid, vb);
    tr_step(F, ia, va, l, TR_I_L, dummy, hn, F.lds, tid, lane, w);
    tr_step(F, ib, vb, l, TR_I_L, dummy, hn, F.lds, tid, lane, w);
    __syncthreads();
}
DI void p0_prologue(Frame& F) {
    const int tid = F.tid(), lane = F.lane(), w = F.wave();
    LAS unsigned char* tile = F.lds;
    TrItem ia, ib; f32x4 va[8], vb[8];
    int it = blockIdx.x; const int G = F.G();
#define P0_IDX(i) ((i) < TR_I_IN ? (i) : TR_I_L)
    bool ha = tr_item(F, 0, P0_IDX(it), ia), hb = tr_item(F, 0, P0_IDX(it + G), ib);
    if (ha) tr_load(ia, tid, va);
    if (hb) tr_load(ib, tid, vb);
    while (ha) {
        TrItem na; bool hna;
        tr_step(F, ia, va, 0, P0_IDX(it + 2 * G), na, hna, tile, tid, lane, w);
        if (!hb) break;
        TrItem nb; bool hnb;
        tr_step(F, ib, vb, 0, P0_IDX(it + 3 * G), nb, hnb, tile, tid, lane, w);
        ia = na; ha = hna; ib = nb; hb = hnb; it += 2 * G;
    }
    const int gw = blockIdx.x * NWAVES + w, NGW = F.G() * NWAVES;
    for (int i = blockIdx.x * NTHR + tid; i < DEPTH * 240 * (DM / 8); i += F.G() * NTHR) { const int l = i / (240 * (DM / 8)), r = i % (240 * (DM / 8));
        *(v4u*)(F.WIN() + (size_t)l * NPJ * DM + (size_t)(C_DT + 16) * DM + (size_t)r * 8) = (v4u){0u, 0u, 0u, 0u}; }
    for (int i = blockIdx.x * NTHR + tid; i < DEPTH * 2 * 8 * 128 * 128; i += F.G() * NTHR) { const int d = i & 127, e = (i >> 7) & 127, nb = (i >> 14) & 7, gate = (i >> 17) & 1, l = i >> 18;
        const float* wp = (gate ? F.in(14) : F.in(12)) + ((size_t)(l * 8 + nb) * 128 + d) * 128 + e; F.LRUW()[i] = (bf16)f2bf(*wp); }
    for (int m = gw; m < MTOK; m += NGW) { const f32x4* xr = (const f32x4*)(F.in(0) + (size_t)m * DM) + lane; float ss = 0.f;
#pragma unroll
        for (int j = 0; j < 16; ++j) { const f32x4 x = xr[64 * j]; ss += (x[0] * x[0] + x[1] * x[1]) + (x[2] * x[2] + x[3] * x[3]);
            const unsigned long long o = (unsigned long long)pkbf(x[0], x[1]) | ((unsigned long long)pkbf(x[2], x[3]) << 32); *((unsigned long long*)(F.XB() + (size_t)m * DM) + 64 * j + lane) = o; }
        ss = wave_sum(ss); if (lane < 16) F.SSQ()[(size_t)m * 16 + lane] = lane == 0 ? ss : 0.f; }
}
DI void p_final(Frame& F) {
    const int gw = blockIdx.x * NWAVES + F.wave(), NGW = F.G() * NWAVES, lane = F.lane(); const float* fw = F.in(18);
    for (int m = gw; m < MTOK; m += NGW) { float ss = F.SSQ()[(size_t)m * 16 + (lane & 15)]; ss += __shfl_xor(ss, 1); ss += __shfl_xor(ss, 2); ss += __shfl_xor(ss, 4); ss += __shfl_xor(ss, 8); const float rs = rsqrtf(ss * (1.0f / 4096.0f) + EPS);
        const v4u* xr = (const v4u*)(F.XB() + (size_t)m * DM) + lane; f32x4* o = (f32x4*)(F.out() + (size_t)m * DM) + 2 * lane; const f32x4* wv = (const f32x4*)fw + 2 * lane;
#pragma unroll
        for (int j = 0; j < 8; ++j) { float x[8]; unpack8(xr[64 * j], x); const f32x4 w0 = wv[128 * j], w1 = wv[128 * j + 1];
            o[128 * j] = (f32x4){x[0] * rs * w0[0], x[1] * rs * w0[1], x[2] * rs * w0[2], x[3] * rs * w0[3]}; o[128 * j + 1] = (f32x4){x[4] * rs * w1[0], x[5] * rs * w1[1], x[6] * rs * w1[2], x[7] * rs * w1[3]}; } }
}

DI int swz(int row) { return ((row & 3) << 2) | ((row >> 2) & 3); }
DI void dma_tile256(const bf16* src, size_t gp, LAS unsigned char* dst, int w, int lane) {
#pragma unroll
    for (int i = 0; i < 4; ++i) { const int idx = w * 4 + i, row = 2 * idx + (lane >> 5), c = (lane & 31) ^ swz(row);
        __builtin_amdgcn_global_load_lds((const unsigned*)(src + (size_t)row * gp + c * 8), (LAS unsigned*)(dst + idx * 1024), 16, 0, 0); }
}
DI bf16x8 frag_tr_sw512(const LAS unsigned char* t, int ra, int rb, int c0, int lane) {
    const int q = (lane & 15) >> 2, p = lane & 3, ch = (c0 >> 3) + (p >> 1), r0 = ra + q, r1 = rb + q;
    const s16x4 lo = __builtin_bit_cast(s16x4, __builtin_amdgcn_ds_read_tr16_b64_v4i16((LAS v4i16_t*)(t + 512 * r0 + 16 * (ch ^ swz(r0)) + 8 * (p & 1))));
    const s16x4 hi = __builtin_bit_cast(s16x4, __builtin_amdgcn_ds_read_tr16_b64_v4i16((LAS v4i16_t*)(t + 512 * r1 + 16 * (ch ^ swz(r1)) + 8 * (p & 1))));
    bf16x8 r; r[0] = lo[0]; r[1] = lo[1]; r[2] = lo[2]; r[3] = lo[3]; r[4] = hi[0]; r[5] = hi[1]; r[6] = hi[2]; r[7] = hi[3]; return r;
}
DI bf16x8 frag_row_sw512(const LAS unsigned char* t, int row, int ch) { return *(const LAS bf16x8*)(t + 512 * row + 16 * (ch ^ swz(row))); }
DI void ret_A(Frame& F, int unit) {
    const int c = unit & 15, bh = unit >> 4, h = bh & 3, b = bh >> 2, lane = F.lane(), w = F.wave(), gq = lane >> 4, l15 = lane & 15;
    const size_t t0 = (size_t)b * SEQ + c * 256;
    const bf16* Kp = F.P() + t0 * NPJ + C_RK + h * 256; const bf16* Vp = F.P() + t0 * NPJ + C_RV + h * 256;
    const float lg = log1pf(-exp2f(-5.f - (float)h));
    LAS unsigned char* B0 = F.lds; LAS unsigned char* B1 = F.lds + 65536;
    f32x4 acc[2][16];
#pragma unroll
    for (int a = 0; a < 2; ++a)
#pragma unroll
        for (int v = 0; v < 16; ++v) acc[a][v] = (f32x4){0.f, 0.f, 0.f, 0.f};
    float kd8[8];
#pragma unroll
    for (int e = 0; e < 8; ++e) kd8[e] = __expf(-lg * (float)(8 * gq + e));
    __syncthreads();
    dma_tile256(Kp, NPJ, B0, w, lane); dma_tile256(Vp, NPJ, B0 + 32768, w, lane);
    VM_WAIT(); __syncthreads();
    for (int jt = 0; jt < 4; ++jt) {
        LAS unsigned char* cur = (jt & 1) ? B1 : B0; LAS unsigned char* nxt = (jt & 1) ? B0 : B1;
        if (jt < 3) { dma_tile256(Kp + (size_t)(64 * (jt + 1)) * NPJ, NPJ, nxt, w, lane); dma_tile256(Vp + (size_t)(64 * (jt + 1)) * NPJ, NPJ, nxt + 32768, w, lane); }
        { int lz = lane; asm volatile("" : "+v"(lz)); const int lane = lz, gq = lz >> 4;
#pragma unroll
          for (int ks = 0; ks < 2; ++ks) { const int ra = 32 * ks + 8 * gq, rb = ra + 4;
              const float base = __expf(lg * (float)(255 - (64 * jt + 32 * ks))) * 0.0625f;
              bf16x8 A[2];
#pragma unroll
              for (int dt = 0; dt < 2; ++dt) { float f[8]; unpack8(__builtin_bit_cast(v4u, frag_tr_sw512(cur, ra, rb, 32 * w + 16 * dt, lane)), f);
#pragma unroll
                  for (int e = 0; e < 8; ++e) f[e] *= base * kd8[e];
                  A[dt] = pack8f(f); }
#pragma unroll
              for (int vt = 0; vt < 16; ++vt) { const bf16x8 B = frag_tr_sw512(cur + 32768, ra, rb, 16 * vt, lane); acc[0][vt] = mfma16(A[0], B, acc[0][vt]); acc[1][vt] = mfma16(A[1], B, acc[1][vt]); } } }
        VM_WAIT(); __syncthreads();
    }
    bf16* U = F.RU() + (size_t)unit * 65536;
#pragma unroll
    for (int dt = 0; dt < 2; ++dt)
#pragma unroll
        for (int vt = 0; vt < 16; ++vt) { v2u o; o.x = pkbf(acc[dt][vt][0], acc[dt][vt][1]); o.y = pkbf(acc[dt][vt][2], acc[dt][vt][3]); *(v2u*)(U + (16 * vt + l15) * 256 + 32 * w + 16 * dt + 4 * gq) = o; }
}
DI void ret_B(Frame& F) {
    for (int it = blockIdx.x * NTHR + F.tid(); it < 8 * 16384; it += F.G() * NTHR) { const int bh = it >> 14, e4 = it & 16383, h = bh & 3;
        const float cd = __expf(log1pf(-exp2f(-5.f - (float)h)) * 256.f); f32x4 s = (f32x4){0.f, 0.f, 0.f, 0.f};
        const size_t o0 = (size_t)(bh * 16) * 65536 + (size_t)e4 * 4; const bf16* __restrict__ ru = F.RU() + o0; bf16* __restrict__ rs = F.RS() + o0;
        f32x4 u[15];
#pragma unroll
        for (int c = 0; c < 15; ++c) { const v2u r = *(const v2u*)(ru + (size_t)c * 65536); u[c] = (f32x4){bf_lo(r.x), bf_hi(r.x), bf_lo(r.y), bf_hi(r.y)}; }
#pragma unroll
        for (int c = 0; c < 16; ++c) { *(unsigned long long*)(rs + (size_t)c * 65536) = (unsigned long long)pkbf(s[0], s[1]) | ((unsigned long long)pkbf(s[2], s[3]) << 32);
            if (c < 15) s = s * cd + u[c]; } }
}
DI void ret_C(Frame& F, int l, int unit2) {
    const int half = unit2 & 1, unit = unit2 >> 1, c = unit & 15, bh = unit >> 4, h = bh & 3, b = bh >> 2, lane = F.lane(), w = F.wave(), gq = lane >> 4, l15 = lane & 15;
    const size_t t0 = (size_t)b * SEQ + c * 256;
    const int il = half * 128 + w * 16 + l15;
    const float lg = log1pf(-exp2f(-5.f - (float)h));
    const bf16* St = F.RS() + (size_t)unit * 65536;
    const bf16* Kp = F.P() + t0 * NPJ + C_RK + h * 256; const bf16* Vp = F.P() + t0 * NPJ + C_RV + h * 256;
    LAS unsigned char* B0 = F.lds; LAS unsigned char* B1 = F.lds + 65536;
    if (c > 0) dma_tile256(St, 256, B0, w, lane); else { dma_tile256(Kp, NPJ, B0, w, lane); dma_tile256(Vp, NPJ, B0 + 32768, w, lane); }
    const bf16* Qp = F.P() + (t0 + il) * NPJ + C_RQ + h * 256;
    bf16x8 Q[8];
#pragma unroll
    for (int ks = 0; ks < 8; ++ks) Q[ks] = *(const bf16x8*)(Qp + 32 * ks + 8 * gq);
    f32x4 acc[16];
#pragma unroll
    for (int v = 0; v < 16; ++v) acc[v] = (f32x4){0.f, 0.f, 0.f, 0.f};
    const int njt = 2 * (half + 1);
    VM_WAIT(); __syncthreads();
    int par = 0;
    if (c > 0) {
#pragma unroll
        for (int sp = 0; sp < 4; ++sp) {
            LAS unsigned char* cur = (sp & 1) ? B1 : B0; LAS unsigned char* nxt = (sp & 1) ? B0 : B1;
            if (sp < 3) dma_tile256(St + (size_t)(64 * (sp + 1)) * 256, 256, nxt, w, lane); else { dma_tile256(Kp, NPJ, nxt, w, lane); dma_tile256(Vp, NPJ, nxt + 32768, w, lane); }
#pragma unroll
            for (int ks = 0; ks < 8; ++ks)
#pragma unroll
                for (int vt = 0; vt < 4; ++vt) acc[4 * sp + vt] = mfma16(frag_row_sw512(cur, 16 * vt + l15, 4 * ks + gq), Q[ks], acc[4 * sp + vt]);
            VM_WAIT(); __syncthreads();
        }
        const float qd = __expf(lg * (float)(il + 1));
#pragma unroll
        for (int v = 0; v < 16; ++v) acc[v] *= qd;
        par = 0;
    }
    for (int jt = 0; jt < njt; ++jt) {
        LAS unsigned char* cur = ((jt + par) & 1) ? B1 : B0; LAS unsigned char* nxt = ((jt + par) & 1) ? B0 : B1;
        if (jt + 1 < njt) { dma_tile256(Kp + (size_t)(64 * (jt + 1)) * NPJ, NPJ, nxt, w, lane); dma_tile256(Vp + (size_t)(64 * (jt + 1)) * NPJ, NPJ, nxt + 32768, w, lane); }
        if (64 * jt <= half * 128 + w * 16 + 15) {
            const LAS unsigned char* Kt = cur; const LAS unsigned char* Vt = cur + 32768;
#pragma unroll
            for (int js = 0; js < 2; ++js) {
                f32x4 s0 = (f32x4){0.f, 0.f, 0.f, 0.f}, s1 = s0, s0b = s0, s1b = s0;
                const int kr0 = 32 * js + 8 * (l15 >> 2) + (l15 & 3), kr1 = kr0 + 4;
#pragma unroll
                for (int ks = 0; ks < 8; ks += 2) { s0 = mfma16(frag_row_sw512(Kt, kr0, 4 * ks + gq), Q[ks], s0); s1 = mfma16(frag_row_sw512(Kt, kr1, 4 * ks + gq), Q[ks], s1);
                    s0b = mfma16(frag_row_sw512(Kt, kr0, 4 * ks + 4 + gq), Q[ks + 1], s0b); s1b = mfma16(frag_row_sw512(Kt, kr1, 4 * ks + 4 + gq), Q[ks + 1], s1b); }
                s0 += s0b; s1 += s1b;
                float p[8]; const int jb = 64 * jt + 32 * js + 8 * gq;
#pragma unroll
                for (int e = 0; e < 8; ++e) { const int j = jb + e; const float sv = (e < 4) ? s0[e & 3] : s1[e & 3]; const float f = __expf(lg * (float)(il - j)) * 0.0625f; p[e] = (il >= j) ? sv * f : 0.f; }
                const bf16x8 Pf = pack8f(p);
#pragma unroll
                for (int vt = 0; vt < 16; ++vt) acc[vt] = mfma16(frag_tr_sw512(Vt, 32 * js + 8 * gq, 32 * js + 8 * gq + 4, 16 * vt, lane), Pf, acc[vt]);
            }
        }
        VM_WAIT(); __syncthreads();
    }
    float ss = 0.f;
#pragma unroll
    for (int v = 0; v < 16; ++v) ss += (acc[v][0] * acc[v][0] + acc[v][1] * acc[v][1]) + (acc[v][2] * acc[v][2] + acc[v][3] * acc[v][3]);
    ss += __shfl_xor(ss, 16); ss += __shfl_xor(ss, 32);
    const float rms = rsqrtf(ss * (1.0f / 256.0f) + EPS);
    const float* gw = F.in(3) + l * 1024 + h * 256; const bf16* Gp = F.P() + (t0 + il) * NPJ + C_RG + h * 256; bf16* Yp = F.Y() + (t0 + il) * DM + 0 + h * 256;
#pragma unroll
    for (int vt = 0; vt < 16; ++vt) { const int v = 16 * vt + 4 * gq; const v2u gv = *(const v2u*)(Gp + v); const f32x4 w4 = *(const f32x4*)(gw + v);
        const float y0 = acc[vt][0] * rms * w4[0] * silu(bf_lo(gv.x)), y1 = acc[vt][1] * rms * w4[1] * silu(bf_hi(gv.x)), y2 = acc[vt][2] * rms * w4[2] * silu(bf_lo(gv.y)), y3 = acc[vt][3] * rms * w4[3] * silu(bf_hi(gv.y));
        v2u o; o.x = pkbf(y0, y1); o.y = pkbf(y2, y3); *(v2u*)(Yp + v) = o; }
}

DI void moba_kmean(Frame& F, int unit) {
    const int blk = unit & 15, bh = unit >> 4, h = bh & 7, b = bh >> 3, tid = F.tid(), ch = tid & 15, rg = tid >> 4;
    const bf16* Kp = F.P() + ((size_t)b * SEQ + blk * 256 + rg) * NPJ + C_MK + h * 128 + ch * 8;
    v4u raw[8];
#pragma unroll
    for (int i = 0; i < 8; ++i) raw[i] = *(const v4u*)(Kp + (size_t)(32 * i) * NPJ);
    float s[8] = {0.f, 0.f, 0.f, 0.f, 0.f, 0.f, 0.f, 0.f}; float r2max = 0.f;
#pragma unroll
    for (int i = 0; i < 8; ++i) { float f[8]; unpack8(raw[i], f); float r2 = 0.f;
#pragma unroll
        for (int e = 0; e < 8; ++e) { s[e] += f[e]; r2 += f[e] * f[e]; }
        r2 += __shfl_xor(r2, 1); r2 += __shfl_xor(r2, 2); r2 += __shfl_xor(r2, 4); r2 += __shfl_xor(r2, 8);
        r2max = fmaxf(r2max, r2); }
    LAS float* red = (LAS float*)F.lds;
    __syncthreads();
    *(LAS f32x4*)(red + rg * 128 + ch * 8) = (f32x4){s[0], s[1], s[2], s[3]}; *(LAS f32x4*)(red + rg * 128 + ch * 8 + 4) = (f32x4){s[4], s[5], s[6], s[7]};
    if (ch == 0) red[4096 + rg] = r2max;
    __syncthreads();
    if (tid < 32) { float m = red[4096 + tid]; m = fmaxf(m, __shfl_xor(m, 1)); m = fmaxf(m, __shfl_xor(m, 2)); m = fmaxf(m, __shfl_xor(m, 4)); m = fmaxf(m, __shfl_xor(m, 8)); m = fmaxf(m, __shfl_xor(m, 16));
        if (tid == 0) F.KMX()[unit] = m; }
    if (tid < 128) { float t = 0.f;
#pragma unroll
        for (int g = 0; g < 32; ++g) t += red[g * 128 + tid];
        const float km = t * (1.0f / 256.0f);
        const unsigned hi = f2bf(km); const float rem = km - __uint_as_float(hi << 16);
        F.KMH()[(size_t)unit * 128 + tid] = (bf16)hi; F.KML()[(size_t)unit * 128 + tid] = (bf16)f2bf(rem); }
}
struct MobaSt {
    bf16x8 Q[2][4]; f32x4 acc[2][8]; f32x4 accl[2]; float m_ref[2], cq[2], kbias[8]; unsigned mym[2], wm;
    const LAS unsigned char* kptr[2][4]; const LAS unsigned char* vptr[2][8];
    unsigned voff[2]; const char* gK; LAS unsigned char* hb; bf16x8 ones;
    float scale2, slope2; int ob, qrel_hi, qpos0, w8, gq;
};
DI void moba_dma(const MobaSt& S, int tt, int bufoff) {
    const char* g = S.gK + (size_t)tt * (64 * NPJ * 2);
#pragma unroll
    for (int i = 0; i < 2; ++i) { LAS unsigned char* d = S.hb + bufoff + (S.w8 * 2 + i) * 1024;
        __builtin_amdgcn_global_load_lds((const unsigned*)(g + S.voff[i]), (LAS unsigned*)d, 16, 0, 0);
        __builtin_amdgcn_global_load_lds((const unsigned*)(g + (C_MV - C_MK) * 2 + S.voff[i]), (LAS unsigned*)(d + 16384), 16, 0, 0); }
}
template <int BUF> DI void moba_tile(MobaSt& S, int tt) {
    const int kb = tt >> 2, tile = tt & 3;
    if (!(((S.wm >> kb) & 1u) && (kb < S.ob || 64 * tile <= S.qrel_hi))) return;
    const bool own = (kb == S.ob);
#pragma unroll
    for (int js = 0; js < 2; ++js) {
        f32x4 s[2][2];
#pragma unroll
        for (int qi = 0; qi < 2; ++qi) { s[qi][0] = (f32x4){0.f, 0.f, 0.f, 0.f}; s[qi][1] = s[qi][0]; }
#pragma unroll
        for (int ks = 0; ks < 4; ++ks) {
            const bf16x8 K0 = *(const LAS bf16x8*)(S.kptr[0][ks] + BUF + 8192 * js), K1 = *(const LAS bf16x8*)(S.kptr[1][ks] + BUF + 8192 * js);
#pragma unroll
            for (int qi = 0; qi < 2; ++qi) { s[qi][0] = mfma16(K0, S.Q[qi][ks], s[qi][0]); s[qi][1] = mfma16(K1, S.Q[qi][ks], s[qi][1]); } }
        bf16x8 Pf[2];
        const float basef = S.slope2 * (float)(tt * 64 + 32 * js);
#pragma unroll
        for (int qi = 0; qi < 2; ++qi) {
            float t0 = basef - S.cq[qi] - S.m_ref[qi]; t0 = ((S.mym[qi] >> kb) & 1u) ? t0 : -INFINITY;
            float p[8]; float mx;
#pragma unroll
            for (int e = 0; e < 8; ++e) { const float sv = (e < 4) ? s[qi][0][e & 3] : s[qi][1][e & 3]; p[e] = sv * S.scale2 + (t0 + S.kbias[e]); }
            if (own) { const int kp = tt * 64 + 32 * js + 8 * S.gq, qp = S.qpos0 + 16 * qi;
#pragma unroll
                for (int e = 0; e < 8; ++e) p[e] = (kp + e <= qp) ? p[e] : -INFINITY; }
            mx = fmaxf(fmaxf(fmaxf(p[0], p[1]), fmaxf(p[2], p[3])), fmaxf(fmaxf(p[4], p[5]), fmaxf(p[6], p[7])));
            if (__any(mx > 8.0f)) {
                mx = fmaxf(mx, __shfl_xor(mx, 16)); mx = fmaxf(mx, __shfl_xor(mx, 32));
                const float d = fmaxf(mx, 0.f), alpha = __builtin_amdgcn_exp2f(-d);
                S.m_ref[qi] += d; S.accl[qi] *= alpha;
#pragma unroll
                for (int v = 0; v < 8; ++v) S.acc[qi][v] *= alpha;
#pragma unroll
                for (int e = 0; e < 8; ++e) p[e] -= d; }
#pragma unroll
            for (int e = 0; e < 8; ++e) p[e] = __builtin_amdgcn_exp2f(p[e]);
            Pf[qi] = pack8f(p); }
#pragma unroll
        for (int vt = 0; vt < 8; ++vt) {
            const s16x4 lo = __builtin_bit_cast(s16x4, __builtin_amdgcn_ds_read_tr16_b64_v4i16((LAS v4i16_t*)(S.vptr[0][vt] + BUF + 8192 * js)));
            const s16x4 hi = __builtin_bit_cast(s16x4, __builtin_amdgcn_ds_read_tr16_b64_v4i16((LAS v4i16_t*)(S.vptr[1][vt] + BUF + 8192 * js)));
            bf16x8 Vf; Vf[0] = lo[0]; Vf[1] = lo[1]; Vf[2] = lo[2]; Vf[3] = lo[3]; Vf[4] = hi[0]; Vf[5] = hi[1]; Vf[6] = hi[2]; Vf[7] = hi[3];
            S.acc[0][vt] = mfma16(Vf, Pf[0], S.acc[0][vt]); S.acc[1][vt] = mfma16(Vf, Pf[1], S.acc[1][vt]); }
        S.accl[0] = mfma16(S.ones, Pf[0], S.accl[0]); S.accl[1] = mfma16(S.ones, Pf[1], S.accl[1]);
    }
}
DI void moba_attn(Frame& F, int ob, int bh) {
    const int lane = F.lane(), w = F.wave(), gq = lane >> 4, l15 = lane & 15;
    const int h = bh & 7, b = bh >> 3;
    const size_t tq = (size_t)b * SEQ + ob * 256 + w * 32;
    MobaSt S;
    S.ob = ob; S.w8 = w; S.gq = gq; S.hb = F.lds;
    S.scale2 = 0.08838834764831845f * 1.4426950408889634f; S.slope2 = exp2f(-(float)(h + 1)) * 1.4426950408889634f;
#pragma unroll
    for (int qi = 0; qi < 2; ++qi)
#pragma unroll
        for (int ks = 0; ks < 4; ++ks) S.Q[qi][ks] = *(const bf16x8*)(F.P() + (tq + qi * 16 + l15) * NPJ + C_MQ + h * 128 + 32 * ks + 8 * gq);
    { bf16x8 KH[4], KL[4];
#pragma unroll
      for (int ks = 0; ks < 4; ++ks) { KH[ks] = *(const bf16x8*)(F.KMH() + ((size_t)bh * 16 + l15) * 128 + 32 * ks + 8 * gq); KL[ks] = *(const bf16x8*)(F.KML() + ((size_t)bh * 16 + l15) * 128 + 32 * ks + 8 * gq); }
#pragma unroll
      for (int qi = 0; qi < 2; ++qi) { f32x4 g = (f32x4){0.f, 0.f, 0.f, 0.f};
#pragma unroll
          for (int ks = 0; ks < 4; ++ks) { g = mfma16(KH[ks], S.Q[qi][ks], g); g = mfma16(KL[ks], S.Q[qi][ks], g); }
          float gv[4];
#pragma unroll
          for (int r = 0; r < 4; ++r) gv[r] = (4 * gq + r < ob) ? g[r] : -INFINITY;
          unsigned mask = 0u;
#pragma unroll
          for (int pass = 0; pass < 3; ++pass) { float bv = -INFINITY; int bn = 31;
#pragma unroll
              for (int r = 0; r < 4; ++r) { const int n = 4 * gq + r; if (!((mask >> n) & 1u) && gv[r] > bv) { bv = gv[r]; bn = n; } }
#pragma unroll
              for (int off = 16; off <= 32; off <<= 1) { const float ov = __shfl_xor(bv, off); const int on = __shfl_xor(bn, off); if (ov > bv || (ov == bv && on < bn)) { bv = ov; bn = on; } }
              if (bv > -INFINITY) mask |= 1u << bn; }
          S.mym[qi] = mask | (1u << ob); } }
    { unsigned wm = S.mym[0] | S.mym[1]; wm |= __shfl_xor(wm, 1); wm |= __shfl_xor(wm, 2); wm |= __shfl_xor(wm, 4); wm |= __shfl_xor(wm, 8); S.wm = __builtin_amdgcn_readfirstlane(wm); }
#pragma unroll
    for (int qi = 0; qi < 2; ++qi) { const bf16* kp = F.P() + (tq + qi * 16 + l15) * NPJ + C_MK + h * 128 + 8 * gq; float d = 0.f;
#pragma unroll
        for (int ks = 0; ks < 4; ++ks) { float kf[8], qf[8]; unpack8(*(const v4u*)(kp + 32 * ks), kf); unpack8(__builtin_bit_cast(v4u, S.Q[qi][ks]), qf);
#pragma unroll
            for (int e = 0; e < 8; ++e) d += kf[e] * qf[e]; }
        d += __shfl_xor(d, 16); d += __shfl_xor(d, 32); S.m_ref[qi] = d * S.scale2; }
    const int qrel0 = w * 32 + l15; S.qpos0 = ob * 256 + qrel0; S.qrel_hi = w * 32 + 31;
    S.cq[0] = S.slope2 * (float)S.qpos0; S.cq[1] = S.slope2 * (float)(S.qpos0 + 16);
#pragma unroll
    for (int e = 0; e < 8; ++e) S.kbias[e] = S.slope2 * (float)(8 * gq + e);
#pragma unroll
    for (int qi = 0; qi < 2; ++qi) { S.accl[qi] = (f32x4){0.f, 0.f, 0.f, 0.f};
#pragma unroll
        for (int v = 0; v < 8; ++v) S.acc[qi][v] = (f32x4){0.f, 0.f, 0.f, 0.f}; }
    { const short one = (l15 == 0) ? (short)0x3F80 : (short)0;
#pragma unroll
      for (int e = 0; e < 8; ++e) S.ones[e] = one; }
#pragma unroll
    for (int sub = 0; sub < 2; ++sub) { const int row = 8 * (l15 >> 2) + 4 * sub + (l15 & 3);
#pragma unroll
        for (int ks = 0; ks < 4; ++ks) S.kptr[sub][ks] = S.hb + 256 * row + 16 * ((4 * ks + gq) ^ swz(row)); }
    { const int q = l15 >> 2, pp = lane & 3;
#pragma unroll
      for (int t = 0; t < 2; ++t) { const int row = 8 * gq + 4 * t + q;
#pragma unroll
          for (int vt = 0; vt < 8; ++vt) S.vptr[t][vt] = S.hb + 16384 + 256 * row + 16 * ((2 * vt + (pp >> 1)) ^ swz(row)) + 8 * (pp & 1); } }
#pragma unroll
    for (int i = 0; i < 2; ++i) { const int row = 4 * (w * 2 + i) + (lane >> 4), c = (lane & 15) ^ swz(row); S.voff[i] = (unsigned)(row * NPJ + c * 8) * 2u; }
    S.gK = (const char*)(F.P() + (size_t)b * SEQ * NPJ + h * 128 + C_MK);
    const int NT = ob * 4 + 4;
    { float q2 = 0.f;
#pragma unroll
      for (int qi = 0; qi < 2; ++qi) { float ss = 0.f;
#pragma unroll
          for (int ks = 0; ks < 4; ++ks) { float qf[8]; unpack8(__builtin_bit_cast(v4u, S.Q[qi][ks]), qf);
#pragma unroll
              for (int e = 0; e < 8; ++e) ss += qf[e] * qf[e]; }
          ss += __shfl_xor(ss, 16); ss += __shfl_xor(ss, 32); q2 = fmaxf(q2, ss); }
      q2 = fmaxf(q2, __shfl_xor(q2, 1)); q2 = fmaxf(q2, __shfl_xor(q2, 2)); q2 = fmaxf(q2, __shfl_xor(q2, 4)); q2 = fmaxf(q2, __shfl_xor(q2, 8));
      const float qn = sqrtf(q2) * 1.01f, kown = sqrtf(F.KMX()[bh * 16 + ob]) * 1.01f, kj = sqrtf(F.KMX()[bh * 16 + l15]) * 1.01f;
      const float dist = (float)(ob * 256 + w * 32 - (256 * l15 + 255));
      const bool zero = (l15 < ob) && (qn * (kj + kown) * S.scale2 - S.slope2 * dist < -138.0f);
      const unsigned zmask = (unsigned)(__ballot(zero) & 0xFFFFull);
      S.wm &= ~zmask;
      const int lead = __builtin_ctz(~zmask);
      if (lane == 0) ((volatile LAS int*)(F.lds + LDSCTL_OFF + 512))[w] = lead; }
    __syncthreads();
    int T0;
    { volatile LAS int* le = (volatile LAS int*)(F.lds + LDSCTL_OFF + 512); int m = le[0];
#pragma unroll
      for (int k = 1; k < 8; ++k) m = min(m, le[k]);
      T0 = 4 * __builtin_amdgcn_readfirstlane(m); }
    moba_dma(S, T0, 0);
    VM_WAIT(); __syncthreads();
    for (int tt = T0; tt < NT; tt += 2) {
        moba_dma(S, tt + 1, 32768);
        moba_tile<0>(S, tt);
        VM_WAIT(); __syncthreads();
        if (tt + 2 < NT) moba_dma(S, tt + 2, 0);
        moba_tile<32768>(S, tt + 1);
        VM_WAIT(); __syncthreads();
    }
#pragma unroll
    for (int qi = 0; qi < 2; ++qi) { const float lt = __shfl(S.accl[qi][0], l15); const float inv = 1.0f / lt; const size_t ti = tq + qi * 16 + l15;
        const bf16* Gp = F.P() + ti * NPJ + C_MG + h * 128; bf16* Yp = F.Y() + ti * DM + 1024 + h * 128;
#pragma unroll
        for (int vt = 0; vt < 8; ++vt) { const int v = 16 * vt + 4 * gq; const v2u gv = *(const v2u*)(Gp + v);
            const float y0 = S.acc[qi][vt][0] * inv * silu(bf_lo(gv.x)), y1 = S.acc[qi][vt][1] * inv * silu(bf_hi(gv.x)), y2 = S.acc[qi][vt][2] * inv * silu(bf_lo(gv.y)), y3 = S.acc[qi][vt][3] * inv * silu(bf_hi(gv.y));
            v2u o; o.x = pkbf(y0, y1); o.y = pkbf(y2, y3); *(v2u*)(Yp + v) = o; } }
}

DI void ssd_A(Frame& F, int l, int unit) {
    const int grp = unit & 3, bc = unit >> 2, c = bc & 15, b = bc >> 4, tid = F.tid(), lane = F.lane(), w = F.wave(), gq = lane >> 4;
    const size_t t0 = (size_t)b * SEQ + c * 256;
    LAS float* dtl = (LAS float*)F.lds; LAS float* dacs = dtl + 1024; LAS float* fac = dtl + 2048;
    LAS unsigned char* Bt = F.lds + 12288; LAS unsigned char* XWt = Bt + 64 * SB128;
    __syncthreads();
    for (int idx = tid; idx < 1024; idx += NTHR) { const int r = idx >> 8, t = idx & 255, head = 4 * grp + r;
        const float raw = F.DTRAW()[(t0 + t) * 16 + head] + F.in(6)[l * 16 + head]; const float dt = softplus(raw), a = -__expf(F.in(7)[l * 16 + head]);
        dtl[idx] = dt; dacs[idx] = dt * a; }
    __syncthreads();
    if (w < 4) { float x0 = dacs[w * 256 + 4 * lane], x1 = dacs[w * 256 + 4 * lane + 1], x2 = dacs[w * 256 + 4 * lane + 2], x3 = dacs[w * 256 + 4 * lane + 3];
        x1 += x0; x2 += x1; x3 += x2; float tot = x3;
#pragma unroll
        for (int o = 1; o < 64; o <<= 1) { const float y = __shfl_up(tot, o); if (lane >= o) tot += y; }
        const float ex = tot - x3;
        dacs[w * 256 + 4 * lane] = x0 + ex; dacs[w * 256 + 4 * lane + 1] = x1 + ex; dacs[w * 256 + 4 * lane + 2] = x2 + ex; dacs[w * 256 + 4 * lane + 3] = x3 + ex; }
    __syncthreads();
    for (int idx = tid; idx < 1024; idx += NTHR) { const int r = idx >> 8, t = idx & 255, head = 4 * grp + r; const float dc = dacs[idx], dt = dtl[idx];
        fac[idx] = __expf(dacs[r * 256 + 255] - dc) * dt; F.DT()[(t0 + t) * 16 + head] = dt; F.DACS()[(t0 + t) * 16 + head] = dc * 1.4426950408889634f; }
    f32x4 acc[16];
#pragma unroll
    for (int v = 0; v < 16; ++v) acc[v] = (f32x4){0.f, 0.f, 0.f, 0.f};
    const int cc = tid & 63, tg = tid >> 6;
    const int chn = cc < 32 ? grp * 256 + cc * 8 : (cc < 48 ? 1024 + grp * 128 + (cc - 32) * 8 : 1536 + grp * 128 + (cc - 48) * 8);
    float cw[4][8], cb[8];
#pragma unroll
    for (int k = 0; k < 4; ++k) { const f32x4 a = *(const f32x4*)(F.in(4) + ((size_t)l * 4 + k) * 2048 + chn), bq = *(const f32x4*)(F.in(4) + ((size_t)l * 4 + k) * 2048 + chn + 4);
        cw[k][0] = a[0]; cw[k][1] = a[1]; cw[k][2] = a[2]; cw[k][3] = a[3]; cw[k][4] = bq[0]; cw[k][5] = bq[1]; cw[k][6] = bq[2]; cw[k][7] = bq[3]; }
    { const f32x4 a = *(const f32x4*)(F.in(5) + (size_t)l * 2048 + chn), bq = *(const f32x4*)(F.in(5) + (size_t)l * 2048 + chn + 4);
      cb[0] = a[0]; cb[1] = a[1]; cb[2] = a[2]; cb[3] = a[3]; cb[4] = bq[0]; cb[5] = bq[1]; cb[6] = bq[2]; cb[7] = bq[3]; }
    const bf16* Xp = F.P() + t0 * NPJ + C_SX + chn;
    for (int jt = 0; jt < 4; ++jt) {
        __syncthreads();
        { const int tl0 = jt * 64 + tg * 8; float h0[8], h1[8], h2[8];
          { const bool z = (c == 0 && tl0 < 3);
            if (z) {
#pragma unroll
                for (int e = 0; e < 8; ++e) { h0[e] = 0.f; h1[e] = 0.f; h2[e] = 0.f; }
            } else { unpack8(*(const v4u*)(Xp + ((long)tl0 - 3) * NPJ), h0); unpack8(*(const v4u*)(Xp + ((long)tl0 - 2) * NPJ), h1); unpack8(*(const v4u*)(Xp + ((long)tl0 - 1) * NPJ), h2); } }
          v4u xraw[8];
#pragma unroll
          for (int i = 0; i < 8; ++i) xraw[i] = *(const v4u*)(Xp + (size_t)(tl0 + i) * NPJ);
#pragma unroll
          for (int i = 0; i < 8; ++i) { const int tl = tl0 + i; float x[8], y[8]; unpack8(xraw[i], x);
#pragma unroll
              for (int e = 0; e < 8; ++e) { const float v = cb[e] + cw[0][e] * h0[e] + cw[1][e] * h1[e] + cw[2][e] * h2[e] + cw[3][e] * x[e]; y[e] = silu(v); h0[e] = h1[e]; h1[e] = h2[e]; h2[e] = x[e]; }
              *(v4u*)(F.XBC() + (t0 + tl) * 2048 + chn) = pack8(y);
              if (cc < 32) { const float f = fac[(cc >> 3) * 256 + tl];
#pragma unroll
                  for (int e = 0; e < 8; ++e) y[e] *= f;
                  *(LAS v4u*)(XWt + (tg * 8 + i) * SB256 + cc * 16) = pack8(y); }
              else if (cc < 48) *(LAS v4u*)(Bt + (tg * 8 + i) * SB128 + (cc - 32) * 16) = pack8(y); } }
        __syncthreads();
#pragma unroll
        for (int ks = 0; ks < 2; ++ks) { const int ra = 32 * ks + 8 * gq, rb = ra + 4; const bf16x8 A = frag_tr(Bt, SB128, ra, rb, 16 * w, lane);
#pragma unroll
            for (int pt = 0; pt < 16; ++pt) acc[pt] = mfma16(A, frag_tr(XWt, SB256, ra, rb, 16 * pt, lane), acc[pt]); }
    }
#pragma unroll
    for (int pt = 0; pt < 16; ++pt) { const int head = 4 * grp + (pt >> 2); float* S = F.SST() + ((size_t)bc * 16 + head) * 8192;
        *(f32x4*)(S + ((pt & 3) * 16 + (lane & 15)) * 128 + 16 * w + 4 * gq) = acc[pt]; }
}
DI void ssd_B(Frame& F) {
    for (int it = blockIdx.x * NTHR + F.tid(); it < 32 * 2048; it += F.G() * NTHR) { const int e4 = it & 2047, bhd = it >> 11, head = bhd & 15, b = bhd >> 4; f32x4 s = (f32x4){0.f, 0.f, 0.f, 0.f};
        const size_t o0 = ((size_t)(b * 16) * 16 + head) * 8192 + (size_t)e4 * 4; const float* __restrict__ st = F.SST() + o0; bf16* __restrict__ hp = F.SHP() + o0;
        f32x4 u[15]; float dec[15];
#pragma unroll
        for (int c = 0; c < 15; ++c) { u[c] = *(const f32x4*)(st + (size_t)c * 16 * 8192); dec[c] = F.DACS()[((size_t)b * SEQ + c * 256 + 255) * 16 + head]; }
#pragma unroll
        for (int c = 0; c < 16; ++c) { *(unsigned long long*)(hp + (size_t)c * 16 * 8192) = (unsigned long long)pkbf(s[0], s[1]) | ((unsigned long long)pkbf(s[2], s[3]) << 32);
            if (c < 15) s = s * __builtin_amdgcn_exp2f(dec[c]) + u[c]; } }
}
template <int NROWS> DI void dma_rows128(const bf16* src, size_t gp, LAS unsigned char* dst, int w, int lane) {
#pragma unroll
    for (int i = 0; i < NROWS / 32; ++i) { const int idx = w * (NROWS / 32) + i, row = 4 * idx + (lane >> 4), c = (lane & 15) ^ swz(row);
        __builtin_amdgcn_global_load_lds((const unsigned*)(src + (size_t)row * gp + c * 8), (LAS unsigned*)(dst + idx * 1024), 16, 0, 0); }
}
DI bf16x8 frag_row_sw256(const LAS unsigned char* t, int row, int ch) { return *(const LAS bf16x8*)(t + 256 * row + 16 * (ch ^ swz(row))); }
constexpr int SC_B = 0, SC_X = 16384, SC_DA = 49152, SC_DT = 50176;
DI void ssd_dma_tile(Frame& F, size_t trow, int grp, LAS unsigned char* buf, int w, int lane) {
    dma_rows128<64>(F.XBC() + trow * 2048 + 1024 + grp * 128, 2048, buf + SC_B, w, lane);
    dma_tile256(F.XBC() + trow * 2048 + grp * 256, 2048, buf + SC_X, w, lane);
    if (w == 0) __builtin_amdgcn_global_load_lds((const unsigned*)(F.DACS() + (trow + lane) * 16 + 4 * grp), (LAS unsigned*)(buf + SC_DA), 16, 0, 0);
    if (w == 1) __builtin_amdgcn_global_load_lds((const unsigned*)(F.DT() + (trow + lane) * 16 + 4 * grp), (LAS unsigned*)(buf + SC_DT), 16, 0, 0);
}
DI void ssd_C(Frame& F, int l, int unit2) {
    const int half = unit2 & 1, unit = unit2 >> 1, grp = unit & 3, bc = unit >> 2, c = bc & 15, b = bc >> 4, lane = F.lane(), w = F.wave(), gq = lane >> 4, l15 = lane & 15;
    const size_t t0 = (size_t)b * SEQ + c * 256; const int il = half * 128 + w * 16 + l15; const size_t ti = t0 + il;
    LAS unsigned char* B0 = F.lds; LAS unsigned char* B1 = F.lds + 65536;
    if (c > 0) dma_rows128<256>(F.SHP() + ((size_t)bc * 16 + 4 * grp) * 8192, 128, B0, w, lane); else ssd_dma_tile(F, t0, grp, B0, w, lane);
    bf16x8 Cf[4];
#pragma unroll
    for (int ks = 0; ks < 4; ++ks) Cf[ks] = *(const bf16x8*)(F.XBC() + ti * 2048 + 1536 + grp * 128 + 32 * ks + 8 * gq);
    f32x4 acc[4][4]; float dci[4];
    { const f32x4 d4 = *(const f32x4*)(F.DACS() + ti * 16 + 4 * grp); dci[0] = d4[0]; dci[1] = d4[1]; dci[2] = d4[2]; dci[3] = d4[3]; }
#pragma unroll
    for (int r = 0; r < 4; ++r)
#pragma unroll
        for (int pt = 0; pt < 4; ++pt) acc[r][pt] = (f32x4){0.f, 0.f, 0.f, 0.f};
    const int njt = 2 * (half + 1);
    VM_WAIT(); __syncthreads();
    int par = 0;
    if (c > 0) {
        ssd_dma_tile(F, t0, grp, B1, w, lane);
#pragma unroll
        for (int r = 0; r < 4; ++r) {
#pragma unroll
            for (int ks = 0; ks < 4; ++ks)
#pragma unroll
                for (int pt = 0; pt < 4; ++pt) acc[r][pt] = mfma16(frag_row_sw256(B0, r * 64 + 16 * pt + l15, 4 * ks + gq), Cf[ks], acc[r][pt]);
            const float ed = __builtin_amdgcn_exp2f(dci[r]);
#pragma unroll
            for (int pt = 0; pt < 4; ++pt) acc[r][pt] *= ed; }
        VM_WAIT(); __syncthreads();
        par = 1;
    }
    for (int jt = 0; jt < njt; ++jt) {
        LAS unsigned char* cur = ((jt + par) & 1) ? B1 : B0; LAS unsigned char* nxt = ((jt + par) & 1) ? B0 : B1;
        if (jt + 1 < njt) ssd_dma_tile(F, t0 + 64 * (jt + 1), grp, nxt, w, lane);
        if (64 * jt <= half * 128 + w * 16 + 15) {
            int lz = lane; asm volatile("" : "+v"(lz));
            const int gq = lz >> 4, l15 = lz & 15, lane = lz;
            const bool diag = 64 * jt + 63 > half * 128 + w * 16;
#pragma unroll
            for (int js = 0; js < 2; ++js) {
                f32x4 s0 = (f32x4){0.f, 0.f, 0.f, 0.f}, s1 = s0, s0b = s0, s1b = s0;
                const int kr0 = 32 * js + 8 * (l15 >> 2) + (l15 & 3), kr1 = kr0 + 4;
#pragma unroll
                for (int ks = 0; ks < 4; ks += 2) { s0 = mfma16(frag_row_sw256(cur + SC_B, kr0, 4 * ks + gq), Cf[ks], s0); s1 = mfma16(frag_row_sw256(cur + SC_B, kr1, 4 * ks + gq), Cf[ks], s1);
                    s0b = mfma16(frag_row_sw256(cur + SC_B, kr0, 4 * ks + 4 + gq), Cf[ks + 1], s0b); s1b = mfma16(frag_row_sw256(cur + SC_B, kr1, 4 * ks + 4 + gq), Cf[ks + 1], s1b); }
                s0 += s0b; s1 += s1b;
                float p[4][8];
#pragma unroll
                for (int e = 0; e < 8; ++e) { const int j = 64 * jt + 32 * js + 8 * gq + e; const float sv = (e < 4) ? s0[e & 3] : s1[e & 3];
                    const f32x4 dj = *(const LAS f32x4*)(cur + SC_DA + (32 * js + 8 * gq + e) * 16), dtj = *(const LAS f32x4*)(cur + SC_DT + (32 * js + 8 * gq + e) * 16);
#pragma unroll
                    for (int r = 0; r < 4; ++r) { float ex = dci[r] - dj[r]; if (diag) ex = (il >= j) ? ex : -INFINITY; p[r][e] = sv * __builtin_amdgcn_exp2f(ex) * dtj[r]; } }
#pragma unroll
                for (int r = 0; r < 4; ++r) { const bf16x8 Pf = pack8f(p[r]);
#pragma unroll
                    for (int pt = 0; pt < 4; ++pt) acc[r][pt] = mfma16(frag_tr_sw512(cur + SC_X, 32 * js + 8 * gq, 32 * js + 8 * gq + 4, r * 64 + 16 * pt, lane), Pf, acc[r][pt]); }
            }
        }
        VM_WAIT(); __syncthreads();
    }
    float ss = 0.f;
    const bf16* xb = F.XBC() + ti * 2048 + grp * 256 + 4 * gq; const bf16* zb = F.P() + ti * NPJ + C_SZ + grp * 256 + 4 * gq;
#pragma unroll
    for (int r = 0; r < 4; ++r) { const float dsk = F.in(8)[l * 16 + 4 * grp + r];
#pragma unroll
        for (int pt = 0; pt < 4; ++pt) { const v2u xv = *(const v2u*)(xb + r * 64 + 16 * pt), zv = *(const v2u*)(zb + r * 64 + 16 * pt);
            f32x4 y = acc[r][pt]; y[0] = (y[0] + dsk * bf_lo(xv.x)) * silu(bf_lo(zv.x)); y[1] = (y[1] + dsk * bf_hi(xv.x)) * silu(bf_hi(zv.x)); y[2] = (y[2] + dsk * bf_lo(xv.y)) * silu(bf_lo(zv.y)); y[3] = (y[3] + dsk * bf_hi(xv.y)) * silu(bf_hi(zv.y));
            acc[r][pt] = y; ss += (y[0] * y[0] + y[1] * y[1]) + (y[2] * y[2] + y[3] * y[3]); }
        asm volatile("" ::: "memory"); }
    ss += __shfl_xor(ss, 16); ss += __shfl_xor(ss, 32);
    const float rms = rsqrtf(ss * (1.0f / 256.0f) + EPS);
    const float* nw = F.in(9) + (size_t)l * 1024 + grp * 256 + 4 * gq; bf16* yb = F.Y() + ti * DM + 2048 + grp * 256 + 4 * gq;
#pragma unroll
    for (int r = 0; r < 4; ++r)
#pragma unroll
        for (int pt = 0; pt < 4; ++pt) { const f32x4 w4 = *(const f32x4*)(nw + r * 64 + 16 * pt); const f32x4 y = acc[r][pt] * rms * w4;
            v2u o; o.x = pkbf(y[0], y[1]); o.y = pkbf(y[2], y[3]); *(v2u*)(yb + r * 64 + 16 * pt) = o; }
}

DI void lru_A(Frame& F, int l, int unit) {
    const int nb = unit & 7, bc = unit >> 3, c256 = bc & 15, b = bc >> 4, tid = F.tid(), lane = F.lane(), w = F.wave(), gq = lane >> 4;
    const int chn0 = nb * 128;
    LAS float* xcf = (LAS float*)F.lds; LAS float* al = xcf + 8192; LAS unsigned char* xcb = F.lds + 65536;
    LAS float* sh = (LAS float*)(F.lds + 65536 + 64 * SB128); LAS float* sa = sh + 512;
    const int ch8 = tid & 15, tg = tid >> 4, chn = chn0 + ch8 * 8, tl0 = tg * 2; float cw[4][8], cb[8];
#pragma unroll
    for (int k = 0; k < 4; ++k) { const f32x4 a = *(const f32x4*)(F.in(10) + ((size_t)l * 4 + k) * 1024 + chn), bq = *(const f32x4*)(F.in(10) + ((size_t)l * 4 + k) * 1024 + chn + 4);
        cw[k][0] = a[0]; cw[k][1] = a[1]; cw[k][2] = a[2]; cw[k][3] = a[3]; cw[k][4] = bq[0]; cw[k][5] = bq[1]; cw[k][6] = bq[2]; cw[k][7] = bq[3]; }
    { const f32x4 a = *(const f32x4*)(F.in(11) + (size_t)l * 1024 + chn), bq = *(const f32x4*)(F.in(11) + (size_t)l * 1024 + chn + 4);
      cb[0] = a[0]; cb[1] = a[1]; cb[2] = a[2]; cb[3] = a[3]; cb[4] = bq[0]; cb[5] = bq[1]; cb[6] = bq[2]; cb[7] = bq[3]; }
    const int eg = 16 * w + (lane & 15), chg = chn0 + eg;
    bf16x8 Ba[4], Bx[4];
    { const bf16* WTa = F.LRUW() + ((((size_t)l * 2 + 0) * 8 + nb) * 128 + eg) * 128; const bf16* WTx = F.LRUW() + ((((size_t)l * 2 + 1) * 8 + nb) * 128 + eg) * 128;
#pragma unroll
      for (int ks = 0; ks < 4; ++ks) { Ba[ks] = *(const bf16x8*)(WTa + 32 * ks + 8 * gq); Bx[ks] = *(const bf16x8*)(WTx + 32 * ks + 8 * gq); } }
    const float ba = F.in(13)[l * 1024 + chg], bx = F.in(15)[l * 1024 + chg], spl = softplus(-F.in(16)[l * 1024 + chg]);
    const size_t tu = (size_t)b * SEQ + c256 * 256;
    const bf16* Xp0 = F.P() + tu * NPJ + C_LX + chn;
    v4u raw[5];
#pragma unroll
    for (int k = 0; k < 5; ++k) { const int tl = tl0 - 3 + k; raw[k] = (c256 == 0 && tl < 0) ? (v4u){0u, 0u, 0u, 0u} : *(const v4u*)(Xp0 + (long)tl * NPJ); }
    for (int sc = 0; sc < 4; ++sc) {
        const int cc = c256 * 4 + sc, bcc = b * 64 + cc; const size_t t0 = tu + sc * 64;
        float xr[5][8];
#pragma unroll
        for (int k = 0; k < 5; ++k) unpack8(raw[k], xr[k]);
        if (sc < 3) {
#pragma unroll
            for (int k = 0; k < 5; ++k) raw[k] = *(const v4u*)(Xp0 + (long)((sc + 1) * 64 + tl0 - 3 + k) * NPJ); }
        WG_BAR_LDS();
#pragma unroll
        for (int i = 0; i < 2; ++i) { float y[8];
#pragma unroll
            for (int e = 0; e < 8; ++e) y[e] = cb[e] + cw[0][e] * xr[i][e] + cw[1][e] * xr[i + 1][e] + cw[2][e] * xr[i + 2][e] + cw[3][e] * xr[i + 3][e];
            *(LAS f32x4*)(xcf + (tl0 + i) * 128 + ch8 * 8) = (f32x4){y[0], y[1], y[2], y[3]}; *(LAS f32x4*)(xcf + (tl0 + i) * 128 + ch8 * 8 + 4) = (f32x4){y[4], y[5], y[6], y[7]};
            *(LAS v4u*)(xcb + (tl0 + i) * SB128 + ch8 * 16) = pack8(y); }
        WG_BAR_LDS();
#pragma unroll
        for (int mt = 0; mt < 4; ++mt) { f32x4 ra = (f32x4){0.f, 0.f, 0.f, 0.f}, rx = ra;
#pragma unroll
            for (int ks = 0; ks < 4; ++ks) { const bf16x8 A = frag_row(xcb, SB128, 16 * mt, 32 * ks, lane); ra = mfma16(A, Ba[ks], ra); rx = mfma16(A, Bx[ks], rx); }
#pragma unroll
            for (int reg = 0; reg < 4; ++reg) { const int t = 16 * mt + 4 * gq + reg; const float r_ = sigm(ra[reg] + ba), i_ = sigm(rx[reg] + bx), la = -8.0f * r_ * spl;
                const float a = __expf(la), u = __builtin_amdgcn_sqrtf(one_minus_exp(2.0f * la)) * i_ * xcf[t * 128 + eg]; al[t * 128 + eg] = a; xcf[t * 128 + eg] = u; } }
        WG_BAR_LDS();
        { const int e = tid & 127, seg = tid >> 7, ch = chn0 + e; float hv[16], av[16]; float hh = 0.f, ap = 1.f;
#pragma unroll
          for (int t = 0; t < 16; ++t) { const float a = al[(seg * 16 + t) * 128 + e], u = xcf[(seg * 16 + t) * 128 + e]; hh = a * hh + u; ap *= a; hv[t] = hh; av[t] = ap; }
          sh[seg * 128 + e] = hh; sa[seg * 128 + e] = ap;
          WG_BAR_LDS();
          float cin = 0.f, ain = 1.f;
#pragma unroll
          for (int k = 0; k < 3; ++k) if (k < seg) { cin = sa[k * 128 + e] * cin + sh[k * 128 + e]; ain *= sa[k * 128 + e]; }
#pragma unroll
          for (int t = 0; t < 16; ++t) { const size_t o = (t0 + seg * 16 + t) * 1024 + ch; F.HLOC()[o] = (bf16)f2bf(hv[t] + av[t] * cin); F.ACUM()[o] = (bf16)f2bf(av[t] * ain); }
          if (seg == 3) { F.HEND()[(size_t)bcc * 1024 + ch] = hv[15] + av[15] * cin; F.AEND()[(size_t)bcc * 1024 + ch] = av[15] * ain; } }
    }
}
DI void lru_B(Frame& F) {
    for (int it = blockIdx.x * NTHR + F.tid(); it < 2048; it += F.G() * NTHR) { const int ch = it & 1023, b = it >> 10; float carry = 0.f;
        const float* __restrict__ ae = F.AEND() + (size_t)(b * 64) * 1024 + ch; const float* __restrict__ he = F.HEND() + (size_t)(b * 64) * 1024 + ch; float* __restrict__ cr = F.CARRY() + (size_t)(b * 64) * 1024 + ch;
        float a[64], hh[64];
#pragma unroll
        for (int k = 0; k < 64; ++k) { a[k] = ae[(size_t)k * 1024]; hh[k] = he[(size_t)k * 1024]; }
#pragma unroll
        for (int k = 0; k < 64; ++k) { cr[(size_t)k * 1024] = carry; carry = a[k] * carry + hh[k]; } }
}
DI void lru_C(Frame& F, int unit) {
    const size_t tb = (size_t)unit * 32;
#pragma unroll 4
    for (int idx = F.tid(); idx < 32 * 128; idx += NTHR) { const size_t t = tb + (idx >> 7); const int ch = (idx & 127) * 8; const int b = (int)(t / SEQ), cc = (int)(t % SEQ) >> 6;
        const float* cr = F.CARRY() + (size_t)(b * 64 + cc) * 1024 + ch;
        float hl[8], ac[8], g[8]; unpack8(*(const v4u*)(F.HLOC() + t * 1024 + ch), hl); unpack8(*(const v4u*)(F.ACUM() + t * 1024 + ch), ac); unpack8(*(const v4u*)(F.P() + t * NPJ + C_LG + ch), g);
        const f32x4 c0 = *(const f32x4*)cr, c1 = *(const f32x4*)(cr + 4);
        float y[8];
#pragma unroll
        for (int e = 0; e < 8; ++e) { const float cv = e < 4 ? c0[e & 3] : c1[e & 3]; y[e] = (hl[e] + ac[e] * cv) * silu(g[e]); }
        *(v4u*)(F.Y() + t * DM + 3072 + ch) = pack8(y); }
}

__global__ void __launch_bounds__(NTHR, 2) hymba_fwd(Args args) {
    extern __shared__ __attribute__((aligned(16))) unsigned char lds[];
    Frame F = mk_frame((LAS unsigned char*)lds, &args);
    for (int u = F.tid(); u < (LDS_BYTES - LDSCTL_OFF) / 4; u += NTHR) ((LAS unsigned*)(F.lds + LDSCTL_OFF))[u] = 0u;
    __syncthreads();
    const int lo = args.ph_lo, hi = args.ph_hi;
    XcdBarrier bar; bar.bar = F.ctl() + CW_BAR; bar.x = 0; bar.st = nullptr;
    if (hi - lo > 1) bar = xcd_barrier_post(F.ctl() + CW_BAR, F.MISC() + 8);
#define IN(k) (lo <= (k) && (k) < hi)
#define SEAM(k) do { if (IN(k) && IN((k) + 1)) xcd_barrier(bar); } while (0)

    if (IN(0)) { p0_prologue(F);
#ifdef PROBE_PRO2
        xcd_barrier(bar); p0_prologue(F);
#endif
        SEAM(0); }
    for (int l = 0; l < DEPTH; ++l) {
        const int pb = 1 + 5 * l;
        if (IN(pb)) { F = mk_frame((LAS unsigned char*)lds, &args);
            pg8::Gemm g{F.XB(), F.WIN() + (size_t)l * NPJ * DM, MTOK, 12288, DM}; pg8::RemapOrder S; S.init(MTOK, 12288, F.G(), (int)blockIdx.x);
            pg8::Unit u0; S.next(0, u0); const int fm = u0.pm & ~7; LAS float* rtab = (LAS float*)(F.lds + LDSCTL_OFF + 1024);
            { const float* sq = F.SSQ() + (size_t)fm * 256 * 16;
              for (int r = F.tid(); r < 2048; r += NTHR) { const f32x4* p = (const f32x4*)(sq + (size_t)r * 16); const f32x4 a = p[0], b4 = p[1], c4 = p[2], d4 = p[3];
                  const float ssum = ((a[0] + a[1]) + (a[2] + a[3])) + ((b4[0] + b4[1]) + (b4[2] + b4[3])) + ((c4[0] + c4[1]) + (c4[2] + c4[3])) + ((d4[0] + d4[1]) + (d4[2] + d4[3]));
                  rtab[r] = rsqrtf(ssum * (1.0f / 4096.0f) + EPS); }
              __syncthreads(); }
            pg8::EpiProj E{F.P(), F.DTRAW(), F.SSQ(), rtab, fm};
#ifdef PROBE_IN2
            for (int rep2 = 0; rep2 < 2; ++rep2) { pg8::gemm_phase<pg8::EpiProj, pg8::RemapOrder, true, true>(F.lds, g, S, E); if (rep2 == 0) xcd_barrier(bar); }
#else
            pg8::gemm_phase<pg8::EpiProj, pg8::RemapOrder, true, true>(F.lds, g, S, E);
#endif
            SEAM(pb);
        }
#ifdef PROBE_MIX2
        for (int rep = 0; rep < 2; ++rep) {
#else
        { constexpr int rep = 0;
#endif
        if (IN(pb + 1)) { F = mk_frame((LAS unsigned char*)lds, &args);
#ifndef NO_STAGE_A
            for (int u = (int)blockIdx.x;; u = F.G() + next_unit(F, l * 4 + 0 + 2 * rep)) { F = mk_frame((LAS unsigned char*)lds, &args);
                if (u < 160) { const int t = u >> 5; pg8::Gemm g{F.XB(), F.WIN() + (size_t)l * NPJ * DM, MTOK, NPJ, DM}; pg8::OneUnit S1{u & 31, t == 0 ? 35 : 47 + t}; pg8::EpiProj E{F.P(), F.DTRAW(), F.SSQ(), nullptr, 0};
                    pg8::gemm_phase<pg8::EpiProj, pg8::OneUnit, true, true>(F.lds, g, S1, E); }
                else if (u < 288) ssd_A(F, l, u - 160);
                else {
                    const int v = u - 288; int kind, idx;
                    if (v < 1920) { const int g = v / 3, r = v - 3 * g; if (r == 0) { kind = 0; idx = g; } else { kind = 1; idx = 2 * g + r - 1; } }
                    else { kind = 1; idx = 1280 + (v - 1920); }
                    if (kind == 0) { if (idx < 256) lru_A(F, l, idx); else if (idx < 384) ret_A(F, idx - 256); else moba_kmean(F, idx - 384); }
                    else { if (idx < 512) tr_unit(F, l, TR_I_IN + 2 * idx, 2); else if (idx < 1352 && l + 1 < DEPTH) tr_unit(F, l + 1, 2 * (idx - 512), 2); else if (idx >= 1352) break; } } }
#endif
            SEAM(pb + 1);
        }
        if (IN(pb + 2)) { F = mk_frame((LAS unsigned char*)lds, &args);
#ifndef NO_STAGE_B
            ret_B(F); ssd_B(F); lru_B(F);
#endif
            SEAM(pb + 2);
        }
        if (IN(pb + 3)) { F = mk_frame((LAS unsigned char*)lds, &args);
#ifndef NO_STAGE_C
            for (int u = (int)blockIdx.x;; u = F.G() + next_unit(F, l * 4 + 1 + 2 * rep)) { F = mk_frame((LAS unsigned char*)lds, &args);
                if (u < 256) moba_attn(F, 15 - (u >> 4), u & 15);
                else if (u < 512) ret_C(F, l, u - 256);
                else if (u < 768) ssd_C(F, l, u - 512);
                else if (u < 1024) lru_C(F, u - 768);
                else if (u < 1024 + 840 && l + 1 < DEPTH) tr_unit(F, l + 1, 1680 + 2 * (u - 1024), 2);
                else break; }
#endif
            SEAM(pb + 3);
        }
        }
        if (IN(pb + 4)) { F = mk_frame((LAS unsigned char*)lds, &args);
            pg8::Gemm g{F.Y(), F.WOUT() + (size_t)l * DM * DM, MTOK, DM, DM}; pg8::StaticOrder S; S.init(MTOK, DM, F.G(), (int)blockIdx.x);
            pg8::EpiOut E{F.XB(), F.SSQ(), (LAS float*)(F.lds + LDSCTL_OFF + 1024)};
            pg8::gemm_phase<pg8::EpiOut, pg8::StaticOrder, true, true>(F.lds, g, S, E);
            SEAM(pb + 4);
        }
    }
    if (IN(NPHASE - 1)) { F = mk_frame((LAS unsigned char*)lds, &args); p_final(F); }
#undef IN
#undef SEAM
}

#ifndef MK_ONE_LAUNCH
#define MK_ONE_LAUNCH 1
#endif
extern "C" void kernel_launch(void* const* d_in, const int* in_sizes, int n_in, void* d_out, int out_size, void* d_ws, size_t ws_size, hipStream_t stream) {
    static int grid = 0;
    if (grid == 0) {
        if (n_in != 19 || out_size != MTOK * DM || ws_size < WS_END) { fprintf(stderr, "kernel_launch: unexpected shapes (n_in %d, out %d, ws %zu)\n", n_in, out_size, ws_size); grid = -1; return; }
        int dev = 0, cus = 0, per_cu = 0;
        if (hipGetDevice(&dev) != hipSuccess || hipDeviceGetAttribute(&cus, hipDeviceAttributeMultiprocessorCount, dev) != hipSuccess) { grid = -1; return; }
        if (hipFuncSetAttribute((const void*)hymba_fwd, hipFuncAttributeMaxDynamicSharedMemorySize, LDS_BYTES) != hipSuccess) { fprintf(stderr, "kernel_launch: hipFuncSetAttribute failed\n"); grid = -1; return; }
        if (hipOccupancyMaxActiveBlocksPerMultiprocessor(&per_cu, (const void*)hymba_fwd, NTHR, LDS_BYTES) != hipSuccess || per_cu < 1) { fprintf(stderr, "kernel_launch: occupancy query says %d\n", per_cu); }
        (void)hipGetLastError();
        grid = cus;
    }
    if (grid < 0) return;
    (void)hipMemsetAsync((char*)d_ws + WS_CTL, 0, CTL_ZERO_BYTES, stream);
    Args a{};
    for (int i = 0; i < 19; ++i) a.in[i] = (const float*)d_in[i];
    a.out = (float*)d_out; a.ws = (unsigned char*)d_ws;
#if MK_ONE_LAUNCH
    a.ph_lo = 0; a.ph_hi = NPHASE;
    hipLaunchKernelGGL(hymba_fwd, dim3(grid), dim3(NTHR), LDS_BYTES, stream, a);
#else
    for (int p = 0; p < NPHASE; ++p) { a.ph_lo = p; a.ph_hi = p + 1; hipLaunchKernelGGL(hymba_fwd, dim3(grid), dim3(NTHR), LDS_BYTES, stream, a); }
#endif
}
```

```cpp
#include <hip/hip_runtime.h>
#include <cstdio>
#include <cstdint>
#include <cmath>
namespace pg8 {
#define PG8_LAS __attribute__((address_space(3)))
typedef unsigned short bf16_t;
typedef short bf16x8 __attribute__((ext_vector_type(8)));
typedef float f32x4 __attribute__((ext_vector_type(4)));
typedef unsigned u32x4 __attribute__((ext_vector_type(4)));
constexpr int BM = 256, BK = 64, HALF = 128, HTB = HALF * BK * 2  , STAGE_BYTES = 8 * HTB, NXCD = 8, WGM = 8;

__host__ __device__ __forceinline__ int lds_byte(int r, int c) { const int st = (r >> 4) * 2 + (c >> 5), rr = r & 15, cc = c & 31, ob = rr * 64 + cc * 2; return st * 1024 + (ob ^ (((ob >> 9) & 1) << 5)); }
__host__ __device__ __forceinline__ void stage_rc(int b, int& R, int& C) { const int st = b / 1024, sb = b % 1024, swz = sb ^ (((sb >> 9) & 1) << 5); R = (st >> 1) * 16 + swz / 64; C = (st & 1) * 32 + (swz % 64) / 2; }
__host__ __device__ __forceinline__ int perm32(int rho) { const int n = rho >> 4, i = rho & 15; return 8 * (i >> 2) + 4 * n + (i & 3); }

struct Unit { int pm, pn; };
struct Gemm { const bf16_t* A; const bf16_t* Bt; int M, N, K; };

struct StaticOrder {
    int nM, nN, nwg, G, c;
    __host__ __device__ void init(int M, int N, int G_, int c_) { nM = M / BM; nN = N / BM; nwg = nM * nN; G = G_; c = c_; }
    __host__ __device__ bool next(int i, Unit& u) const {
        const long L = (long)i * G + c; if (L >= nwg) return false;
        int wgid = (int)L; { const int q = nwg / NXCD, r = nwg % NXCD, xcd = wgid % NXCD, off = wgid / NXCD; wgid = (xcd < r ? xcd * (q + 1) : r * (q + 1) + (xcd - r) * q) + off; }
        const int nig = WGM * nN, gid = wgid / nig, fm = gid * WGM, gsz = (nM - fm) < WGM ? (nM - fm) : WGM;
        u.pm = fm + ((wgid % nig) % gsz); u.pn = (wgid % nig) / gsz; return true;
    }
    __device__ __forceinline__ void a_ready(const Unit&) const {}
    __device__ __forceinline__ void done(const Unit&) const {}
};

__device__ __forceinline__ unsigned cvt_pk_bf16(float lo, float hi) { unsigned r; asm volatile("v_cvt_pk_bf16_f32 %0, %1, %2" : "=v"(r) : "v"(lo), "v"(hi)); return r; }
typedef float f32x2 __attribute__((ext_vector_type(2)));
template <class Epi, class Sched, bool ALIGN_EPI = false, bool SP2 = false>
__device__ __forceinline__ void gemm_phase(PG8_LAS unsigned char* lds, const Gemm g, const Sched& S, const Epi& E) {
    int tid_l = threadIdx.x; asm volatile("" : "+v"(tid_l));
    const int tid = tid_l, wid = __builtin_amdgcn_readfirstlane(tid >> 6), lane = tid & 63, wr = wid >> 2, wc = wid & 3, fr = lane & 15, fq = lane >> 4;
    const int K = g.K, nt = K / BK;
    unsigned voffA[2], voffB[2];
#pragma unroll
    for (int i = 0; i < 2; ++i) { int R, C; stage_rc(tid * 16 + i * 8192, R, C); const int Rb = Epi::PERM ? ((R & ~31) + perm32(R & 31)) : R;
        voffA[i] = (unsigned)(R * K + C) * 2u; voffB[i] = (unsigned)(Rb * K + C) * 2u; }
    const size_t kstep = (size_t)(BK * 2);
    const size_t hstep = (size_t)HALF * K * 2;
    const size_t tstep = 2 * hstep;
    const unsigned ldsw = (unsigned)wid * 1024u;
    const int aoff = lds_byte(wr * 64 + fr, fq * 8), boff = lds_byte(wc * 32 + fr, fq * 8);
#define PG8_SA(b, h) (((b) * 2 + (h)) * HTB)
#define PG8_SB(b, h) ((4 + (b) * 2 + (h)) * HTB)
#define PG8_STAGE(bufoff, gbase, voff) do { _Pragma("unroll") for (int _i = 0; _i < 2; ++_i) \
        __builtin_amdgcn_global_load_lds((const unsigned*)((const char*)(gbase) + (voff)[_i]), (PG8_LAS unsigned*)(lds + (bufoff) + ldsw + _i * 8192), 16, 0, 0); } while (0)
#define PG8_LDA(dst, b, h) do { _Pragma("unroll") for (int m = 0; m < 4; ++m) _Pragma("unroll") for (int k = 0; k < 2; ++k) dst[m][k] = *(const PG8_LAS bf16x8*)(lds + PG8_SA(b, h) + aoff + m * 2048 + k * 1024); } while (0)
#define PG8_LDB(dst, b, h) do { _Pragma("unroll") for (int n = 0; n < 2; ++n) _Pragma("unroll") for (int k = 0; k < 2; ++k) dst[n][k] = *(const PG8_LAS bf16x8*)(lds + PG8_SB(b, h) + boff + n * 2048 + k * 1024); } while (0)
#define PG8_MMA(ai, bj, At, Bt) do { __builtin_amdgcn_s_setprio(1); _Pragma("unroll") for (int m = 0; m < 4; ++m) _Pragma("unroll") for (int n = 0; n < 2; ++n) _Pragma("unroll") for (int k = 0; k < 2; ++k) \
        acc[ai][bj][m][n] = __builtin_amdgcn_mfma_f32_16x16x32_bf16(Bt[n][k], At[m][k], acc[ai][bj][m][n], 0, 0, 0); __builtin_amdgcn_s_setprio(0); } while (0)
#define PG8_WAIT_V(n) asm volatile("s_waitcnt vmcnt(" #n ")" ::: "memory")
#define PG8_WAIT_L(n) asm volatile("s_waitcnt lgkmcnt(" #n ")" ::: "memory")
#define PG8_BAR __builtin_amdgcn_s_barrier()
#define PG8_SCHED __builtin_amdgcn_sched_barrier(0)
    Unit cur, nxt; int ui = 0;
    if (!S.next(0, cur)) return;
    f32x4 acc[2][2][4][2];
#pragma unroll
    for (int a = 0; a < 2; ++a)
#pragma unroll
        for (int b = 0; b < 2; ++b)
#pragma unroll
            for (int m = 0; m < 4; ++m)
#pragma unroll
                for (int n = 0; n < 2; ++n) acc[a][b][m][n] = (f32x4){0.f, 0.f, 0.f, 0.f};
    bf16x8 At[4][2], B0[2][2], B1[2][2];
    const char* cA = (const char*)g.A + (size_t)cur.pm * tstep; const char* cB = (const char*)g.Bt + (size_t)cur.pn * tstep;
    S.a_ready(cur);
    if constexpr (SP2) {
        PG8_STAGE(PG8_SB(0, 0), cB, voffB); PG8_STAGE(PG8_SB(0, 1), cB + hstep, voffB); PG8_STAGE(PG8_SA(0, 0), cA, voffA); PG8_STAGE(PG8_SA(0, 1), cA + hstep, voffA);
        if (wr == 1) PG8_BAR;
        PG8_WAIT_V(2); PG8_BAR;
        PG8_STAGE(PG8_SB(1, 0), cB + kstep, voffB); PG8_STAGE(PG8_SA(1, 0), cA + kstep, voffA); PG8_STAGE(PG8_SB(1, 1), cB + hstep + kstep, voffB);
        PG8_WAIT_V(6); PG8_BAR;
    } else {
        PG8_STAGE(PG8_SB(0, 0), cB, voffB); PG8_STAGE(PG8_SA(0, 0), cA, voffA); PG8_STAGE(PG8_SB(0, 1), cB + hstep, voffB); PG8_STAGE(PG8_SA(0, 1), cA + hstep, voffA);
        if (wr == 1) PG8_BAR;
        PG8_WAIT_V(4); PG8_BAR;
        PG8_STAGE(PG8_SB(1, 0), cB + kstep, voffB); PG8_STAGE(PG8_SA(1, 0), cA + kstep, voffA); PG8_STAGE(PG8_SB(1, 1), cB + hstep + kstep, voffB);
        PG8_WAIT_V(6); PG8_BAR;
    }
    for (;;) {
        const bool has_next = S.next(ui + 1, nxt);
        const char* nA = has_next ? (const char*)g.A + (size_t)nxt.pm * tstep : cA; const char* nB = has_next ? (const char*)g.Bt + (size_t)nxt.pn * tstep : cB;
        for (int t = 0; t < nt; t += 2) {
            const bool last = (t == nt - 2);
            const char* a1 = cA + (size_t)(t + 1) * kstep;
            const char* a2 = last ? nA : cA + (size_t)(t + 2) * kstep; const char* b2 = last ? nB : cB + (size_t)(t + 2) * kstep;
            const char* a3 = a2 + kstep; const char* b3 = b2 + kstep;
            if (last && has_next) S.a_ready(nxt);
            if constexpr (SP2) {
            PG8_LDB(B0, 0, 0); PG8_LDB(B1, 0, 1); PG8_SCHED; PG8_LDA(At, 0, 0); PG8_STAGE(PG8_SA(1, 1), a1 + hstep, voffA);
            PG8_WAIT_V(8); PG8_WAIT_L(0); PG8_BAR; PG8_MMA(0, 0, At, B0); PG8_MMA(0, 1, At, B1); PG8_BAR; PG8_SCHED;
            PG8_LDA(At, 0, 1); PG8_STAGE(PG8_SB(0, 0), b2, voffB); PG8_STAGE(PG8_SB(0, 1), b2 + hstep, voffB); PG8_STAGE(PG8_SA(0, 0), a2, voffA);
            PG8_WAIT_V(8); PG8_WAIT_L(0); PG8_BAR; PG8_MMA(1, 0, At, B0); PG8_MMA(1, 1, At, B1); PG8_BAR; PG8_SCHED;
            PG8_LDB(B0, 1, 0); PG8_LDB(B1, 1, 1); PG8_SCHED; PG8_LDA(At, 1, 0); PG8_STAGE(PG8_SA(0, 1), a2 + hstep, voffA);
            PG8_WAIT_V(8); PG8_WAIT_L(0); PG8_BAR; PG8_MMA(0, 0, At, B0); PG8_MMA(0, 1, At, B1); PG8_BAR; PG8_SCHED;
            PG8_LDA(At, 1, 1); PG8_STAGE(PG8_SB(1, 0), b3, voffB); PG8_STAGE(PG8_SB(1, 1), b3 + hstep, voffB); PG8_STAGE(PG8_SA(1, 0), a3, voffA);
            PG8_WAIT_V(8); PG8_WAIT_L(0); PG8_BAR; PG8_MMA(1, 0, At, B0); PG8_MMA(1, 1, At, B1); PG8_BAR; PG8_SCHED;
            } else {
            PG8_LDB(B0, 0, 0); PG8_SCHED; PG8_LDA(At, 0, 0); PG8_STAGE(PG8_SA(1, 1), a1 + hstep, voffA);
            PG8_WAIT_L(8); PG8_BAR; PG8_WAIT_L(0); PG8_MMA(0, 0, At, B0); PG8_BAR; PG8_SCHED;
            PG8_LDB(B1, 0, 1); PG8_STAGE(PG8_SB(0, 0), b2, voffB);
            PG8_BAR; PG8_WAIT_L(0); PG8_MMA(0, 1, At, B1); PG8_BAR;
            PG8_LDA(At, 0, 1); PG8_STAGE(PG8_SA(0, 0), a2, voffA);
            PG8_BAR; PG8_WAIT_L(0); PG8_MMA(1, 0, At, B0); PG8_BAR; PG8_SCHED;
            PG8_STAGE(PG8_SB(0, 1), b2 + hstep, voffB);
            PG8_WAIT_V(6); PG8_BAR; PG8_MMA(1, 1, At, B1); PG8_BAR;
            PG8_LDB(B0, 1, 0); PG8_SCHED; PG8_LDA(At, 1, 0); PG8_STAGE(PG8_SA(0, 1), a2 + hstep, voffA);
            PG8_WAIT_L(8); PG8_BAR; PG8_WAIT_L(0); PG8_MMA(0, 0, At, B0); PG8_BAR; PG8_SCHED;
            PG8_LDB(B1, 1, 1); PG8_STAGE(PG8_SB(1, 0), b3, voffB);
            PG8_BAR; PG8_WAIT_L(0); PG8_MMA(0, 1, At, B1); PG8_BAR;
            PG8_LDA(At, 1, 1); PG8_STAGE(PG8_SA(1, 0), a3, voffA);
            PG8_BAR; PG8_WAIT_L(0); PG8_MMA(1, 0, At, B0); PG8_BAR; PG8_SCHED;
            PG8_STAGE(PG8_SB(1, 1), b3 + hstep, voffB);
            PG8_WAIT_V(6); PG8_BAR; PG8_MMA(1, 1, At, B1); PG8_BAR;
            }
        }
        if constexpr (ALIGN_EPI) { if (wr == 0) PG8_BAR; }
        if constexpr (!Epi::AFTER_DRAIN) { E(acc, cur, wr, wc, fr, fq); S.done(cur); }
        if (!has_next) break;
#pragma unroll
        for (int a = 0; a < 2; ++a)
#pragma unroll
            for (int b = 0; b < 2; ++b)
#pragma unroll
                for (int m = 0; m < 4; ++m)
#pragma unroll
                    for (int n = 0; n < 2; ++n) acc[a][b][m][n] = (f32x4){0.f, 0.f, 0.f, 0.f};
        cur = nxt; cA = nA; cB = nB; ++ui;
        if constexpr (ALIGN_EPI) { if (wr == 1) PG8_BAR; }
    }
    PG8_WAIT_V(0);
    if constexpr (!ALIGN_EPI) { if (wr == 0) PG8_BAR; }
    PG8_BAR;
    if constexpr (Epi::AFTER_DRAIN) { E.fused(acc, cur, wr, wc, fr, fq, lds, wid, lane); S.done(cur); }
#undef PG8_SA
#undef PG8_SB
#undef PG8_STAGE
#undef PG8_LDA
#undef PG8_LDB
#undef PG8_MMA
#undef PG8_WAIT_V
#undef PG8_WAIT_L
#undef PG8_BAR
#undef PG8_SCHED
}
}

#define GAS __attribute__((address_space(1)))
#define LAS __attribute__((address_space(3)))
#define DI __device__ __forceinline__
typedef unsigned short bf16;
typedef unsigned v4u __attribute__((ext_vector_type(4)));
typedef unsigned v2u __attribute__((ext_vector_type(2)));
typedef float f32x4 __attribute__((ext_vector_type(4)));
typedef short bf16x8 __attribute__((ext_vector_type(8)));
typedef short s16x4 __attribute__((ext_vector_type(4)));
typedef GAS unsigned gu32;
typedef GAS unsigned long long gu64;
#define RLX_AGENT __ATOMIC_RELAXED, __HIP_MEMORY_SCOPE_AGENT
#define LDS_WAIT() asm volatile("s_waitcnt lgkmcnt(0)" ::: "memory")
#define VM_WAIT() asm volatile("s_waitcnt vmcnt(0)" ::: "memory")
DI unsigned f2bf(float f) { unsigned u = __builtin_bit_cast(unsigned, f); return (u + 0x7fffu + ((u >> 16) & 1u)) >> 16; }
__device__ __forceinline__ unsigned pk2(float lo, float hi) { return f2bf(lo) | (f2bf(hi) << 16); }

#define XB_TMO      128
#define XB_XCNT(j)  (256  + 64 * (j))
#define XB_XSUB(j)  (1280 + 64 * (j))
#define XB_XGEN(j)  (2304 + 64 * (j))
#define XB_TOP      3328
#define XB_TOPGEN   3392
#define XCD_BAR_WORDS 3456
#define XB_SPIN_CAP (1u << 18)

__device__ __forceinline__ unsigned xb_ld(unsigned* p)              { return __hip_atomic_load(p, __ATOMIC_RELAXED, __HIP_MEMORY_SCOPE_AGENT); }
__device__ __forceinline__ unsigned xb_add(unsigned* p, unsigned v) { return __hip_atomic_fetch_add(p, v, __ATOMIC_RELAXED, __HIP_MEMORY_SCOPE_AGENT); }
__device__ __forceinline__ unsigned xb_xcc_id() { return (unsigned)__builtin_amdgcn_s_getreg((3 << 11) | 20) & 0xFu; }
#define XB_SPIN(cond, bar) do { unsigned _sp = 0; while (cond) { __builtin_amdgcn_s_sleep(1); \
    if ((++_sp & 255u) == 0u) { if (xb_ld(&(bar)[XB_TMO])) break; if (_sp > XB_SPIN_CAP) { atomicAdd(&(bar)[XB_TMO], 1u); break; } } } } while (0)

struct XcdBarrier {
    unsigned* bar; unsigned x;
    volatile LAS unsigned* st;
};

__device__ __forceinline__ XcdBarrier xcd_barrier_post(unsigned* bar, volatile LAS unsigned* st) {
    XcdBarrier b; b.bar = bar; b.x = xb_xcc_id(); b.st = st;
    if (threadIdx.x == 0) (void)xb_add(&bar[XB_XCNT(b.x)], 1u);
    return b;
}
__device__ __forceinline__ void xcd_barrier_complete(unsigned* bar, unsigned x, unsigned& nloc, unsigned& nx) {
    const unsigned G = gridDim.x * gridDim.y * gridDim.z;
    unsigned sum, cnt, mine, sp = 0u;
    for (;;) {
        sum = 0u; cnt = 0u; mine = 0u;
#pragma unroll 1
        for (unsigned j = 0; j < 16; ++j) { const unsigned c = xb_ld(&bar[XB_XCNT(j)]); sum += c; cnt += (c > 0u) ? 1u : 0u; mine = (j == x) ? c : mine; }
        if (sum == G) break;
        __builtin_amdgcn_s_sleep(1);
        if ((++sp & 255u) == 0u) { if (xb_ld(&bar[XB_TMO])) break; if (sp > XB_SPIN_CAP) { atomicAdd(&bar[XB_TMO], 1u); break; } }
    }
    nloc = mine > 0u ? mine : 1u; nx = cnt > 0u ? cnt : 1u;
}

__device__ __forceinline__ void xcd_barrier(const XcdBarrier& b) {
    asm volatile("s_waitcnt vmcnt(0)" ::: "memory");
    __syncthreads();
    if (threadIdx.x == 0) {
        unsigned* bar = b.bar;
        __builtin_amdgcn_s_waitcnt(0);
        unsigned nloc = b.st[0], nx = b.st[1];
        if (nloc == 0u) { xcd_barrier_complete(bar, b.x, nloc, nx); b.st[0] = nloc; b.st[1] = nx; }
        const unsigned old = xb_add(&bar[XB_XSUB(b.x)], 1u);
        const unsigned gen = old / nloc;
        if (old + 1u == (gen + 1u) * nloc) {
            __builtin_amdgcn_fence(__ATOMIC_RELEASE, "agent");
            asm volatile("s_waitcnt vmcnt(0)" ::: "memory");
            const unsigned og = xb_add(&bar[XB_TOP], 1u);
            const unsigned tg = og / nx;
            if (og + 1u == (tg + 1u) * nx) xb_add(&bar[XB_TOPGEN], 1u);
            else XB_SPIN(xb_ld(&bar[XB_TOPGEN]) == tg, bar);
            __builtin_amdgcn_fence(__ATOMIC_ACQUIRE, "agent");
            xb_add(&bar[XB_XGEN(b.x)], 1u);
            asm volatile("s_waitcnt vmcnt(0)" ::: "memory");
        } else {
            XB_SPIN(xb_ld(&bar[XB_XGEN(b.x)]) == gen, bar);
            __builtin_amdgcn_fence(__ATOMIC_ACQUIRE, "agent");
            asm volatile("s_waitcnt vmcnt(0)" ::: "memory");
        }
    }
    __syncthreads();
}

constexpr int BATCH = 2, SEQ = 4096, DM = 4096, DEPTH = 4, MTOK = BATCH * SEQ;
constexpr int DIN = 13328;
constexpr int NPJ = 13568;
constexpr int C_RQ = 0, C_RK = 1024, C_RV = 2048, C_RG = 3072, C_MQ = 4096, C_MK = 5120, C_MV = 6144, C_MG = 7168, C_SZ = 8192, C_SX = 9216, C_LX = 11264, C_LG = 12288, C_DT = 13312;
constexpr float EPS = 1e-6f;
constexpr int NWAVES = 8, NTHR = 512;
constexpr int NPHASE = 2 + 5 * DEPTH;

constexpr size_t MiB = 1u << 20;
constexpr size_t WS_CTL = 0, CTL_ZERO_BYTES = 1 * MiB;
constexpr size_t WS_SSQ = 2 * MiB, WS_LRUW = 4 * MiB, WS_KMEAN = 6 * MiB, WS_DT = 7 * MiB, WS_DTRAW = 8 * MiB, WS_DACS = 9 * MiB, WS_HEND = 10 * MiB, WS_AEND = 11 * MiB, WS_CARRY = 12 * MiB;
constexpr size_t WS_WIN = 16 * MiB, WIN_LAYER = (size_t)NPJ * DM * 2;
constexpr size_t WS_WOUT = 440 * MiB, WOUT_LAYER = (size_t)DM * DM * 2;
constexpr size_t WS_X = 568 * MiB, WS_XB = 696 * MiB, WS_P = 760 * MiB, WS_Y = 972 * MiB, WS_RU = 1036 * MiB, WS_RS = 1068 * MiB, WS_XBC = 1084 * MiB, WS_SST = 1116 * MiB, WS_SHP = 1132 * MiB,
                 WS_HLOC = 1140 * MiB, WS_ACUM = 1172 * MiB, WS_END = 1204 * MiB;
static_assert(WS_WIN + 4 * WIN_LAYER <= WS_WOUT && WS_P + (size_t)MTOK * NPJ * 2 <= WS_Y, "ws map");
constexpr int CW_BAR = 4096;
constexpr int CW_WQ = 16384;

constexpr int RING_BYTES = 131072, LDSCTL_OFF = RING_BYTES, MISC_OFF = LDSCTL_OFF + 320, LDS_BYTES = 147456;
constexpr int SB256 = 528, SB128 = 272;

struct Args { const float* in[19]; float* out; unsigned char* ws; int ph_lo, ph_hi; };
struct Frame {
    LAS unsigned char* lds; const Args* a; int z, tid_;
    DI int tid() const { return tid_; }
    DI int lane() const { return tid_ & 63; }
    DI int wave() const { return __builtin_amdgcn_readfirstlane(tid_ >> 6); }
    DI int G() const { return (int)gridDim.x; }
    DI volatile LAS unsigned* MISC() const { return (volatile LAS unsigned*)(lds + MISC_OFF); }
    DI unsigned char* ws() const { return a->ws + z; }
    DI unsigned* ctl() const { return (unsigned*)(a->ws + z + WS_CTL); }
    DI const float* in(int k) const { return a->in[k] + z; }
    DI float* out() const { return a->out + z; }
#define FV(T, name, off) DI T* name() const { return (T*)(a->ws + z + (off)); }
    FV(bf16, WIN, WS_WIN) FV(bf16, WOUT, WS_WOUT) FV(bf16, XB, WS_XB) FV(bf16, P, WS_P) FV(bf16, Y, WS_Y) FV(bf16, RS, WS_RS) FV(bf16, XBC, WS_XBC) FV(bf16, SHP, WS_SHP) FV(bf16, LRUW, WS_LRUW)
    FV(float, X, WS_X) FV(float, SSQ, WS_SSQ) FV(bf16, KMH, WS_KMEAN) FV(bf16, KML, WS_KMEAN + 65536) FV(float, KMX, WS_KMEAN + 131072) FV(float, DT, WS_DT) FV(float, DTRAW, WS_DTRAW) FV(float, DACS, WS_DACS) FV(float, HEND, WS_HEND) FV(float, AEND, WS_AEND)
    FV(float, CARRY, WS_CARRY) FV(bf16, RU, WS_RU) FV(float, SST, WS_SST) FV(bf16, HLOC, WS_HLOC) FV(bf16, ACUM, WS_ACUM)
#undef FV
};

DI Frame mk_frame(LAS unsigned char* lds, const Args* a) { Frame F; F.lds = lds; F.a = a; int z = 0; asm volatile("" : "+s"(z)); int t = (int)threadIdx.x; asm volatile("" : "+v"(t)); F.z = z; F.tid_ = t; return F; }
DI float bf_lo(unsigned u) { return __uint_as_float(u << 16); }
DI float bf_hi(unsigned u) { return __uint_as_float(u & 0xffff0000u); }
typedef float f32x2_t __attribute__((ext_vector_type(2))); typedef __bf16 bf16x2_t __attribute__((ext_vector_type(2)));
DI unsigned pkbf(float lo, float hi) { f32x2_t v = {lo, hi}; bf16x2_t b = __builtin_convertvector(v, bf16x2_t); return __builtin_bit_cast(unsigned, b); }
DI float wave_sum(float v) {
#pragma unroll
    for (int o = 1; o < 64; o <<= 1) v += __shfl_xor(v, o);
    return v;
}
DI float sigm(float x) { return __builtin_amdgcn_rcpf(1.f + __expf(-x)); }
DI float silu(float x) { return x * __builtin_amdgcn_rcpf(1.f + __expf(-x)); }
DI float one_minus_exp(float x) { const float p = -x * (1.0f + x * (0.5f + x * (0.16666667f + x * (0.041666668f + x * 0.008333334f)))); return x > -0.25f ? p : 1.0f - __expf(x); }
DI float softplus(float x) { return x > 20.f ? x : log1pf(__expf(x)); }
DI f32x4 mfma16(bf16x8 a, bf16x8 b, f32x4 c) { return __builtin_amdgcn_mfma_f32_16x16x32_bf16(a, b, c, 0, 0, 0); }
DI void unpack8(const v4u v, float (&f)[8]) { f[0] = bf_lo(v.x); f[1] = bf_hi(v.x); f[2] = bf_lo(v.y); f[3] = bf_hi(v.y); f[4] = bf_lo(v.z); f[5] = bf_hi(v.z); f[6] = bf_lo(v.w); f[7] = bf_hi(v.w); }
DI v4u pack8(const float (&f)[8]) { v4u v; v.x = pkbf(f[0], f[1]); v.y = pkbf(f[2], f[3]); v.z = pkbf(f[4], f[5]); v.w = pkbf(f[6], f[7]); return v; }
DI bf16x8 pack8f(const float (&f)[8]) { return __builtin_bit_cast(bf16x8, pack8(f)); }
DI bf16x8 frag_row(const LAS unsigned char* t, int sb, int r0, int k0, int lane) { return *(const LAS bf16x8*)(t + (r0 + (lane & 15)) * sb + (k0 + 8 * (lane >> 4)) * 2); }
typedef short v4i16_t __attribute__((ext_vector_type(4)));
DI bf16x8 frag_tr(const LAS unsigned char* t, int sb, int ra, int rb, int c0, int lane) {
    const int q = (lane & 15) >> 2, p = lane & 3;
    const s16x4 lo = __builtin_bit_cast(s16x4, __builtin_amdgcn_ds_read_tr16_b64_v4i16((LAS v4i16_t*)(t + (ra + q) * sb + (c0 + 4 * p) * 2)));
    const s16x4 hi = __builtin_bit_cast(s16x4, __builtin_amdgcn_ds_read_tr16_b64_v4i16((LAS v4i16_t*)(t + (rb + q) * sb + (c0 + 4 * p) * 2)));
    bf16x8 r; r[0] = lo[0]; r[1] = lo[1]; r[2] = lo[2]; r[3] = lo[3]; r[4] = hi[0]; r[5] = hi[1]; r[6] = hi[2]; r[7] = hi[3]; return r;
}
template <int COLS> DI void stage_bf16(LAS unsigned char* dst, int sb, const bf16* src, size_t gp, int rows, int tid) {
    constexpr int CPR = COLS / 8; const int total = rows * CPR;
    for (int c = tid; c < total; c += NTHR) { const int r = c / CPR, ch = c % CPR; const v4u v = *(const v4u*)(src + (size_t)r * gp + ch * 8); *(LAS v4u*)(dst + r * sb + ch * 16) = v; }
}
DI unsigned wq_issue(Frame& F, int ctr) { unsigned v = 0u; if (F.tid() == 0) v = __hip_atomic_fetch_add(F.ctl() + CW_WQ + 64 * ctr, 1u, RLX_AGENT); return v; }
DI int wq_publish(Frame& F, unsigned v) { __syncthreads(); if (F.tid() == 0) F.MISC()[0] = v; __syncthreads(); return __builtin_amdgcn_readfirstlane((int)F.MISC()[0]); }
DI int next_unit(Frame& F, int ctr) {
    __syncthreads();
    if (F.tid() == 0) F.MISC()[0] = __hip_atomic_fetch_add(F.ctl() + CW_WQ + 64 * ctr, 1u, RLX_AGENT);
    __syncthreads();
    return __builtin_amdgcn_readfirstlane((int)F.MISC()[0]);
}

namespace pg8 {
struct EpiProj {
    static constexpr bool PERM = true, AFTER_DRAIN = false;
    bf16_t* O; float* dtraw; const float* ssq;
    const PG8_LAS float* rtab; int fm;
    __device__ __forceinline__ void operator()(const f32x4 (&acc)[2][2][4][2], const Unit& u, int wr, int wc, int fr, int fq) const {
        asm volatile("" : "+v"(fr), "+v"(fq));
        const int row0 = u.pm * BM + wr * 64 + fr;
        const bool dt_tile = u.pn >= 52;
        const int col0 = u.pn * BM + wc * 32 + 8 * fq;
        const bool tab = rtab != nullptr && (unsigned)(u.pm - fm) < 8u;
        float rs[2][4];
        if (tab) { const PG8_LAS float* t = rtab + (u.pm - fm) * BM + wr * 64 + fr;
#pragma unroll
            for (int ai = 0; ai < 2; ++ai)
#pragma unroll
                for (int m = 0; m < 4; ++m) rs[ai][m] = t[ai * HALF + m * 16];
        } else { f32x4 pv[2][4];
#pragma unroll
            for (int ai = 0; ai < 2; ++ai)
#pragma unroll
                for (int m = 0; m < 4; ++m) pv[ai][m] = *(const f32x4*)(ssq + (size_t)(row0 + ai * HALF + m * 16) * 16 + 4 * fq);
#pragma unroll
            for (int ai = 0; ai < 2; ++ai)
#pragma unroll
                for (int m = 0; m < 4; ++m) { float s = (pv[ai][m][0] + pv[ai][m][1]) + (pv[ai][m][2] + pv[ai][m][3]); s += __shfl_xor(s, 16); s += __shfl_xor(s, 32); rs[ai][m] = rsqrtf(s * (1.0f / 4096.0f) + 1e-6f); } }
#pragma unroll
        for (int ai = 0; ai < 2; ++ai)
#pragma unroll
            for (int m = 0; m < 4; ++m) { const int r = row0 + ai * HALF + m * 16; const float s = rs[ai][m];
                if (!dt_tile) { bf16_t* rowp = O + (size_t)r * 13568 + col0;
#pragma unroll
                    for (int bj = 0; bj < 2; ++bj) { const f32x4 v0 = acc[ai][bj][m][0] * s, v1 = acc[ai][bj][m][1] * s;
                        u32x4 w; w.x = cvt_pk_bf16(v0[0], v0[1]); w.y = cvt_pk_bf16(v0[2], v0[3]); w.z = cvt_pk_bf16(v1[0], v1[1]); w.w = cvt_pk_bf16(v1[2], v1[3]);
                        *(u32x4*)(rowp + bj * HALF) = w; }
                } else if (wc == 0 && fq < 2) { float* rowp = dtraw + (size_t)r * 16 + 8 * fq; *(f32x4*)(rowp) = acc[ai][0][m][0] * s; *(f32x4*)(rowp + 4) = acc[ai][0][m][1] * s; } }
    }
};
struct EpiOut {
    static constexpr bool PERM = false, AFTER_DRAIN = false;
    bf16_t* xb; float* ssq; PG8_LAS float* red;
    __device__ __forceinline__ void operator()(const f32x4 (&acc)[2][2][4][2], const Unit& u, int wr, int wc, int fr, int fq) const {
        asm volatile("" : "+v"(fr), "+v"(fq));
        const int row0 = u.pm * BM + wr * 64 + fr, col0 = u.pn * BM + wc * 32 + 4 * fq;
#pragma unroll
        for (int ai = 0; ai < 2; ++ai) {
            unsigned long long xo[4][2][2];
#pragma unroll
            for (int m = 0; m < 4; ++m)
#pragma unroll
                for (int bj = 0; bj < 2; ++bj)
#pragma unroll
                    for (int n = 0; n < 2; ++n) xo[m][bj][n] = *(const unsigned long long*)(xb + (size_t)(row0 + ai * HALF + m * 16) * 4096 + col0 + bj * HALF + n * 16);
#pragma unroll
            for (int m = 0; m < 4; ++m) { const int r = row0 + ai * HALF + m * 16; const size_t off = (size_t)r * 4096 + col0; float ss = 0.f;
#pragma unroll
                for (int bj = 0; bj < 2; ++bj)
#pragma unroll
                    for (int n = 0; n < 2; ++n) { const unsigned lo = (unsigned)xo[m][bj][n], hi = (unsigned)(xo[m][bj][n] >> 32);
                        f32x4 o = acc[ai][bj][m][n]; o[0] += __uint_as_float(lo << 16); o[1] += __uint_as_float(lo & 0xffff0000u); o[2] += __uint_as_float(hi << 16); o[3] += __uint_as_float(hi & 0xffff0000u);
                        ss += (o[0] * o[0] + o[1] * o[1]) + (o[2] * o[2] + o[3] * o[3]);
                        const unsigned w0 = cvt_pk_bf16(o[0], o[1]), w1 = cvt_pk_bf16(o[2], o[3]);
                        *(unsigned long long*)(xb + off + bj * HALF + n * 16) = (unsigned long long)w0 | ((unsigned long long)w1 << 32); }
                ss += __shfl_xor(ss, 16); ss += __shfl_xor(ss, 32);
                if (fq == 0) red[(ai * HALF + wr * 64 + m * 16 + fr) * 4 + wc] = ss; }
            asm volatile("" ::: "memory"); }
        asm volatile("s_waitcnt lgkmcnt(0)" ::: "memory"); __builtin_amdgcn_s_barrier(); asm volatile("" ::: "memory");
        { const int t = (wr * 4 + wc) * 64 + fq * 16 + fr;
          if (t < 256) { const f32x4 p4 = *(const PG8_LAS f32x4*)(red + t * 4); ssq[(size_t)(u.pm * BM + t) * 16 + u.pn] = (p4[0] + p4[1]) + (p4[2] + p4[3]); } }
    }
};
struct RemapOrder : StaticOrder {
    __device__ __forceinline__ bool next(int i, Unit& u) const { if (!StaticOrder::next(i, u)) return false; if (u.pn == 35) u.pn = 52; return true; }
};
struct OneUnit {
    int pm, pn;
    __device__ __forceinline__ bool next(int i, Unit& u) const { if (i != 0) return false; u.pm = pm; u.pn = pn; return true; }
    __device__ __forceinline__ void a_ready(const Unit&) const {}
    __device__ __forceinline__ void done(const Unit&) const {}
};
}

DI int map_in_col(int n) { return n < 11264 ? n : (n < 11280 ? C_DT + (n - 11264) : n - 16); }
constexpr int TR_SB = 272;
struct TrItem { const float* W; const float* ks; bf16* WT; int N, k0, n0, is_in; };
constexpr int TR_NB_IN = (DIN + 127) / 128, TR_I_IN = 32 * TR_NB_IN, TR_I_OUT = 32 * 32, TR_I_L = TR_I_IN + TR_I_OUT;
DI bool tr_item(Frame& F, int l, int r, TrItem& t) {
    constexpr int NB_IN = TR_NB_IN, I_IN = TR_I_IN;
    if (r >= TR_I_L) return false;
    if (r < I_IN) { t.W = F.in(2) + (size_t)l * DM * DIN; t.ks = F.in(1) + l * DM; t.WT = F.WIN() + (size_t)l * NPJ * DM; t.N = DIN; t.k0 = 128 * (r / NB_IN); t.n0 = 128 * (r % NB_IN); t.is_in = 1; }
    else { const int q = r - I_IN; t.W = F.in(17) + (size_t)l * DM * DM; t.ks = nullptr; t.WT = F.WOUT() + (size_t)l * DM * DM; t.N = DM; t.k0 = 128 * (q / 32); t.n0 = 128 * (q % 32); t.is_in = 0; }
    return true;
}
DI void tr_load(const TrItem& t, int tid, f32x4 (&v)[8]) {
    const int c4 = tid & 31, n = t.n0 + 4 * c4; const bool ok = n < t.N;
#pragma unroll
    for (int p = 0; p < 8; ++p) { const int k = t.k0 + p * 16 + (tid >> 5); f32x4 x = ok ? *(const f32x4*)(t.W + (size_t)k * t.N + n) : (f32x4){0.f, 0.f, 0.f, 0.f}; if (t.ks) x *= t.ks[k]; v[p] = x; }
}
DI void tr_step(Frame& F, const TrItem& cur, f32x4 (&v)[8], int l, int r_next, TrItem& nxt, bool& hn, LAS unsigned char* tile, int tid, int lane, int w) {
    const int gq = lane >> 4, l15 = lane & 15, c4 = tid & 31;
    __syncthreads();
#pragma unroll
    for (int p = 0; p < 8; ++p) { const int kr = p * 16 + (tid >> 5); v2u o; o.x = pkbf(v[p][0], v[p][1]); o.y = pkbf(v[p][2], v[p][3]); *(LAS v2u*)(tile + kr * TR_SB + c4 * 8) = o; }
    __syncthreads();
    hn = tr_item(F, l, r_next, nxt);
    if (hn) tr_load(nxt, tid, v);
    const int n = cur.n0 + 16 * w + l15; const bool okn = n < cur.N; const int row = cur.is_in ? map_in_col(okn ? n : 0) : n; bf16* dst = cur.WT + (size_t)row * DM + cur.k0 + 8 * gq;
#pragma unroll
    for (int ks = 0; ks < 4; ++ks) { const bf16x8 f = frag_tr(tile, TR_SB, 32 * ks + 8 * gq, 32 * ks + 8 * gq + 4, 16 * w, lane); if (okn) *(bf16x8*)(dst + 32 * ks) = f; }
}
DI void tr_unit(Frame& F, int l, int r0, int cnt) {
    const int tid = F.tid(), lane = F.lane(), w = F.wave();
    TrItem ia, ib, dummy; f32x4 va[8], vb[8]; bool hn;
    tr_item(F, l, r0, ia); tr_item(F, l, r0 + 1, ib);
    tr_load(ia, tid, va); tr_load(ib, tid, vb);
    tr_step(F, ia, va, l, TR_I_L, dummy, hn, F.lds, tid, lane, w);
    tr_step(F, ib, vb, l, TR_I_L, dummy, hn, F.lds, tid, lane, w);
    __syncthreads();
}
DI void p0_prologue(Frame& F) {
    const int tid = F.tid(), lane = F.lane(), w = F.wave();
    LAS unsigned char* tile = F.lds;
    TrItem ia, ib; f32x4 va[8], vb[8];
    int it = blockIdx.x; const int G = F.G();
#define P0_IDX(i) ((i) < TR_I_IN ? (i) : TR_I_L)
    bool ha = tr_item(F, 0, P0_IDX(it), ia), hb = tr_item(F, 0, P0_IDX(it + G), ib);
    if (ha) tr_load(ia, tid, va);
    if (hb) tr_load(ib, tid, vb);
    while (ha) {
        TrItem na; bool hna;
        tr_step(F, ia, va, 0, P0_IDX(it + 2 * G), na, hna, tile, tid, lane, w);
        if (!hb) break;
        TrItem nb; bool hnb;
        tr_step(F, ib, vb, 0, P0_IDX(it + 3 * G), nb, hnb, tile, tid, lane, w);
        ia = na; ha = hna; ib = nb; hb = hnb; it += 2 * G;
    }
    const int gw = blockIdx.x * NWAVES + w, NGW = F.G() * NWAVES;
    for (int i = blockIdx.x * NTHR + tid; i < DEPTH * 240 * (DM / 8); i += F.G() * NTHR) { const int l = i / (240 * (DM / 8)), r = i % (240 * (DM / 8));
        *(v4u*)(F.WIN() + (size_t)l * NPJ * DM + (size_t)(C_DT + 16) * DM + (size_t)r * 8) = (v4u){0u, 0u, 0u, 0u}; }
    for (int i = blockIdx.x * NTHR + tid; i < DEPTH * 2 * 8 * 128 * 128; i += F.G() * NTHR) { const int d = i & 127, e = (i >> 7) & 127, nb = (i >> 14) & 7, gate = (i >> 17) & 1, l = i >> 18;
        const float* wp = (gate ? F.in(14) : F.in(12)) + ((size_t)(l * 8 + nb) * 128 + d) * 128 + e; F.LRUW()[i] = (bf16)f2bf(*wp); }
    for (int m = gw; m < MTOK; m += NGW) { const f32x4* xr = (const f32x4*)(F.in(0) + (size_t)m * DM) + lane; float ss = 0.f;
#pragma unroll
        for (int j = 0; j < 16; ++j) { const f32x4 x = xr[64 * j]; ss += (x[0] * x[0] + x[1] * x[1]) + (x[2] * x[2] + x[3] * x[3]);
            const unsigned long long o = (unsigned long long)pkbf(x[0], x[1]) | ((unsigned long long)pkbf(x[2], x[3]) << 32); *((unsigned long long*)(F.XB() + (size_t)m * DM) + 64 * j + lane) = o; }
        ss = wave_sum(ss); if (lane < 16) F.SSQ()[(size_t)m * 16 + lane] = lane == 0 ? ss : 0.f; }
}
DI void p_final(Frame& F) {
    const int gw = blockIdx.x * NWAVES + F.wave(), NGW = F.G() * NWAVES, lane = F.lane(); const float* fw = F.in(18);
    for (int m = gw; m < MTOK; m += NGW) { float ss = F.SSQ()[(size_t)m * 16 + (lane & 15)]; ss += __shfl_xor(ss, 1); ss += __shfl_xor(ss, 2); ss += __shfl_xor(ss, 4); ss += __shfl_xor(ss, 8); const float rs = rsqrtf(ss * (1.0f / 4096.0f) + EPS);
        const v4u* xr = (const v4u*)(F.XB() + (size_t)m * DM) + lane; f32x4* o = (f32x4*)(F.out() + (size_t)m * DM) + 2 * lane; const f32x4* wv = (const f32x4*)fw + 2 * lane;
#pragma unroll
        for (int j = 0; j < 8; ++j) { float x[8]; unpack8(xr[64 * j], x); const f32x4 w0 = wv[128 * j], w1 = wv[128 * j + 1];
            o[128 * j] = (f32x4){x[0] * rs * w0[0], x[1] * rs * w0[1], x[2] * rs * w0[2], x[3] * rs * w0[3]}; o[128 * j + 1] = (f32x4){x[4] * rs * w1[0], x[5] * rs * w1[1], x[6] * rs * w1[2], x[7] * rs * w1[3]}; } }
}

DI int swz(int row) { return ((row & 3) << 2) | ((row >> 2) & 3); }
DI void dma_tile256(const bf16* src, size_t gp, LAS unsigned char* dst, int w, int lane) {
#pragma unroll
    for (int i = 0; i < 4; ++i) { const int idx = w * 4 + i, row = 2 * idx + (lane >> 5), c = (lane & 31) ^ swz(row);
        __builtin_amdgcn_global_load_lds((const unsigned*)(src + (size_t)row * gp + c * 8), (LAS unsigned*)(dst + idx * 1024), 16, 0, 0); }
}
DI bf16x8 frag_tr_sw512(const LAS unsigned char* t, int ra, int rb, int c0, int lane) {
    const int q = (lane & 15) >> 2, p = lane & 3, ch = (c0 >> 3) + (p >> 1), r0 = ra + q, r1 = rb + q;
    const s16x4 lo = __builtin_bit_cast(s16x4, __builtin_amdgcn_ds_read_tr16_b64_v4i16((LAS v4i16_t*)(t + 512 * r0 + 16 * (ch ^ swz(r0)) + 8 * (p & 1))));
    const s16x4 hi = __builtin_bit_cast(s16x4, __builtin_amdgcn_ds_read_tr16_b64_v4i16((LAS v4i16_t*)(t + 512 * r1 + 16 * (ch ^ swz(r1)) + 8 * (p & 1))));
    bf16x8 r; r[0] = lo[0]; r[1] = lo[1]; r[2] = lo[2]; r[3] = lo[3]; r[4] = hi[0]; r[5] = hi[1]; r[6] = hi[2]; r[7] = hi[3]; return r;
}
DI bf16x8 frag_row_sw512(const LAS unsigned char* t, int row, int ch) { return *(const LAS bf16x8*)(t + 512 * row + 16 * (ch ^ swz(row))); }
DI void ret_A(Frame& F, int unit) {
    const int c = unit & 15, bh = unit >> 4, h = bh & 3, b = bh >> 2, lane = F.lane(), w = F.wave(), gq = lane >> 4, l15 = lane & 15;
    const size_t t0 = (size_t)b * SEQ + c * 256;
    const bf16* Kp = F.P() + t0 * NPJ + C_RK + h * 256; const bf16* Vp = F.P() + t0 * NPJ + C_RV + h * 256;
    const float lg = log1pf(-exp2f(-5.f - (float)h));
    LAS unsigned char* B0 = F.lds; LAS unsigned char* B1 = F.lds + 65536;
    f32x4 acc[2][16];
#pragma unroll
    for (int a = 0; a < 2; ++a)
#pragma unroll
        for (int v = 0; v < 16; ++v) acc[a][v] = (f32x4){0.f, 0.f, 0.f, 0.f};
    float kd8[8];
#pragma unroll
    for (int e = 0; e < 8; ++e) kd8[e] = __expf(-lg * (float)(8 * gq + e));
    __syncthreads();
    dma_tile256(Kp, NPJ, B0, w, lane); dma_tile256(Vp, NPJ, B0 + 32768, w, lane);
    VM_WAIT(); __syncthreads();
    for (int jt = 0; jt < 4; ++jt) {
        LAS unsigned char* cur = (jt & 1) ? B1 : B0; LAS unsigned char* nxt = (jt & 1) ? B0 : B1;
        if (jt < 3) { dma_tile256(Kp + (size_t)(64 * (jt + 1)) * NPJ, NPJ, nxt, w, lane); dma_tile256(Vp + (size_t)(64 * (jt + 1)) * NPJ, NPJ, nxt + 32768, w, lane); }
        { int lz = lane; asm volatile("" : "+v"(lz)); const int lane = lz, gq = lz >> 4;
#pragma unroll
          for (int ks = 0; ks < 2; ++ks) { const int ra = 32 * ks + 8 * gq, rb = ra + 4;
              const float base = __expf(lg * (float)(255 - (64 * jt + 32 * ks))) * 0.0625f;
              bf16x8 A[2];
#pragma unroll
              for (int dt = 0; dt < 2; ++dt) { float f[8]; unpack8(__builtin_bit_cast(v4u, frag_tr_sw512(cur, ra, rb, 32 * w + 16 * dt, lane)), f);
#pragma unroll
                  for (int e = 0; e < 8; ++e) f[e] *= base * kd8[e];
                  A[dt] = pack8f(f); }
#pragma unroll
              for (int vt = 0; vt < 16; ++vt) { const bf16x8 B = frag_tr_sw512(cur + 32768, ra, rb, 16 * vt, lane); acc[0][vt] = mfma16(A[0], B, acc[0][vt]); acc[1][vt] = mfma16(A[1], B, acc[1][vt]); } } }
        VM_WAIT(); __syncthreads();
    }
    bf16* U = F.RU() + (size_t)unit * 65536;
#pragma unroll
    for (int dt = 0; dt < 2; ++dt)
#pragma unroll
        for (int vt = 0; vt < 16; ++vt) { v2u o; o.x = pkbf(acc[dt][vt][0], acc[dt][vt][1]); o.y = pkbf(acc[dt][vt][2], acc[dt][vt][3]); *(v2u*)(U + (16 * vt + l15) * 256 + 32 * w + 16 * dt + 4 * gq) = o; }
}
DI void ret_B(Frame& F) {
    for (int it = blockIdx.x * NTHR + F.tid(); it < 8 * 16384; it += F.G() * NTHR) { const int bh = it >> 14, e4 = it & 16383, h = bh & 3;
        const float cd = __expf(log1pf(-exp2f(-5.f - (float)h)) * 256.f); f32x4 s = (f32x4){0.f, 0.f, 0.f, 0.f};
        const size_t o0 = (size_t)(bh * 16) * 65536 + (size_t)e4 * 4; const bf16* __restrict__ ru = F.RU() + o0; bf16* __restrict__ rs = F.RS() + o0;
        f32x4 u[15];
#pragma unroll
        for (int c = 0; c < 15; ++c) { const v2u r = *(const v2u*)(ru + (size_t)c * 65536); u[c] = (f32x4){bf_lo(r.x), bf_hi(r.x), bf_lo(r.y), bf_hi(r.y)}; }
#pragma unroll
        for (int c = 0; c < 16; ++c) { *(unsigned long long*)(rs + (size_t)c * 65536) = (unsigned long long)pkbf(s[0], s[1]) | ((unsigned long long)pkbf(s[2], s[3]) << 32);
            if (c < 15) s = s * cd + u[c]; } }
}
DI void ret_C(Frame& F, int l, int unit2) {
    const int half = unit2 & 1, unit = unit2 >> 1, c = unit & 15, bh = unit >> 4, h = bh & 3, b = bh >> 2, lane = F.lane(), w = F.wave(), gq = lane >> 4, l15 = lane & 15;
    const size_t t0 = (size_t)b * SEQ + c * 256;
    const int il = half * 128 + w * 16 + l15;
    const float lg = log1pf(-exp2f(-5.f - (float)h));
    const bf16* St = F.RS() + (size_t)unit * 65536;
    const bf16* Kp = F.P() + t0 * NPJ + C_RK + h * 256; const bf16* Vp = F.P() + t0 * NPJ + C_RV + h * 256;
    LAS unsigned char* B0 = F.lds; LAS unsigned char* B1 = F.lds + 65536;
    if (c > 0) dma_tile256(St, 256, B0, w, lane); else { dma_tile256(Kp, NPJ, B0, w, lane); dma_tile256(Vp, NPJ, B0 + 32768, w, lane); }
    const bf16* Qp = F.P() + (t0 + il) * NPJ + C_RQ + h * 256;
    bf16x8 Q[8];
#pragma unroll
    for (int ks = 0; ks < 8; ++ks) Q[ks] = *(const bf16x8*)(Qp + 32 * ks + 8 * gq);
    f32x4 acc[16];
#pragma unroll
    for (int v = 0; v < 16; ++v) acc[v] = (f32x4){0.f, 0.f, 0.f, 0.f};
    const int njt = 2 * (half + 1);
    float gp[8]; const float kb = __expf(-lg * (float)(8 * gq)) * 0.0625f;
#pragma unroll
    for (int e = 0; e < 8; ++e) gp[e] = __builtin_bit_cast(float, __builtin_amdgcn_readfirstlane(__builtin_bit_cast(int, __expf(-lg * (float)e))));
    VM_WAIT(); __syncthreads();
    int par = 0;
    if (c > 0) {
#pragma unroll
        for (int sp = 0; sp < 4; ++sp) {
            LAS unsigned char* cur = (sp & 1) ? B1 : B0; LAS unsigned char* nxt = (sp & 1) ? B0 : B1;
            if (sp < 3) dma_tile256(St + (size_t)(64 * (sp + 1)) * 256, 256, nxt, w, lane); else { dma_tile256(Kp, NPJ, nxt, w, lane); dma_tile256(Vp, NPJ, nxt + 32768, w, lane); }
#pragma unroll
            for (int ks = 0; ks < 8; ++ks)
#pragma unroll
                for (int vt = 0; vt < 4; ++vt) acc[4 * sp + vt] = mfma16(frag_row_sw512(cur, 16 * vt + l15, 4 * ks + gq), Q[ks], acc[4 * sp + vt]);
            VM_WAIT(); __syncthreads();
        }
        const float qd = __expf(lg * (float)(il + 1));
#pragma unroll
        for (int v = 0; v < 16; ++v) acc[v] *= qd;
        par = 0;
    }
    for (int jt = 0; jt < njt; ++jt) {
        LAS unsigned char* cur = ((jt + par) & 1) ? B1 : B0; LAS unsigned char* nxt = ((jt + par) & 1) ? B0 : B1;
        if (jt + 1 < njt) { dma_tile256(Kp + (size_t)(64 * (jt + 1)) * NPJ, NPJ, nxt, w, lane); dma_tile256(Vp + (size_t)(64 * (jt + 1)) * NPJ, NPJ, nxt + 32768, w, lane); }
        if (64 * jt <= half * 128 + w * 16 + 15) {
            const LAS unsigned char* Kt = cur; const LAS unsigned char* Vt = cur + 32768;
#pragma unroll
            for (int js = 0; js < 2; ++js) {
                f32x4 s0 = (f32x4){0.f, 0.f, 0.f, 0.f}, s1 = s0, s0b = s0, s1b = s0;
                const int kr0 = 32 * js + 8 * (l15 >> 2) + (l15 & 3), kr1 = kr0 + 4;
#pragma unroll
                for (int ks = 0; ks < 8; ks += 2) { s0 = mfma16(frag_row_sw512(Kt, kr0, 4 * ks + gq), Q[ks], s0); s1 = mfma16(frag_row_sw512(Kt, kr1, 4 * ks + gq), Q[ks], s1);
                    s0b = mfma16(frag_row_sw512(Kt, kr0, 4 * ks + 4 + gq), Q[ks + 1], s0b); s1b = mfma16(frag_row_sw512(Kt, kr1, 4 * ks + 4 + gq), Q[ks + 1], s1b); }
                s0 += s0b; s1 += s1b;
                float p[8]; const int jbase = 64 * jt + 32 * js; const float rowf = __expf(lg * (float)(il - jbase)) * kb;
#pragma unroll
                for (int e = 0; e < 8; ++e) { const float sv = (e < 4) ? s0[e & 3] : s1[e & 3]; p[e] = sv * gp[e] * rowf; }
                if (jbase + 31 > half * 128 + w * 16) {
#pragma unroll
                    for (int e = 0; e < 8; ++e) p[e] = (il >= jbase + 8 * gq + e) ? p[e] : 0.f; }
                const bf16x8 Pf = pack8f(p);
#pragma unroll
                for (int vt = 0; vt < 16; ++vt) acc[vt] = mfma16(frag_tr_sw512(Vt, 32 * js + 8 * gq, 32 * js + 8 * gq + 4, 16 * vt, lane), Pf, acc[vt]);
            }
        }
        VM_WAIT(); __syncthreads();
    }
    float ss = 0.f;
#pragma unroll
    for (int v = 0; v < 16; ++v) ss += (acc[v][0] * acc[v][0] + acc[v][1] * acc[v][1]) + (acc[v][2] * acc[v][2] + acc[v][3] * acc[v][3]);
    ss += __shfl_xor(ss, 16); ss += __shfl_xor(ss, 32);
    const float rms = rsqrtf(ss * (1.0f / 256.0f) + EPS);
    const float* gw = F.in(3) + l * 1024 + h * 256; const bf16* Gp = F.P() + (t0 + il) * NPJ + C_RG + h * 256; bf16* Yp = F.Y() + (t0 + il) * DM + 0 + h * 256;
#pragma unroll
    for (int vt = 0; vt < 16; ++vt) { const int v = 16 * vt + 4 * gq; const v2u gv = *(const v2u*)(Gp + v); const f32x4 w4 = *(const f32x4*)(gw + v);
        const float y0 = acc[vt][0] * rms * w4[0] * silu(bf_lo(gv.x)), y1 = acc[vt][1] * rms * w4[1] * silu(bf_hi(gv.x)), y2 = acc[vt][2] * rms * w4[2] * silu(bf_lo(gv.y)), y3 = acc[vt][3] * rms * w4[3] * silu(bf_hi(gv.y));
        v2u o; o.x = pkbf(y0, y1); o.y = pkbf(y2, y3); *(v2u*)(Yp + v) = o; }
}

DI void moba_kmean(Frame& F, int unit) {
    const int blk = unit & 15, bh = unit >> 4, h = bh & 7, b = bh >> 3, tid = F.tid(), ch = tid & 15, rg = tid >> 4;
    const bf16* Kp = F.P() + ((size_t)b * SEQ + blk * 256 + rg) * NPJ + C_MK + h * 128 + ch * 8;
    v4u raw[8];
#pragma unroll
    for (int i = 0; i < 8; ++i) raw[i] = *(const v4u*)(Kp + (size_t)(32 * i) * NPJ);
    float s[8] = {0.f, 0.f, 0.f, 0.f, 0.f, 0.f, 0.f, 0.f}; float r2max = 0.f;
#pragma unroll
    for (int i = 0; i < 8; ++i) { float f[8]; unpack8(raw[i], f); float r2 = 0.f;
#pragma unroll
        for (int e = 0; e < 8; ++e) { s[e] += f[e]; r2 += f[e] * f[e]; }
        r2 += __shfl_xor(r2, 1); r2 += __shfl_xor(r2, 2); r2 += __shfl_xor(r2, 4); r2 += __shfl_xor(r2, 8);
        r2max = fmaxf(r2max, r2); }
    LAS float* red = (LAS float*)F.lds;
    __syncthreads();
    *(LAS f32x4*)(red + rg * 128 + ch * 8) = (f32x4){s[0], s[1], s[2], s[3]}; *(LAS f32x4*)(red + rg * 128 + ch * 8 + 4) = (f32x4){s[4], s[5], s[6], s[7]};
    if (ch == 0) red[4096 + rg] = r2max;
    __syncthreads();
    if (tid < 32) { float m = red[4096 + tid]; m = fmaxf(m, __shfl_xor(m, 1)); m = fmaxf(m, __shfl_xor(m, 2)); m = fmaxf(m, __shfl_xor(m, 4)); m = fmaxf(m, __shfl_xor(m, 8)); m = fmaxf(m, __shfl_xor(m, 16));
        if (tid == 0) F.KMX()[unit] = m; }
    if (tid < 128) { float t = 0.f;
#pragma unroll
        for (int g = 0; g < 32; ++g) t += red[g * 128 + tid];
        const float km = t * (1.0f / 256.0f);
        const unsigned hi = f2bf(km); const float rem = km - __uint_as_float(hi << 16);
        F.KMH()[(size_t)unit * 128 + tid] = (bf16)hi; F.KML()[(size_t)unit * 128 + tid] = (bf16)f2bf(rem); }
}
struct MobaSt {
    bf16x8 Q[2][4]; f32x4 acc[2][8]; f32x4 accl[2]; float m_ref[2], cq[2], kbias[8]; unsigned mym[2], wm;
    const LAS unsigned char* kptr[2][4]; const LAS unsigned char* vptr[2][8];
    unsigned voff[2]; const char* gK; LAS unsigned char* hb; bf16x8 ones;
    float scale2, slope2; int ob, qrel_hi, qpos0, w8, gq;
};
DI void moba_dma(const MobaSt& S, int tt, int bufoff) {
    const char* g = S.gK + (size_t)tt * (64 * NPJ * 2);
#pragma unroll
    for (int i = 0; i < 2; ++i) { LAS unsigned char* d = S.hb + bufoff + (S.w8 * 2 + i) * 1024;
        __builtin_amdgcn_global_load_lds((const unsigned*)(g + S.voff[i]), (LAS unsigned*)d, 16, 0, 0);
        __builtin_amdgcn_global_load_lds((const unsigned*)(g + (C_MV - C_MK) * 2 + S.voff[i]), (LAS unsigned*)(d + 16384), 16, 0, 0); }
}
template <int BUF> DI void moba_tile(MobaSt& S, int tt) {
    const int kb = tt >> 2, tile = tt & 3;
    if (!(((S.wm >> kb) & 1u) && (kb < S.ob || 64 * tile <= S.qrel_hi))) return;
    const bool own = (kb == S.ob);
#pragma unroll
    for (int js = 0; js < 2; ++js) {
        f32x4 s[2][2];
#pragma unroll
        for (int qi = 0; qi < 2; ++qi) { s[qi][0] = (f32x4){0.f, 0.f, 0.f, 0.f}; s[qi][1] = s[qi][0]; }
#pragma unroll
        for (int ks = 0; ks < 4; ++ks) {
            const bf16x8 K0 = *(const LAS bf16x8*)(S.kptr[0][ks] + BUF + 8192 * js), K1 = *(const LAS bf16x8*)(S.kptr[1][ks] + BUF + 8192 * js);
#pragma unroll
            for (int qi = 0; qi < 2; ++qi) { s[qi][0] = mfma16(K0, S.Q[qi][ks], s[qi][0]); s[qi][1] = mfma16(K1, S.Q[qi][ks], s[qi][1]); } }
        bf16x8 Pf[2];
        const float basef = S.slope2 * (float)(tt * 64 + 32 * js);
#pragma unroll
        for (int qi = 0; qi < 2; ++qi) {
            float t0 = basef - S.cq[qi] - S.m_ref[qi]; t0 = ((S.mym[qi] >> kb) & 1u) ? t0 : -INFINITY;
            float p[8]; float mx;
#pragma unroll
            for (int e = 0; e < 8; ++e) { const float sv = (e < 4) ? s[qi][0][e & 3] : s[qi][1][e & 3]; p[e] = sv * S.scale2 + (t0 + S.kbias[e]); }
            if (own) { const int kp = tt * 64 + 32 * js + 8 * S.gq, qp = S.qpos0 + 16 * qi;
#pragma unroll
                for (int e = 0; e < 8; ++e) p[e] = (kp + e <= qp) ? p[e] : -INFINITY; }
            mx = fmaxf(fmaxf(fmaxf(p[0], p[1]), fmaxf(p[2], p[3])), fmaxf(fmaxf(p[4], p[5]), fmaxf(p[6], p[7])));
            if (__any(mx > 8.0f)) {
                mx = fmaxf(mx, __shfl_xor(mx, 16)); mx = fmaxf(mx, __shfl_xor(mx, 32));
                const float d = fmaxf(mx, 0.f), alpha = __builtin_amdgcn_exp2f(-d);
                S.m_ref[qi] += d; S.accl[qi] *= alpha;
#pragma unroll
                for (int v = 0; v < 8; ++v) S.acc[qi][v] *= alpha;
#pragma unroll
                for (int e = 0; e < 8; ++e) p[e] -= d; }
#pragma unroll
            for (int e = 0; e < 8; ++e) p[e] = __builtin_amdgcn_exp2f(p[e]);
            Pf[qi] = pack8f(p); }
#pragma unroll
        for (int vt = 0; vt < 8; ++vt) {
            const s16x4 lo = __builtin_bit_cast(s16x4, __builtin_amdgcn_ds_read_tr16_b64_v4i16((LAS v4i16_t*)(S.vptr[0][vt] + BUF + 8192 * js)));
            const s16x4 hi = __builtin_bit_cast(s16x4, __builtin_amdgcn_ds_read_tr16_b64_v4i16((LAS v4i16_t*)(S.vptr[1][vt] + BUF + 8192 * js)));
            bf16x8 Vf; Vf[0] = lo[0]; Vf[1] = lo[1]; Vf[2] = lo[2]; Vf[3] = lo[3]; Vf[4] = hi[0]; Vf[5] = hi[1]; Vf[6] = hi[2]; Vf[7] = hi[3];
            S.acc[0][vt] = mfma16(Vf, Pf[0], S.acc[0][vt]); S.acc[1][vt] = mfma16(Vf, Pf[1], S.acc[1][vt]); }
        S.accl[0] = mfma16(S.ones, Pf[0], S.accl[0]); S.accl[1] = mfma16(S.ones, Pf[1], S.accl[1]);
    }
}
DI void moba_attn(Frame& F, int ob, int bh) {
    const int lane = F.lane(), w = F.wave(), gq = lane >> 4, l15 = lane & 15;
    const int h = bh & 7, b = bh >> 3;
    const size_t tq = (size_t)b * SEQ + ob * 256 + w * 32;
    MobaSt S;
    S.ob = ob; S.w8 = w; S.gq = gq; S.hb = F.lds;
    S.scale2 = 0.08838834764831845f * 1.4426950408889634f; S.slope2 = exp2f(-(float)(h + 1)) * 1.4426950408889634f;
#pragma unroll
    for (int qi = 0; qi < 2; ++qi)
#pragma unroll
        for (int ks = 0; ks < 4; ++ks) S.Q[qi][ks] = *(const bf16x8*)(F.P() + (tq + qi * 16 + l15) * NPJ + C_MQ + h * 128 + 32 * ks + 8 * gq);
    { bf16x8 KH[4], KL[4];
#pragma unroll
      for (int ks = 0; ks < 4; ++ks) { KH[ks] = *(const bf16x8*)(F.KMH() + ((size_t)bh * 16 + l15) * 128 + 32 * ks + 8 * gq); KL[ks] = *(const bf16x8*)(F.KML() + ((size_t)bh * 16 + l15) * 128 + 32 * ks + 8 * gq); }
#pragma unroll
      for (int qi = 0; qi < 2; ++qi) { f32x4 g = (f32x4){0.f, 0.f, 0.f, 0.f};
#pragma unroll
          for (int ks = 0; ks < 4; ++ks) { g = mfma16(KH[ks], S.Q[qi][ks], g); g = mfma16(KL[ks], S.Q[qi][ks], g); }
          float gv[4];
#pragma unroll
          for (int r = 0; r < 4; ++r) gv[r] = (4 * gq + r < ob) ? g[r] : -INFINITY;
          unsigned mask = 0u;
#pragma unroll
          for (int pass = 0; pass < 3; ++pass) { float bv = -INFINITY; int bn = 31;
#pragma unroll
              for (int r = 0; r < 4; ++r) { const int n = 4 * gq + r; if (!((mask >> n) & 1u) && gv[r] > bv) { bv = gv[r]; bn = n; } }
#pragma unroll
              for (int off = 16; off <= 32; off <<= 1) { const float ov = __shfl_xor(bv, off); const int on = __shfl_xor(bn, off); if (ov > bv || (ov == bv && on < bn)) { bv = ov; bn = on; } }
              if (bv > -INFINITY) mask |= 1u << bn; }
          S.mym[qi] = mask | (1u << ob); } }
    { unsigned wm = S.mym[0] | S.mym[1]; wm |= __shfl_xor(wm, 1); wm |= __shfl_xor(wm, 2); wm |= __shfl_xor(wm, 4); wm |= __shfl_xor(wm, 8); S.wm = __builtin_amdgcn_readfirstlane(wm); }
#pragma unroll
    for (int qi = 0; qi < 2; ++qi) { const bf16* kp = F.P() + (tq + qi * 16 + l15) * NPJ + C_MK + h * 128 + 8 * gq; float d = 0.f;
#pragma unroll
        for (int ks = 0; ks < 4; ++ks) { float kf[8], qf[8]; unpack8(*(const v4u*)(kp + 32 * ks), kf); unpack8(__builtin_bit_cast(v4u, S.Q[qi][ks]), qf);
#pragma unroll
            for (int e = 0; e < 8; ++e) d += kf[e] * qf[e]; }
        d += __shfl_xor(d, 16); d += __shfl_xor(d, 32); S.m_ref[qi] = d * S.scale2; }
    const int qrel0 = w * 32 + l15; S.qpos0 = ob * 256 + qrel0; S.qrel_hi = w * 32 + 31;
    S.cq[0] = S.slope2 * (float)S.qpos0; S.cq[1] = S.slope2 * (float)(S.qpos0 + 16);
#pragma unroll
    for (int e = 0; e < 8; ++e) S.kbias[e] = S.slope2 * (float)(8 * gq + e);
#pragma unroll
    for (int qi = 0; qi < 2; ++qi) { S.accl[qi] = (f32x4){0.f, 0.f, 0.f, 0.f};
#pragma unroll
        for (int v = 0; v < 8; ++v) S.acc[qi][v] = (f32x4){0.f, 0.f, 0.f, 0.f}; }
    { const short one = (l15 == 0) ? (short)0x3F80 : (short)0;
#pragma unroll
      for (int e = 0; e < 8; ++e) S.ones[e] = one; }
#pragma unroll
    for (int sub = 0; sub < 2; ++sub) { const int row = 8 * (l15 >> 2) + 4 * sub + (l15 & 3);
#pragma unroll
        for (int ks = 0; ks < 4; ++ks) S.kptr[sub][ks] = S.hb + 256 * row + 16 * ((4 * ks + gq) ^ swz(row)); }
    { const int q = l15 >> 2, pp = lane & 3;
#pragma unroll
      for (int t = 0; t < 2; ++t) { const int row = 8 * gq + 4 * t + q;
#pragma unroll
          for (int vt = 0; vt < 8; ++vt) S.vptr[t][vt] = S.hb + 16384 + 256 * row + 16 * ((2 * vt + (pp >> 1)) ^ swz(row)) + 8 * (pp & 1); } }
#pragma unroll
    for (int i = 0; i < 2; ++i) { const int row = 4 * (w * 2 + i) + (lane >> 4), c = (lane & 15) ^ swz(row); S.voff[i] = (unsigned)(row * NPJ + c * 8) * 2u; }
    S.gK = (const char*)(F.P() + (size_t)b * SEQ * NPJ + h * 128 + C_MK);
    const int NT = ob * 4 + 4;
    { float q2 = 0.f;
#pragma unroll
      for (int qi = 0; qi < 2; ++qi) { float ss = 0.f;
#pragma unroll
          for (int ks = 0; ks < 4; ++ks) { float qf[8]; unpack8(__builtin_bit_cast(v4u, S.Q[qi][ks]), qf);
#pragma unroll
              for (int e = 0; e < 8; ++e) ss += qf[e] * qf[e]; }
          ss += __shfl_xor(ss, 16); ss += __shfl_xor(ss, 32); q2 = fmaxf(q2, ss); }
      q2 = fmaxf(q2, __shfl_xor(q2, 1)); q2 = fmaxf(q2, __shfl_xor(q2, 2)); q2 = fmaxf(q2, __shfl_xor(q2, 4)); q2 = fmaxf(q2, __shfl_xor(q2, 8));
      const float qn = sqrtf(q2) * 1.01f, kown = sqrtf(F.KMX()[bh * 16 + ob]) * 1.01f, kj = sqrtf(F.KMX()[bh * 16 + l15]) * 1.01f;
      const float dist = (float)(ob * 256 + w * 32 - (256 * l15 + 255));
      const bool zero = (l15 < ob) && (qn * (kj + kown) * S.scale2 - S.slope2 * dist < -138.0f);
      const unsigned zmask = (unsigned)(__ballot(zero) & 0xFFFFull);
      S.wm &= ~zmask;
      const int lead = __builtin_ctz(~zmask);
      if (lane == 0) ((volatile LAS int*)(F.lds + LDSCTL_OFF + 512))[w] = lead; }
    __syncthreads();
    int T0;
    { volatile LAS int* le = (volatile LAS int*)(F.lds + LDSCTL_OFF + 512); int m = le[0];
#pragma unroll
      for (int k = 1; k < 8; ++k) m = min(m, le[k]);
      T0 = 4 * __builtin_amdgcn_readfirstlane(m); }
    moba_dma(S, T0, 0);
    VM_WAIT(); __syncthreads();
    for (int tt = T0; tt < NT; tt += 2) {
        moba_dma(S, tt + 1, 32768);
        moba_tile<0>(S, tt);
        VM_WAIT(); __syncthreads();
        if (tt + 2 < NT) moba_dma(S, tt + 2, 0);
        moba_tile<32768>(S, tt + 1);
        VM_WAIT(); __syncthreads();
    }
#pragma unroll
    for (int qi = 0; qi < 2; ++qi) { const float lt = __shfl(S.accl[qi][0], l15); const float inv = 1.0f / lt; const size_t ti = tq + qi * 16 + l15;
        const bf16* Gp = F.P() + ti * NPJ + C_MG + h * 128; bf16* Yp = F.Y() + ti * DM + 1024 + h * 128;
#pragma unroll
        for (int vt = 0; vt < 8; ++vt) { const int v = 16 * vt + 4 * gq; const v2u gv = *(const v2u*)(Gp + v);
            const float y0 = S.acc[qi][vt][0] * inv * silu(bf_lo(gv.x)), y1 = S.acc[qi][vt][1] * inv * silu(bf_hi(gv.x)), y2 = S.acc[qi][vt][2] * inv * silu(bf_lo(gv.y)), y3 = S.acc[qi][vt][3] * inv * silu(bf_hi(gv.y));
            v2u o; o.x = pkbf(y0, y1); o.y = pkbf(y2, y3); *(v2u*)(Yp + v) = o; } }
}

DI void ssd_A(Frame& F, int l, int unit) {
    const int grp = unit & 3, bc = unit >> 2, c = bc & 15, b = bc >> 4, tid = F.tid(), lane = F.lane(), w = F.wave(), gq = lane >> 4;
    const size_t t0 = (size_t)b * SEQ + c * 256;
    LAS float* dtl = (LAS float*)F.lds; LAS float* dacs = dtl + 1024; LAS float* fac = dtl + 2048;
    LAS unsigned char* Bt = F.lds + 12288; LAS unsigned char* XWt = Bt + 64 * SB128;
    __syncthreads();
    for (int idx = tid; idx < 1024; idx += NTHR) { const int r = idx >> 8, t = idx & 255, head = 4 * grp + r;
        const float raw = F.DTRAW()[(t0 + t) * 16 + head] + F.in(6)[l * 16 + head]; const float dt = softplus(raw), a = -__expf(F.in(7)[l * 16 + head]);
        dtl[idx] = dt; dacs[idx] = dt * a; }
    __syncthreads();
    if (w < 4) { float x0 = dacs[w * 256 + 4 * lane], x1 = dacs[w * 256 + 4 * lane + 1], x2 = dacs[w * 256 + 4 * lane + 2], x3 = dacs[w * 256 + 4 * lane + 3];
        x1 += x0; x2 += x1; x3 += x2; float tot = x3;
#pragma unroll
        for (int o = 1; o < 64; o <<= 1) { const float y = __shfl_up(tot, o); if (lane >= o) tot += y; }
        const float ex = tot - x3;
        dacs[w * 256 + 4 * lane] = x0 + ex; dacs[w * 256 + 4 * lane + 1] = x1 + ex; dacs[w * 256 + 4 * lane + 2] = x2 + ex; dacs[w * 256 + 4 * lane + 3] = x3 + ex; }
    __syncthreads();
    for (int idx = tid; idx < 1024; idx += NTHR) { const int r = idx >> 8, t = idx & 255, head = 4 * grp + r; const float dc = dacs[idx], dt = dtl[idx];
        fac[idx] = __expf(dacs[r * 256 + 255] - dc) * dt; F.DT()[(t0 + t) * 16 + head] = dt; F.DACS()[(t0 + t) * 16 + head] = dc * 1.4426950408889634f; }
    f32x4 acc[16];
#pragma unroll
    for (int v = 0; v < 16; ++v) acc[v] = (f32x4){0.f, 0.f, 0.f, 0.f};
    const int cc = tid & 63, tg = tid >> 6;
    const int chn = cc < 32 ? grp * 256 + cc * 8 : (cc < 48 ? 1024 + grp * 128 + (cc - 32) * 8 : 1536 + grp * 128 + (cc - 48) * 8);
    float cw[4][8], cb[8];
#pragma unroll
    for (int k = 0; k < 4; ++k) { const f32x4 a = *(const f32x4*)(F.in(4) + ((size_t)l * 4 + k) * 2048 + chn), bq = *(const f32x4*)(F.in(4) + ((size_t)l * 4 + k) * 2048 + chn + 4);
        cw[k][0] = a[0]; cw[k][1] = a[1]; cw[k][2] = a[2]; cw[k][3] = a[3]; cw[k][4] = bq[0]; cw[k][5] = bq[1]; cw[k][6] = bq[2]; cw[k][7] = bq[3]; }
    { const f32x4 a = *(const f32x4*)(F.in(5) + (size_t)l * 2048 + chn), bq = *(const f32x4*)(F.in(5) + (size_t)l * 2048 + chn + 4);
      cb[0] = a[0]; cb[1] = a[1]; cb[2] = a[2]; cb[3] = a[3]; cb[4] = bq[0]; cb[5] = bq[1]; cb[6] = bq[2]; cb[7] = bq[3]; }
    const bf16* Xp = F.P() + t0 * NPJ + C_SX + chn;
    for (int jt = 0; jt < 4; ++jt) {
        __syncthreads();
        { const int tl0 = jt * 64 + tg * 8; float h0[8], h1[8], h2[8];
          { const bool z = (c == 0 && tl0 < 3);
            if (z) {
#pragma unroll
                for (int e = 0; e < 8; ++e) { h0[e] = 0.f; h1[e] = 0.f; h2[e] = 0.f; }
            } else { unpack8(*(const v4u*)(Xp + ((long)tl0 - 3) * NPJ), h0); unpack8(*(const v4u*)(Xp + ((long)tl0 - 2) * NPJ), h1); unpack8(*(const v4u*)(Xp + ((long)tl0 - 1) * NPJ), h2); } }
          v4u xraw[8];
#pragma unroll
          for (int i = 0; i < 8; ++i) xraw[i] = *(const v4u*)(Xp + (size_t)(tl0 + i) * NPJ);
#pragma unroll
          for (int i = 0; i < 8; ++i) { const int tl = tl0 + i; float x[8], y[8]; unpack8(xraw[i], x);
#pragma unroll
              for (int e = 0; e < 8; ++e) { const float v = cb[e] + cw[0][e] * h0[e] + cw[1][e] * h1[e] + cw[2][e] * h2[e] + cw[3][e] * x[e]; y[e] = silu(v); h0[e] = h1[e]; h1[e] = h2[e]; h2[e] = x[e]; }
              *(v4u*)(F.XBC() + (t0 + tl) * 2048 + chn) = pack8(y);
              if (cc < 32) { const float f = fac[(cc >> 3) * 256 + tl];
#pragma unroll
                  for (int e = 0; e < 8; ++e) y[e] *= f;
                  *(LAS v4u*)(XWt + (tg * 8 + i) * SB256 + cc * 16) = pack8(y); }
              else if (cc < 48) *(LAS v4u*)(Bt + (tg * 8 + i) * SB128 + (cc - 32) * 16) = pack8(y); } }
        __syncthreads();
#pragma unroll
        for (int ks = 0; ks < 2; ++ks) { const int ra = 32 * ks + 8 * gq, rb = ra + 4; const bf16x8 A = frag_tr(Bt, SB128, ra, rb, 16 * w, lane);
#pragma unroll
            for (int pt = 0; pt < 16; ++pt) acc[pt] = mfma16(A, frag_tr(XWt, SB256, ra, rb, 16 * pt, lane), acc[pt]); }
    }
#pragma unroll
    for (int pt = 0; pt < 16; ++pt) { const int head = 4 * grp + (pt >> 2); float* S = F.SST() + ((size_t)bc * 16 + head) * 8192;
        *(f32x4*)(S + ((pt & 3) * 16 + (lane & 15)) * 128 + 16 * w + 4 * gq) = acc[pt]; }
}
DI void ssd_B(Frame& F) {
    for (int it = blockIdx.x * NTHR + F.tid(); it < 32 * 2048; it += F.G() * NTHR) { const int e4 = it & 2047, bhd = it >> 11, head = bhd & 15, b = bhd >> 4; f32x4 s = (f32x4){0.f, 0.f, 0.f, 0.f};
        const size_t o0 = ((size_t)(b * 16) * 16 + head) * 8192 + (size_t)e4 * 4; const float* __restrict__ st = F.SST() + o0; bf16* __restrict__ hp = F.SHP() + o0;
        f32x4 u[15]; float dec[15];
#pragma unroll
        for (int c = 0; c < 15; ++c) { u[c] = *(const f32x4*)(st + (size_t)c * 16 * 8192); dec[c] = F.DACS()[((size_t)b * SEQ + c * 256 + 255) * 16 + head]; }
#pragma unroll
        for (int c = 0; c < 16; ++c) { *(unsigned long long*)(hp + (size_t)c * 16 * 8192) = (unsigned long long)pkbf(s[0], s[1]) | ((unsigned long long)pkbf(s[2], s[3]) << 32);
            if (c < 15) s = s * __builtin_amdgcn_exp2f(dec[c]) + u[c]; } }
}
template <int NROWS> DI void dma_rows128(const bf16* src, size_t gp, LAS unsigned char* dst, int w, int lane) {
#pragma unroll
    for (int i = 0; i < NROWS / 32; ++i) { const int idx = w * (NROWS / 32) + i, row = 4 * idx + (lane >> 4), c = (lane & 15) ^ swz(row);
        __builtin_amdgcn_global_load_lds((const unsigned*)(src + (size_t)row * gp + c * 8), (LAS unsigned*)(dst + idx * 1024), 16, 0, 0); }
}
DI bf16x8 frag_row_sw256(const LAS unsigned char* t, int row, int ch) { return *(const LAS bf16x8*)(t + 256 * row + 16 * (ch ^ swz(row))); }
constexpr int SC_B = 0, SC_X = 16384, SC_DA = 49152, SC_DT = 50176;
DI void ssd_dma_tile(Frame& F, size_t trow, int grp, LAS unsigned char* buf, int w, int lane) {
    dma_rows128<64>(F.XBC() + trow * 2048 + 1024 + grp * 128, 2048, buf + SC_B, w, lane);
    dma_tile256(F.XBC() + trow * 2048 + grp * 256, 2048, buf + SC_X, w, lane);
    if (w == 0) __builtin_amdgcn_global_load_lds((const unsigned*)(F.DACS() + (trow + lane) * 16 + 4 * grp), (LAS unsigned*)(buf + SC_DA), 16, 0, 0);
    if (w == 1) __builtin_amdgcn_global_load_lds((const unsigned*)(F.DT() + (trow + lane) * 16 + 4 * grp), (LAS unsigned*)(buf + SC_DT), 16, 0, 0);
}
DI void ssd_C(Frame& F, int l, int unit2) {
    const int half = unit2 & 1, unit = unit2 >> 1, grp = unit & 3, bc = unit >> 2, c = bc & 15, b = bc >> 4, lane = F.lane(), w = F.wave(), gq = lane >> 4, l15 = lane & 15;
    const size_t t0 = (size_t)b * SEQ + c * 256; const int il = half * 128 + w * 16 + l15; const size_t ti = t0 + il;
    LAS unsigned char* B0 = F.lds; LAS unsigned char* B1 = F.lds + 65536;
    if (c > 0) dma_rows128<256>(F.SHP() + ((size_t)bc * 16 + 4 * grp) * 8192, 128, B0, w, lane); else ssd_dma_tile(F, t0, grp, B0, w, lane);
    bf16x8 Cf[4];
#pragma unroll
    for (int ks = 0; ks < 4; ++ks) Cf[ks] = *(const bf16x8*)(F.XBC() + ti * 2048 + 1536 + grp * 128 + 32 * ks + 8 * gq);
    f32x4 acc[4][4]; float dci[4];
    { const f32x4 d4 = *(const f32x4*)(F.DACS() + ti * 16 + 4 * grp); dci[0] = d4[0]; dci[1] = d4[1]; dci[2] = d4[2]; dci[3] = d4[3]; }
#pragma unroll
    for (int r = 0; r < 4; ++r)
#pragma unroll
        for (int pt = 0; pt < 4; ++pt) acc[r][pt] = (f32x4){0.f, 0.f, 0.f, 0.f};
    const int njt = 2 * (half + 1);
    VM_WAIT(); __syncthreads();
    int par = 0;
    if (c > 0) {
        ssd_dma_tile(F, t0, grp, B1, w, lane);
#pragma unroll
        for (int r = 0; r < 4; ++r) {
#pragma unroll
            for (int ks = 0; ks < 4; ++ks)
#pragma unroll
                for (int pt = 0; pt < 4; ++pt) acc[r][pt] = mfma16(frag_row_sw256(B0, r * 64 + 16 * pt + l15, 4 * ks + gq), Cf[ks], acc[r][pt]);
            const float ed = __builtin_amdgcn_exp2f(dci[r]);
#pragma unroll
            for (int pt = 0; pt < 4; ++pt) acc[r][pt] *= ed; }
        VM_WAIT(); __syncthreads();
        par = 1;
    }
    for (int jt = 0; jt < njt; ++jt) {
        LAS unsigned char* cur = ((jt + par) & 1) ? B1 : B0; LAS unsigned char* nxt = ((jt + par) & 1) ? B0 : B1;
        if (jt + 1 < njt) ssd_dma_tile(F, t0 + 64 * (jt + 1), grp, nxt, w, lane);
        if (64 * jt <= half * 128 + w * 16 + 15) {
            int lz = lane; asm volatile("" : "+v"(lz));
            const int gq = lz >> 4, l15 = lz & 15, lane = lz;
            const bool diag = 64 * jt + 63 > half * 128 + w * 16;
#pragma unroll
            for (int js = 0; js < 2; ++js) {
                f32x4 s0 = (f32x4){0.f, 0.f, 0.f, 0.f}, s1 = s0, s0b = s0, s1b = s0;
                const int kr0 = 32 * js + 8 * (l15 >> 2) + (l15 & 3), kr1 = kr0 + 4;
#pragma unroll
                for (int ks = 0; ks < 4; ks += 2) { s0 = mfma16(frag_row_sw256(cur + SC_B, kr0, 4 * ks + gq), Cf[ks], s0); s1 = mfma16(frag_row_sw256(cur + SC_B, kr1, 4 * ks + gq), Cf[ks], s1);
                    s0b = mfma16(frag_row_sw256(cur + SC_B, kr0, 4 * ks + 4 + gq), Cf[ks + 1], s0b); s1b = mfma16(frag_row_sw256(cur + SC_B, kr1, 4 * ks + 4 + gq), Cf[ks + 1], s1b); }
                s0 += s0b; s1 += s1b;
                float p[4][8];
#pragma unroll
                for (int e = 0; e < 8; ++e) { const int j = 64 * jt + 32 * js + 8 * gq + e; const float sv = (e < 4) ? s0[e & 3] : s1[e & 3];
                    const f32x4 dj = *(const LAS f32x4*)(cur + SC_DA + (32 * js + 8 * gq + e) * 16), dtj = *(const LAS f32x4*)(cur + SC_DT + (32 * js + 8 * gq + e) * 16);
#pragma unroll
                    for (int r = 0; r < 4; ++r) { float ex = dci[r] - dj[r]; if (diag) ex = (il >= j) ? ex : -INFINITY; p[r][e] = sv * __builtin_amdgcn_exp2f(ex) * dtj[r]; } }
#pragma unroll
                for (int r = 0; r < 4; ++r) { const bf16x8 Pf = pack8f(p[r]);
#pragma unroll
                    for (int pt = 0; pt < 4; ++pt) acc[r][pt] = mfma16(frag_tr_sw512(cur + SC_X, 32 * js + 8 * gq, 32 * js + 8 * gq + 4, r * 64 + 16 * pt, lane), Pf, acc[r][pt]); }
            }
        }
        VM_WAIT(); __syncthreads();
    }
    float ss = 0.f;
    const bf16* xb = F.XBC() + ti * 2048 + grp * 256 + 4 * gq; const bf16* zb = F.P() + ti * NPJ + C_SZ + grp * 256 + 4 * gq;
#pragma unroll
    for (int r = 0; r < 4; ++r) { const float dsk = F.in(8)[l * 16 + 4 * grp + r];
#pragma unroll
        for (int pt = 0; pt < 4; ++pt) { const v2u xv = *(const v2u*)(xb + r * 64 + 16 * pt), zv = *(const v2u*)(zb + r * 64 + 16 * pt);
            f32x4 y = acc[r][pt]; y[0] = (y[0] + dsk * bf_lo(xv.x)) * silu(bf_lo(zv.x)); y[1] = (y[1] + dsk * bf_hi(xv.x)) * silu(bf_hi(zv.x)); y[2] = (y[2] + dsk * bf_lo(xv.y)) * silu(bf_lo(zv.y)); y[3] = (y[3] + dsk * bf_hi(xv.y)) * silu(bf_hi(zv.y));
            acc[r][pt] = y; ss += (y[0] * y[0] + y[1] * y[1]) + (y[2] * y[2] + y[3] * y[3]); }
        asm volatile("" ::: "memory"); }
    ss += __shfl_xor(ss, 16); ss += __shfl_xor(ss, 32);
    const float rms = rsqrtf(ss * (1.0f / 256.0f) + EPS);
    const float* nw = F.in(9) + (size_t)l * 1024 + grp * 256 + 4 * gq; bf16* yb = F.Y() + ti * DM + 2048 + grp * 256 + 4 * gq;
#pragma unroll
    for (int r = 0; r < 4; ++r)
#pragma unroll
        for (int pt = 0; pt < 4; ++pt) { const f32x4 w4 = *(const f32x4*)(nw + r * 64 + 16 * pt); const f32x4 y = acc[r][pt] * rms * w4;
            v2u o; o.x = pkbf(y[0], y[1]); o.y = pkbf(y[2], y[3]); *(v2u*)(yb + r * 64 + 16 * pt) = o; }
}

DI void lru_A(Frame& F, int l, int unit) {
    const int nb = unit & 7, bc = unit >> 3, c256 = bc & 15, b = bc >> 4, tid = F.tid(), lane = F.lane(), w = F.wave(), gq = lane >> 4;
    const int chn0 = nb * 128;
    LAS float* xcf = (LAS float*)F.lds; LAS float* al = xcf + 8192; LAS unsigned char* xcb = F.lds + 65536;
    LAS float* sh = (LAS float*)(F.lds + 65536 + 64 * SB128); LAS float* sa = sh + 512;
    const int ch8 = tid & 15, tg = tid >> 4, chn = chn0 + ch8 * 8, tl0 = tg * 2; float cw[4][8], cb[8];
#pragma unroll
    for (int k = 0; k < 4; ++k) { const f32x4 a = *(const f32x4*)(F.in(10) + ((size_t)l * 4 + k) * 1024 + chn), bq = *(const f32x4*)(F.in(10) + ((size_t)l * 4 + k) * 1024 + chn + 4);
        cw[k][0] = a[0]; cw[k][1] = a[1]; cw[k][2] = a[2]; cw[k][3] = a[3]; cw[k][4] = bq[0]; cw[k][5] = bq[1]; cw[k][6] = bq[2]; cw[k][7] = bq[3]; }
    { const f32x4 a = *(const f32x4*)(F.in(11) + (size_t)l * 1024 + chn), bq = *(const f32x4*)(F.in(11) + (size_t)l * 1024 + chn + 4);
      cb[0] = a[0]; cb[1] = a[1]; cb[2] = a[2]; cb[3] = a[3]; cb[4] = bq[0]; cb[5] = bq[1]; cb[6] = bq[2]; cb[7] = bq[3]; }
    const int eg = 16 * w + (lane & 15), chg = chn0 + eg;
    bf16x8 Ba[4], Bx[4];
    { const bf16* WTa = F.LRUW() + ((((size_t)l * 2 + 0) * 8 + nb) * 128 + eg) * 128; const bf16* WTx = F.LRUW() + ((((size_t)l * 2 + 1) * 8 + nb) * 128 + eg) * 128;
#pragma unroll
      for (int ks = 0; ks < 4; ++ks) { Ba[ks] = *(const bf16x8*)(WTa + 32 * ks + 8 * gq); Bx[ks] = *(const bf16x8*)(WTx + 32 * ks + 8 * gq); } }
    const float ba = F.in(13)[l * 1024 + chg], bx = F.in(15)[l * 1024 + chg], spl = softplus(-F.in(16)[l * 1024 + chg]);
    const size_t tu = (size_t)b * SEQ + c256 * 256;
    const bf16* Xp0 = F.P() + tu * NPJ + C_LX + chn;
    v4u raw[5];
#pragma unroll
    for (int k = 0; k < 5; ++k) { const int tl = tl0 - 3 + k; raw[k] = (c256 == 0 && tl < 0) ? (v4u){0u, 0u, 0u, 0u} : *(const v4u*)(Xp0 + (long)tl * NPJ); }
    for (int sc = 0; sc < 4; ++sc) {
        const int cc = c256 * 4 + sc, bcc = b * 64 + cc; const size_t t0 = tu + sc * 64;
        float xr[5][8];
#pragma unroll
        for (int k = 0; k < 5; ++k) unpack8(raw[k], xr[k]);
        if (sc < 3) {
#pragma unroll
            for (int k = 0; k < 5; ++k) raw[k] = *(const v4u*)(Xp0 + (long)((sc + 1) * 64 + tl0 - 3 + k) * NPJ); }
        __syncthreads();
#pragma unroll
        for (int i = 0; i < 2; ++i) { float y[8];
#pragma unroll
            for (int e = 0; e < 8; ++e) y[e] = cb[e] + cw[0][e] * xr[i][e] + cw[1][e] * xr[i + 1][e] + cw[2][e] * xr[i + 2][e] + cw[3][e] * xr[i + 3][e];
            *(LAS f32x4*)(xcf + (tl0 + i) * 128 + ch8 * 8) = (f32x4){y[0], y[1], y[2], y[3]}; *(LAS f32x4*)(xcf + (tl0 + i) * 128 + ch8 * 8 + 4) = (f32x4){y[4], y[5], y[6], y[7]};
            *(LAS v4u*)(xcb + (tl0 + i) * SB128 + ch8 * 16) = pack8(y); }
        __syncthreads();
#pragma unroll
        for (int mt = 0; mt < 4; ++mt) { f32x4 ra = (f32x4){0.f, 0.f, 0.f, 0.f}, rx = ra;
#pragma unroll
            for (int ks = 0; ks < 4; ++ks) { const bf16x8 A = frag_row(xcb, SB128, 16 * mt, 32 * ks, lane); ra = mfma16(A, Ba[ks], ra); rx = mfma16(A, Bx[ks], rx); }
#pragma unroll
            for (int reg = 0; reg < 4; ++reg) { const int t = 16 * mt + 4 * gq + reg; const float r_ = sigm(ra[reg] + ba), i_ = sigm(rx[reg] + bx), la = -8.0f * r_ * spl;
                const float a = __expf(la), u = __builtin_amdgcn_sqrtf(one_minus_exp(2.0f * la)) * i_ * xcf[t * 128 + eg]; al[t * 128 + eg] = a; xcf[t * 128 + eg] = u; } }
        __syncthreads();
        { const int e = tid & 127, seg = tid >> 7, ch = chn0 + e; float hv[16], av[16]; float hh = 0.f, ap = 1.f;
#pragma unroll
          for (int t = 0; t < 16; ++t) { const float a = al[(seg * 16 + t) * 128 + e], u = xcf[(seg * 16 + t) * 128 + e]; hh = a * hh + u; ap *= a; hv[t] = hh; av[t] = ap; }
          sh[seg * 128 + e] = hh; sa[seg * 128 + e] = ap;
          __syncthreads();
          float cin = 0.f, ain = 1.f;
#pragma unroll
          for (int k = 0; k < 3; ++k) if (k < seg) { cin = sa[k * 128 + e] * cin + sh[k * 128 + e]; ain *= sa[k * 128 + e]; }
#pragma unroll
          for (int t = 0; t < 16; ++t) { const size_t o = (t0 + seg * 16 + t) * 1024 + ch; F.HLOC()[o] = (bf16)f2bf(hv[t] + av[t] * cin); F.ACUM()[o] = (bf16)f2bf(av[t] * ain); }
          if (seg == 3) { F.HEND()[(size_t)bcc * 1024 + ch] = hv[15] + av[15] * cin; F.AEND()[(size_t)bcc * 1024 + ch] = av[15] * ain; } }
    }
}
DI void lru_B(Frame& F) {
    for (int it = blockIdx.x * NTHR + F.tid(); it < 2048; it += F.G() * NTHR) { const int ch = it & 1023, b = it >> 10; float carry = 0.f;
        const float* __restrict__ ae = F.AEND() + (size_t)(b * 64) * 1024 + ch; const float* __restrict__ he = F.HEND() + (size_t)(b * 64) * 1024 + ch; float* __restrict__ cr = F.CARRY() + (size_t)(b * 64) * 1024 + ch;
        float a[64], hh[64];
#pragma unroll
        for (int k = 0; k < 64; ++k) { a[k] = ae[(size_t)k * 1024]; hh[k] = he[(size_t)k * 1024]; }
#pragma unroll
        for (int k = 0; k < 64; ++k) { cr[(size_t)k * 1024] = carry; carry = a[k] * carry + hh[k]; } }
}
DI void lru_C(Frame& F, int unit) {
    const size_t tb = (size_t)unit * 32;
#pragma unroll 4
    for (int idx = F.tid(); idx < 32 * 128; idx += NTHR) { const size_t t = tb + (idx >> 7); const int ch = (idx & 127) * 8; const int b = (int)(t / SEQ), cc = (int)(t % SEQ) >> 6;
        const float* cr = F.CARRY() + (size_t)(b * 64 + cc) * 1024 + ch;
        float hl[8], ac[8], g[8]; unpack8(*(const v4u*)(F.HLOC() + t * 1024 + ch), hl); unpack8(*(const v4u*)(F.ACUM() + t * 1024 + ch), ac); unpack8(*(const v4u*)(F.P() + t * NPJ + C_LG + ch), g);
        const f32x4 c0 = *(const f32x4*)cr, c1 = *(const f32x4*)(cr + 4);
        float y[8];
#pragma unroll
        for (int e = 0; e < 8; ++e) { const float cv = e < 4 ? c0[e & 3] : c1[e & 3]; y[e] = (hl[e] + ac[e] * cv) * silu(g[e]); }
        *(v4u*)(F.Y() + t * DM + 3072 + ch) = pack8(y); }
}

__global__ void __launch_bounds__(NTHR, 2) hymba_fwd(Args args) {
    extern __shared__ __attribute__((aligned(16))) unsigned char lds[];
    Frame F = mk_frame((LAS unsigned char*)lds, &args);
    for (int u = F.tid(); u < (LDS_BYTES - LDSCTL_OFF) / 4; u += NTHR) ((LAS unsigned*)(F.lds + LDSCTL_OFF))[u] = 0u;
    __syncthreads();
    const int lo = args.ph_lo, hi = args.ph_hi;
    XcdBarrier bar; bar.bar = F.ctl() + CW_BAR; bar.x = 0; bar.st = nullptr;
    if (hi - lo > 1) bar = xcd_barrier_post(F.ctl() + CW_BAR, F.MISC() + 8);
#define IN(k) (lo <= (k) && (k) < hi)
#define SEAM(k) do { if (IN(k) && IN((k) + 1)) xcd_barrier(bar); } while (0)

    if (IN(0)) { p0_prologue(F);
#ifdef PROBE_PRO2
        xcd_barrier(bar); p0_prologue(F);
#endif
        SEAM(0); }
    for (int l = 0; l < DEPTH; ++l) {
        const int pb = 1 + 5 * l;
        if (IN(pb)) { F = mk_frame((LAS unsigned char*)lds, &args);
            pg8::Gemm g{F.XB(), F.WIN() + (size_t)l * NPJ * DM, MTOK, 12288, DM}; pg8::RemapOrder S; S.init(MTOK, 12288, F.G(), (int)blockIdx.x);
            pg8::Unit u0; S.next(0, u0); const int fm = u0.pm & ~7; LAS float* rtab = (LAS float*)(F.lds + LDSCTL_OFF + 1024);
            { const float* sq = F.SSQ() + (size_t)fm * 256 * 16;
              for (int r = F.tid(); r < 2048; r += NTHR) { const f32x4* p = (const f32x4*)(sq + (size_t)r * 16); const f32x4 a = p[0], b4 = p[1], c4 = p[2], d4 = p[3];
                  const float ssum = ((a[0] + a[1]) + (a[2] + a[3])) + ((b4[0] + b4[1]) + (b4[2] + b4[3])) + ((c4[0] + c4[1]) + (c4[2] + c4[3])) + ((d4[0] + d4[1]) + (d4[2] + d4[3]));
                  rtab[r] = rsqrtf(ssum * (1.0f / 4096.0f) + EPS); }
              __syncthreads(); }
            pg8::EpiProj E{F.P(), F.DTRAW(), F.SSQ(), rtab, fm};
#ifdef PROBE_IN2
            for (int rep2 = 0; rep2 < 2; ++rep2) { pg8::gemm_phase<pg8::EpiProj, pg8::RemapOrder, true, true>(F.lds, g, S, E); if (rep2 == 0) xcd_barrier(bar); }
#else
            pg8::gemm_phase<pg8::EpiProj, pg8::RemapOrder, true, true>(F.lds, g, S, E);
#endif
            SEAM(pb);
        }
#ifdef PROBE_MIX2
        for (int rep = 0; rep < 2; ++rep) {
#else
        { constexpr int rep = 0;
#endif
        if (IN(pb + 1)) { F = mk_frame((LAS unsigned char*)lds, &args);
#ifndef NO_STAGE_A
            for (int u = (int)blockIdx.x;; u = F.G() + next_unit(F, l * 4 + 0 + 2 * rep)) { F = mk_frame((LAS unsigned char*)lds, &args);
                if (u < 160) { const int t = u >> 5; pg8::Gemm g{F.XB(), F.WIN() + (size_t)l * NPJ * DM, MTOK, NPJ, DM}; pg8::OneUnit S1{u & 31, t == 0 ? 35 : 47 + t}; pg8::EpiProj E{F.P(), F.DTRAW(), F.SSQ(), nullptr, 0};
                    pg8::gemm_phase<pg8::EpiProj, pg8::OneUnit, true, true>(F.lds, g, S1, E); }
                else if (u < 288) ssd_A(F, l, u - 160);
                else if (u < 544) lru_A(F, l, u - 288);
                else if (u < 672) ret_A(F, u - 544);
                else if (u < 928) moba_kmean(F, u - 672);
                else if (u < 928 + 512) tr_unit(F, l, TR_I_IN + 2 * (u - 928), 2);
                else if (u < 1440 + 840 && l + 1 < DEPTH) tr_unit(F, l + 1, 2 * (u - 1440), 2);
                else break; }
#endif
            SEAM(pb + 1);
        }
        if (IN(pb + 2)) { F = mk_frame((LAS unsigned char*)lds, &args);
#ifndef NO_STAGE_B
            ret_B(F); ssd_B(F); lru_B(F);
#endif
            SEAM(pb + 2);
        }
        if (IN(pb + 3)) { F = mk_frame((LAS unsigned char*)lds, &args);
#ifndef NO_STAGE_C
            for (int u = (int)blockIdx.x;; u = F.G() + next_unit(F, l * 4 + 1 + 2 * rep)) { F = mk_frame((LAS unsigned char*)lds, &args);
                if (u < 256) moba_attn(F, 15 - (u >> 4), u & 15);
                else if (u < 512) ret_C(F, l, u - 256);
                else if (u < 768) ssd_C(F, l, u - 512);
                else if (u < 1024) lru_C(F, u - 768);
                else if (u < 1024 + 840 && l + 1 < DEPTH) tr_unit(F, l + 1, 1680 + 2 * (u - 1024), 2);
                else break; }
#endif
            SEAM(pb + 3);
        }
        }
        if (IN(pb + 4)) { F = mk_frame((LAS unsigned char*)lds, &args);
            pg8::Gemm g{F.Y(), F.WOUT() + (size_t)l * DM * DM, MTOK, DM, DM}; pg8::StaticOrder S; S.init(MTOK, DM, F.G(), (int)blockIdx.x);
            pg8::EpiOut E{F.XB(), F.SSQ(), (LAS float*)(F.lds + LDSCTL_OFF + 1024)};
            pg8::gemm_phase<pg8::EpiOut, pg8::StaticOrder, true, true>(F.lds, g, S, E);
            SEAM(pb + 4);
        }
    }
    if (IN(NPHASE - 1)) { F = mk_frame((LAS unsigned char*)lds, &args); p_final(F); }
#undef IN
#undef SEAM
}

#ifndef MK_ONE_LAUNCH
#define MK_ONE_LAUNCH 1
#endif
extern "C" void kernel_launch(void* const* d_in, const int* in_sizes, int n_in, void* d_out, int out_size, void* d_ws, size_t ws_size, hipStream_t stream) {
    static int grid = 0;
    if (grid == 0) {
        if (n_in != 19 || out_size != MTOK * DM || ws_size < WS_END) { fprintf(stderr, "kernel_launch: unexpected shapes (n_in %d, out %d, ws %zu)\n", n_in, out_size, ws_size); grid = -1; return; }
        int dev = 0, cus = 0, per_cu = 0;
        if (hipGetDevice(&dev) != hipSuccess || hipDeviceGetAttribute(&cus, hipDeviceAttributeMultiprocessorCount, dev) != hipSuccess) { grid = -1; return; }
        if (hipFuncSetAttribute((const void*)hymba_fwd, hipFuncAttributeMaxDynamicSharedMemorySize, LDS_BYTES) != hipSuccess) { fprintf(stderr, "kernel_launch: hipFuncSetAttribute failed\n"); grid = -1; return; }
        if (hipOccupancyMaxActiveBlocksPerMultiprocessor(&per_cu, (const void*)hymba_fwd, NTHR, LDS_BYTES) != hipSuccess || per_cu < 1) { fprintf(stderr, "kernel_launch: occupancy query says %d\n", per_cu); }
        (void)hipGetLastError();
        grid = cus;
    }
    if (grid < 0) return;
    (void)hipMemsetAsync((char*)d_ws + WS_CTL, 0, CTL_ZERO_BYTES, stream);
    Args a{};
    for (int i = 0; i < 19; ++i) a.in[i] = (const float*)d_in[i];
    a.out = (float*)d_out; a.ws = (unsigned char*)d_ws;
#if MK_ONE_LAUNCH
    a.ph_lo = 0; a.ph_hi = NPHASE;
    hipLaunchKernelGGL(hymba_fwd, dim3(grid), dim3(NTHR), LDS_BYTES, stream, a);
#else
    for (int p = 0; p < NPHASE; ++p) { a.ph_lo = p; a.ph_hi = p + 1; hipLaunchKernelGGL(hymba_fwd, dim3(grid), dim3(NTHR), LDS_BYTES, stream, a); }
#endif
}
```

```cpp
#include <hip/hip_runtime.h>
#include <cstdio>
#include <cstdint>
#include <cmath>
namespace pg8 {
#define PG8_LAS __attribute__((address_space(3)))
typedef unsigned short bf16_t;
typedef short bf16x8 __attribute__((ext_vector_type(8)));
typedef float f32x4 __attribute__((ext_vector_type(4)));
typedef unsigned u32x4 __attribute__((ext_vector_type(4)));
constexpr int BM = 256, BK = 64, HALF = 128, HTB = HALF * BK * 2  , STAGE_BYTES = 8 * HTB, NXCD = 8, WGM = 8;

__host__ __device__ __forceinline__ int lds_byte(int r, int c) { const int st = (r >> 4) * 2 + (c >> 5), rr = r & 15, cc = c & 31, ob = rr * 64 + cc * 2; return st * 1024 + (ob ^ (((ob >> 9) & 1) << 5)); }
__host__ __device__ __forceinline__ void stage_rc(int b, int& R, int& C) { const int st = b / 1024, sb = b % 1024, swz = sb ^ (((sb >> 9) & 1) << 5); R = (st >> 1) * 16 + swz / 64; C = (st & 1) * 32 + (swz % 64) / 2; }
__host__ __device__ __forceinline__ int perm32(int rho) { const int n = rho >> 4, i = rho & 15; return 8 * (i >> 2) + 4 * n + (i & 3); }

struct Unit { int pm, pn; };
struct Gemm { const bf16_t* A; const bf16_t* Bt; int M, N, K; };

struct StaticOrder {
    int nM, nN, nwg, G, c;
    __host__ __device__ void init(int M, int N, int G_, int c_) { nM = M / BM; nN = N / BM; nwg = nM * nN; G = G_; c = c_; }
    __host__ __device__ bool next(int i, Unit& u) const {
        const long L = (long)i * G + c; if (L >= nwg) return false;
        int wgid = (int)L; { const int q = nwg / NXCD, r = nwg % NXCD, xcd = wgid % NXCD, off = wgid / NXCD; wgid = (xcd < r ? xcd * (q + 1) : r * (q + 1) + (xcd - r) * q) + off; }
        const int nig = WGM * nN, gid = wgid / nig, fm = gid * WGM, gsz = (nM - fm) < WGM ? (nM - fm) : WGM;
        u.pm = fm + ((wgid % nig) % gsz); u.pn = (wgid % nig) / gsz; return true;
    }
    __device__ __forceinline__ void a_ready(const Unit&) const {}
    __device__ __forceinline__ void done(const Unit&) const {}
};

__device__ __forceinline__ unsigned cvt_pk_bf16(float lo, float hi) { unsigned r; asm volatile("v_cvt_pk_bf16_f32 %0, %1, %2" : "=v"(r) : "v"(lo), "v"(hi)); return r; }
typedef float f32x2 __attribute__((ext_vector_type(2)));
template <class Epi, class Sched, bool ALIGN_EPI = false, bool SP2 = false>
__device__ __forceinline__ void gemm_phase(PG8_LAS unsigned char* lds, const Gemm g, const Sched& S, const Epi& E) {
    int tid_l = threadIdx.x; asm volatile("" : "+v"(tid_l));
    const int tid = tid_l, wid = __builtin_amdgcn_readfirstlane(tid >> 6), lane = tid & 63, wr = wid >> 2, wc = wid & 3, fr = lane & 15, fq = lane >> 4;
    const int K = g.K, nt = K / BK;
    unsigned voffA[2], voffB[2];
#pragma unroll
    for (int i = 0; i < 2; ++i) { int R, C; stage_rc(tid * 16 + i * 8192, R, C); const int Rb = Epi::PERM ? ((R & ~31) + perm32(R & 31)) : R;
        voffA[i] = (unsigned)(R * K + C) * 2u; voffB[i] = (unsigned)(Rb * K + C) * 2u; }
    const size_t kstep = (size_t)(BK * 2);
    const size_t hstep = (size_t)HALF * K * 2;
    const size_t tstep = 2 * hstep;
    const unsigned ldsw = (unsigned)wid * 1024u;
    const int aoff = lds_byte(wr * 64 + fr, fq * 8), boff = lds_byte(wc * 32 + fr, fq * 8);
#define PG8_SA(b, h) (((b) * 2 + (h)) * HTB)
#define PG8_SB(b, h) ((4 + (b) * 2 + (h)) * HTB)
#define PG8_STAGE(bufoff, gbase, voff) do { _Pragma("unroll") for (int _i = 0; _i < 2; ++_i) \
        __builtin_amdgcn_global_load_lds((const unsigned*)((const char*)(gbase) + (voff)[_i]), (PG8_LAS unsigned*)(lds + (bufoff) + ldsw + _i * 8192), 16, 0, 0); } while (0)
#define PG8_LDA(dst, b, h) do { _Pragma("unroll") for (int m = 0; m < 4; ++m) _Pragma("unroll") for (int k = 0; k < 2; ++k) dst[m][k] = *(const PG8_LAS bf16x8*)(lds + PG8_SA(b, h) + aoff + m * 2048 + k * 1024); } while (0)
#define PG8_LDB(dst, b, h) do { _Pragma("unroll") for (int n = 0; n < 2; ++n) _Pragma("unroll") for (int k = 0; k < 2; ++k) dst[n][k] = *(const PG8_LAS bf16x8*)(lds + PG8_SB(b, h) + boff + n * 2048 + k * 1024); } while (0)
#define PG8_MMA(ai, bj, At, Bt) do { __builtin_amdgcn_s_setprio(1); _Pragma("unroll") for (int m = 0; m < 4; ++m) _Pragma("unroll") for (int n = 0; n < 2; ++n) _Pragma("unroll") for (int k = 0; k < 2; ++k) \
        acc[ai][bj][m][n] = __builtin_amdgcn_mfma_f32_16x16x32_bf16(Bt[n][k], At[m][k], acc[ai][bj][m][n], 0, 0, 0); __builtin_amdgcn_s_setprio(0); } while (0)
#define PG8_WAIT_V(n) asm volatile("s_waitcnt vmcnt(" #n ")" ::: "memory")
#define PG8_WAIT_L(n) asm volatile("s_waitcnt lgkmcnt(" #n ")" ::: "memory")
#define PG8_BAR __builtin_amdgcn_s_barrier()
#define PG8_SCHED __builtin_amdgcn_sched_barrier(0)
    Unit cur, nxt; int ui = 0;
    if (!S.next(0, cur)) return;
    f32x4 acc[2][2][4][2];
#pragma unroll
    for (int a = 0; a < 2; ++a)
#pragma unroll
        for (int b = 0; b < 2; ++b)
#pragma unroll
            for (int m = 0; m < 4; ++m)
#pragma unroll
                for (int n = 0; n < 2; ++n) acc[a][b][m][n] = (f32x4){0.f, 0.f, 0.f, 0.f};
    bf16x8 At[4][2], B0[2][2], B1[2][2];
    const char* cA = (const char*)g.A + (size_t)cur.pm * tstep; const char* cB = (const char*)g.Bt + (size_t)cur.pn * tstep;
    S.a_ready(cur);
    if constexpr (SP2) {
        PG8_STAGE(PG8_SB(0, 0), cB, voffB); PG8_STAGE(PG8_SB(0, 1), cB + hstep, voffB); PG8_STAGE(PG8_SA(0, 0), cA, voffA); PG8_STAGE(PG8_SA(0, 1), cA + hstep, voffA);
        if (wr == 1) PG8_BAR;
        PG8_WAIT_V(2); PG8_BAR;
        PG8_STAGE(PG8_SB(1, 0), cB + kstep, voffB); PG8_STAGE(PG8_SA(1, 0), cA + kstep, voffA); PG8_STAGE(PG8_SB(1, 1), cB + hstep + kstep, voffB);
        PG8_WAIT_V(6); PG8_BAR;
    } else {
        PG8_STAGE(PG8_SB(0, 0), cB, voffB); PG8_STAGE(PG8_SA(0, 0), cA, voffA); PG8_STAGE(PG8_SB(0, 1), cB + hstep, voffB); PG8_STAGE(PG8_SA(0, 1), cA + hstep, voffA);
        if (wr == 1) PG8_BAR;
        PG8_WAIT_V(4); PG8_BAR;
        PG8_STAGE(PG8_SB(1, 0), cB + kstep, voffB); PG8_STAGE(PG8_SA(1, 0), cA + kstep, voffA); PG8_STAGE(PG8_SB(1, 1), cB + hstep + kstep, voffB);
        PG8_WAIT_V(6); PG8_BAR;
    }
    for (;;) {
        const bool has_next = S.next(ui + 1, nxt);
        const char* nA = has_next ? (const char*)g.A + (size_t)nxt.pm * tstep : cA; const char* nB = has_next ? (const char*)g.Bt + (size_t)nxt.pn * tstep : cB;
        for (int t = 0; t < nt; t += 2) {
            const bool last = (t == nt - 2);
            const char* a1 = cA + (size_t)(t + 1) * kstep;
            const char* a2 = last ? nA : cA + (size_t)(t + 2) * kstep; const char* b2 = last ? nB : cB + (size_t)(t + 2) * kstep;
            const char* a3 = a2 + kstep; const char* b3 = b2 + kstep;
            if (last && has_next) S.a_ready(nxt);
            if constexpr (SP2) {
            PG8_LDB(B0, 0, 0); PG8_LDB(B1, 0, 1); PG8_SCHED; PG8_LDA(At, 0, 0); PG8_STAGE(PG8_SA(1, 1), a1 + hstep, voffA);
            PG8_WAIT_V(8); PG8_WAIT_L(0); PG8_BAR; PG8_MMA(0, 0, At, B0); PG8_MMA(0, 1, At, B1); PG8_BAR; PG8_SCHED;
            PG8_LDA(At, 0, 1); PG8_STAGE(PG8_SB(0, 0), b2, voffB); PG8_STAGE(PG8_SB(0, 1), b2 + hstep, voffB); PG8_STAGE(PG8_SA(0, 0), a2, voffA);
            PG8_WAIT_V(8); PG8_WAIT_L(0); PG8_BAR; PG8_MMA(1, 0, At, B0); PG8_MMA(1, 1, At, B1); PG8_BAR; PG8_SCHED;
            PG8_LDB(B0, 1, 0); PG8_LDB(B1, 1, 1); PG8_SCHED; PG8_LDA(At, 1, 0); PG8_STAGE(PG8_SA(0, 1), a2 + hstep, voffA);
            PG8_WAIT_V(8); PG8_WAIT_L(0); PG8_BAR; PG8_MMA(0, 0, At, B0); PG8_MMA(0, 1, At, B1); PG8_BAR; PG8_SCHED;
            PG8_LDA(At, 1, 1); PG8_STAGE(PG8_SB(1, 0), b3, voffB); PG8_STAGE(PG8_SB(1, 1), b3 + hstep, voffB); PG8_STAGE(PG8_SA(1, 0), a3, voffA);
            PG8_WAIT_V(8); PG8_WAIT_L(0); PG8_BAR; PG8_MMA(1, 0, At, B0); PG8_MMA(1, 1, At, B1); PG8_BAR; PG8_SCHED;
            } else {
            PG8_LDB(B0, 0, 0); PG8_SCHED; PG8_LDA(At, 0, 0); PG8_STAGE(PG8_SA(1, 1), a1 + hstep, voffA);
            PG8_WAIT_L(8); PG8_BAR; PG8_WAIT_L(0); PG8_MMA(0, 0, At, B0); PG8_BAR; PG8_SCHED;
            PG8_LDB(B1, 0, 1); PG8_STAGE(PG8_SB(0, 0), b2, voffB);
            PG8_BAR; PG8_WAIT_L(0); PG8_MMA(0, 1, At, B1); PG8_BAR;
            PG8_LDA(At, 0, 1); PG8_STAGE(PG8_SA(0, 0), a2, voffA);
            PG8_BAR; PG8_WAIT_L(0); PG8_MMA(1, 0, At, B0); PG8_BAR; PG8_SCHED;
            PG8_STAGE(PG8_SB(0, 1), b2 + hstep, voffB);
            PG8_WAIT_V(6); PG8_BAR; PG8_MMA(1, 1, At, B1); PG8_BAR;
            PG8_LDB(B0, 1, 0); PG8_SCHED; PG8_LDA(At, 1, 0); PG8_STAGE(PG8_SA(0, 1), a2 + hstep, voffA);
            PG8_WAIT_L(8); PG8_BAR; PG8_WAIT_L(0); PG8_MMA(0, 0, At, B0); PG8_BAR; PG8_SCHED;
            PG8_LDB(B1, 1, 1); PG8_STAGE(PG8_SB(1, 0), b3, voffB);
            PG8_BAR; PG8_WAIT_L(0); PG8_MMA(0, 1, At, B1); PG8_BAR;
            PG8_LDA(At, 1, 1); PG8_STAGE(PG8_SA(1, 0), a3, voffA);
            PG8_BAR; PG8_WAIT_L(0); PG8_MMA(1, 0, At, B0); PG8_BAR; PG8_SCHED;
            PG8_STAGE(PG8_SB(1, 1), b3 + hstep, voffB);
            PG8_WAIT_V(6); PG8_BAR; PG8_MMA(1, 1, At, B1); PG8_BAR;
            }
        }
        if constexpr (ALIGN_EPI) { if (wr == 0) PG8_BAR; }
        if constexpr (!Epi::AFTER_DRAIN) { E(acc, cur, wr, wc, fr, fq); S.done(cur); }
        if (!has_next) break;
#pragma unroll
        for (int a = 0; a < 2; ++a)
#pragma unroll
            for (int b = 0; b < 2; ++b)
#pragma unroll
                for (int m = 0; m < 4; ++m)
#pragma unroll
                    for (int n = 0; n < 2; ++n) acc[a][b][m][n] = (f32x4){0.f, 0.f, 0.f, 0.f};
        cur = nxt; cA = nA; cB = nB; ++ui;
        if constexpr (ALIGN_EPI) { if (wr == 1) PG8_BAR; }
    }
    PG8_WAIT_V(0);
    if constexpr (!ALIGN_EPI) { if (wr == 0) PG8_BAR; }
    PG8_BAR;
    if constexpr (Epi::AFTER_DRAIN) { E.fused(acc, cur, wr, wc, fr, fq, lds, wid, lane); S.done(cur); }
#undef PG8_SA
#undef PG8_SB
#undef PG8_STAGE
#undef PG8_LDA
#undef PG8_LDB
#undef PG8_MMA
#undef PG8_WAIT_V
#undef PG8_WAIT_L
#undef PG8_BAR
#undef PG8_SCHED
}
}

#define GAS __attribute__((address_space(1)))
#define LAS __attribute__((address_space(3)))
#define DI __device__ __forceinline__
typedef unsigned short bf16;
typedef unsigned v4u __attribute__((ext_vector_type(4)));
typedef unsigned v2u __attribute__((ext_vector_type(2)));
typedef float f32x4 __attribute__((ext_vector_type(4)));
typedef short bf16x8 __attribute__((ext_vector_type(8)));
typedef short s16x4 __attribute__((ext_vector_type(4)));
typedef GAS unsigned gu32;
typedef GAS unsigned long long gu64;
#define RLX_AGENT __ATOMIC_RELAXED, __HIP_MEMORY_SCOPE_AGENT
#define LDS_WAIT() asm volatile("s_waitcnt lgkmcnt(0)" ::: "memory")
#define VM_WAIT() asm volatile("s_waitcnt vmcnt(0)" ::: "memory")
DI unsigned f2bf(float f) { unsigned u = __builtin_bit_cast(unsigned, f); return (u + 0x7fffu + ((u >> 16) & 1u)) >> 16; }
__device__ __forceinline__ unsigned pk2(float lo, float hi) { return f2bf(lo) | (f2bf(hi) << 16); }

#define XB_TMO      128
#define XB_XCNT(j)  (256  + 64 * (j))
#define XB_XSUB(j)  (1280 + 64 * (j))
#define XB_XGEN(j)  (2304 + 64 * (j))
#define XB_TOP      3328
#define XB_TOPGEN   3392
#define XCD_BAR_WORDS 3456
#define XB_SPIN_CAP (1u << 18)

__device__ __forceinline__ unsigned xb_ld(unsigned* p)              { return __hip_atomic_load(p, __ATOMIC_RELAXED, __HIP_MEMORY_SCOPE_AGENT); }
__device__ __forceinline__ unsigned xb_add(unsigned* p, unsigned v) { return __hip_atomic_fetch_add(p, v, __ATOMIC_RELAXED, __HIP_MEMORY_SCOPE_AGENT); }
__device__ __forceinline__ unsigned xb_xcc_id() { return (unsigned)__builtin_amdgcn_s_getreg((3 << 11) | 20) & 0xFu; }
#define XB_SPIN(cond, bar) do { unsigned _sp = 0; while (cond) { __builtin_amdgcn_s_sleep(1); \
    if ((++_sp & 255u) == 0u) { if (xb_ld(&(bar)[XB_TMO])) break; if (_sp > XB_SPIN_CAP) { atomicAdd(&(bar)[XB_TMO], 1u); break; } } } } while (0)

struct XcdBarrier {
    unsigned* bar; unsigned x;
    volatile LAS unsigned* st;
};

__device__ __forceinline__ XcdBarrier xcd_barrier_post(unsigned* bar, volatile LAS unsigned* st) {
    XcdBarrier b; b.bar = bar; b.x = xb_xcc_id(); b.st = st;
    if (threadIdx.x == 0) (void)xb_add(&bar[XB_XCNT(b.x)], 1u);
    return b;
}
__device__ __forceinline__ void xcd_barrier_complete(unsigned* bar, unsigned x, unsigned& nloc, unsigned& nx) {
    const unsigned G = gridDim.x * gridDim.y * gridDim.z;
    unsigned sum, cnt, mine, sp = 0u;
    for (;;) {
        sum = 0u; cnt = 0u; mine = 0u;
#pragma unroll 1
        for (unsigned j = 0; j < 16; ++j) { const unsigned c = xb_ld(&bar[XB_XCNT(j)]); sum += c; cnt += (c > 0u) ? 1u : 0u; mine = (j == x) ? c : mine; }
        if (sum == G) break;
        __builtin_amdgcn_s_sleep(1);
        if ((++sp & 255u) == 0u) { if (xb_ld(&bar[XB_TMO])) break; if (sp > XB_SPIN_CAP) { atomicAdd(&bar[XB_TMO], 1u); break; } }
    }
    nloc = mine > 0u ? mine : 1u; nx = cnt > 0u ? cnt : 1u;
}

__device__ __forceinline__ void xcd_barrier(const XcdBarrier& b) {
    asm volatile("s_waitcnt vmcnt(0)" ::: "memory");
    __syncthreads();
    if (threadIdx.x == 0) {
        unsigned* bar = b.bar;
        __builtin_amdgcn_s_waitcnt(0);
        unsigned nloc = b.st[0], nx = b.st[1];
        if (nloc == 0u) { xcd_barrier_complete(bar, b.x, nloc, nx); b.st[0] = nloc; b.st[1] = nx; }
        const unsigned old = xb_add(&bar[XB_XSUB(b.x)], 1u);
        const unsigned gen = old / nloc;
        if (old + 1u == (gen + 1u) * nloc) {
            __builtin_amdgcn_fence(__ATOMIC_RELEASE, "agent");
            asm volatile("s_waitcnt vmcnt(0)" ::: "memory");
            const unsigned og = xb_add(&bar[XB_TOP], 1u);
            const unsigned tg = og / nx;
            if (og + 1u == (tg + 1u) * nx) xb_add(&bar[XB_TOPGEN], 1u);
            else XB_SPIN(xb_ld(&bar[XB_TOPGEN]) == tg, bar);
            __builtin_amdgcn_fence(__ATOMIC_ACQUIRE, "agent");
            xb_add(&bar[XB_XGEN(b.x)], 1u);
            asm volatile("s_waitcnt vmcnt(0)" ::: "memory");
        } else {
            XB_SPIN(xb_ld(&bar[XB_XGEN(b.x)]) == gen, bar);
            __builtin_amdgcn_fence(__ATOMIC_ACQUIRE, "agent");
            asm volatile("s_waitcnt vmcnt(0)" ::: "memory");
        }
    }
    __syncthreads();
}

constexpr int BATCH = 2, SEQ = 4096, DM = 4096, DEPTH = 4, MTOK = BATCH * SEQ;
constexpr int DIN = 13328;
constexpr int NPJ = 13568;
constexpr int C_RQ = 0, C_RK = 1024, C_RV = 2048, C_RG = 3072, C_MQ = 4096, C_MK = 5120, C_MV = 6144, C_MG = 7168, C_SZ = 8192, C_SX = 9216, C_LX = 11264, C_LG = 12288, C_DT = 13312;
constexpr float EPS = 1e-6f;
constexpr int NWAVES = 8, NTHR = 512;
constexpr int NPHASE = 2 + 5 * DEPTH;

constexpr size_t MiB = 1u << 20;
constexpr size_t WS_CTL = 0, CTL_ZERO_BYTES = 1 * MiB;
constexpr size_t WS_SSQ = 2 * MiB, WS_LRUW = 4 * MiB, WS_KMEAN = 6 * MiB, WS_DT = 7 * MiB, WS_DTRAW = 8 * MiB, WS_DACS = 9 * MiB, WS_HEND = 10 * MiB, WS_AEND = 11 * MiB, WS_CARRY = 12 * MiB;
constexpr size_t WS_WIN = 16 * MiB, WIN_LAYER = (size_t)NPJ * DM * 2;
constexpr size_t WS_WOUT = 440 * MiB, WOUT_LAYER = (size_t)DM * DM * 2;
constexpr size_t WS_X = 568 * MiB, WS_XB = 696 * MiB, WS_P = 760 * MiB, WS_Y = 972 * MiB, WS_RU = 1036 * MiB, WS_RS = 1068 * MiB, WS_XBC = 1084 * MiB, WS_SST = 1116 * MiB, WS_SHP = 1132 * MiB,
                 WS_HLOC = 1140 * MiB, WS_ACUM = 1172 * MiB, WS_END = 1204 * MiB;
static_assert(WS_WIN + 4 * WIN_LAYER <= WS_WOUT && WS_P + (size_t)MTOK * NPJ * 2 <= WS_Y, "ws map");
constexpr int CW_BAR = 4096;
constexpr int CW_WQ = 16384;

constexpr int RING_BYTES = 131072, LDSCTL_OFF = RING_BYTES, MISC_OFF = LDSCTL_OFF + 320, LDS_BYTES = 147456;
constexpr int SB256 = 528, SB128 = 272;

struct Args { const float* in[19]; float* out; unsigned char* ws; int ph_lo, ph_hi; };
struct Frame {
    LAS unsigned char* lds; const Args* a; int z, tid_;
    DI int tid() const { return tid_; }
    DI int lane() const { return tid_ & 63; }
    DI int wave() const { return __builtin_amdgcn_readfirstlane(tid_ >> 6); }
    DI int G() const { return (int)gridDim.x; }
    DI volatile LAS unsigned* MISC() const { return (volatile LAS unsigned*)(lds + MISC_OFF); }
    DI unsigned char* ws() const { return a->ws + z; }
    DI unsigned* ctl() const { return (unsigned*)(a->ws + z + WS_CTL); }
    DI const float* in(int k) const { return a->in[k] + z; }
    DI float* out() const { return a->out + z; }
#define FV(T, name, off) DI T* name() const { return (T*)(a->ws + z + (off)); }
    FV(bf16, WIN, WS_WIN) FV(bf16, WOUT, WS_WOUT) FV(bf16, XB, WS_XB) FV(bf16, P, WS_P) FV(bf16, Y, WS_Y) FV(bf16, RS, WS_RS) FV(bf16, XBC, WS_XBC) FV(bf16, SHP, WS_SHP) FV(bf16, LRUW, WS_LRUW)
    FV(float, X, WS_X) FV(float, SSQ, WS_SSQ) FV(bf16, KMH, WS_KMEAN) FV(bf16, KML, WS_KMEAN + 65536) FV(float, KMX, WS_KMEAN + 131072) FV(float, DT, WS_DT) FV(float, DTRAW, WS_DTRAW) FV(float, DACS, WS_DACS) FV(float, HEND, WS_HEND) FV(float, AEND, WS_AEND)
    FV(float, CARRY, WS_CARRY) FV(bf16, RU, WS_RU) FV(float, SST, WS_SST) FV(bf16, HLOC, WS_HLOC) FV(bf16, ACUM, WS_ACUM)
#undef FV
};

DI Frame mk_frame(LAS unsigned char* lds, const Args* a) { Frame F; F.lds = lds; F.a = a; int z = 0; asm volatile("" : "+s"(z)); int t = (int)threadIdx.x; asm volatile("" : "+v"(t)); F.z = z; F.tid_ = t; return F; }
DI float bf_lo(unsigned u) { return __uint_as_float(u << 16); }
DI float bf_hi(unsigned u) { return __uint_as_float(u & 0xffff0000u); }
typedef float f32x2_t __attribute__((ext_vector_type(2))); typedef __bf16 bf16x2_t __attribute__((ext_vector_type(2)));
DI unsigned pkbf(float lo, float hi) { f32x2_t v = {lo, hi}; bf16x2_t b = __builtin_convertvector(v, bf16x2_t); return __builtin_bit_cast(unsigned, b); }
DI float wave_sum(float v) {
#pragma unroll
    for (int o = 1; o < 64; o <<= 1) v += __shfl_xor(v, o);
    return v;
}
DI float sigm(float x) { return __builtin_amdgcn_rcpf(1.f + __expf(-x)); }
DI float silu(float x) { return x * __builtin_amdgcn_rcpf(1.f + __expf(-x)); }
DI float one_minus_exp(float x) { const float p = -x * (1.0f + x * (0.5f + x * (0.16666667f + x * (0.041666668f + x * 0.008333334f)))); return x > -0.25f ? p : 1.0f - __expf(x); }
DI float softplus(float x) { return x > 20.f ? x : log1pf(__expf(x)); }
DI f32x4 mfma16(bf16x8 a, bf16x8 b, f32x4 c) { return __builtin_amdgcn_mfma_f32_16x16x32_bf16(a, b, c, 0, 0, 0); }
DI void unpack8(const v4u v, float (&f)[8]) { f[0] = bf_lo(v.x); f[1] = bf_hi(v.x); f[2] = bf_lo(v.y); f[3] = bf_hi(v.y); f[4] = bf_lo(v.z); f[5] = bf_hi(v.z); f[6] = bf_lo(v.w); f[7] = bf_hi(v.w); }
DI v4u pack8(const float (&f)[8]) { v4u v; v.x = pkbf(f[0], f[1]); v.y = pkbf(f[2], f[3]); v.z = pkbf(f[4], f[5]); v.w = pkbf(f[6], f[7]); return v; }
DI bf16x8 pack8f(const float (&f)[8]) { return __builtin_bit_cast(bf16x8, pack8(f)); }
DI bf16x8 frag_row(const LAS unsigned char* t, int sb, int r0, int k0, int lane) { return *(const LAS bf16x8*)(t + (r0 + (lane & 15)) * sb + (k0 + 8 * (lane >> 4)) * 2); }
typedef short v4i16_t __attribute__((ext_vector_type(4)));
DI bf16x8 frag_tr(const LAS unsigned char* t, int sb, int ra, int rb, int c0, int lane) {
    const int q = (lane & 15) >> 2, p = lane & 3;
    const s16x4 lo = __builtin_bit_cast(s16x4, __builtin_amdgcn_ds_read_tr16_b64_v4i16((LAS v4i16_t*)(t + (ra + q) * sb + (c0 + 4 * p) * 2)));
    const s16x4 hi = __builtin_bit_cast(s16x4, __builtin_amdgcn_ds_read_tr16_b64_v4i16((LAS v4i16_t*)(t + (rb + q) * sb + (c0 + 4 * p) * 2)));
    bf16x8 r; r[0] = lo[0]; r[1] = lo[1]; r[2] = lo[2]; r[3] = lo[3]; r[4] = hi[0]; r[5] = hi[1]; r[6] = hi[2]; r[7] = hi[3]; return r;
}
template <int COLS> DI void stage_bf16(LAS unsigned char* dst, int sb, const bf16* src, size_t gp, int rows, int tid) {
    constexpr int CPR = COLS / 8; const int total = rows * CPR;
    for (int c = tid; c < total; c += NTHR) { const int r = c / CPR, ch = c % CPR; const v4u v = *(const v4u*)(src + (size_t)r * gp + ch * 8); *(LAS v4u*)(dst + r * sb + ch * 16) = v; }
}
DI unsigned wq_issue(Frame& F, int ctr) { unsigned v = 0u; if (F.tid() == 0) v = __hip_atomic_fetch_add(F.ctl() + CW_WQ + 64 * ctr, 1u, RLX_AGENT); return v; }
DI int wq_publish(Frame& F, unsigned v) { __syncthreads(); if (F.tid() == 0) F.MISC()[0] = v; __syncthreads(); return __builtin_amdgcn_readfirstlane((int)F.MISC()[0]); }
DI int next_unit(Frame& F, int ctr) {
    __syncthreads();
    if (F.tid() == 0) F.MISC()[0] = __hip_atomic_fetch_add(F.ctl() + CW_WQ + 64 * ctr, 1u, RLX_AGENT);
    __syncthreads();
    return __builtin_amdgcn_readfirstlane((int)F.MISC()[0]);
}

namespace pg8 {
struct EpiProj {
    static constexpr bool PERM = true, AFTER_DRAIN = false;
    bf16_t* O; float* dtraw; const float* ssq;
    const PG8_LAS float* rtab; int fm;
    __device__ __forceinline__ void operator()(const f32x4 (&acc)[2][2][4][2], const Unit& u, int wr, int wc, int fr, int fq) const {
        asm volatile("" : "+v"(fr), "+v"(fq));
        const int row0 = u.pm * BM + wr * 64 + fr;
        const bool dt_tile = u.pn >= 52;
        const int col0 = u.pn * BM + wc * 32 + 8 * fq;
        const bool tab = rtab != nullptr && (unsigned)(u.pm - fm) < 8u;
        float rs[2][4];
        if (tab) { const PG8_LAS float* t = rtab + (u.pm - fm) * BM + wr * 64 + fr;
#pragma unroll
            for (int ai = 0; ai < 2; ++ai)
#pragma unroll
                for (int m = 0; m < 4; ++m) rs[ai][m] = t[ai * HALF + m * 16];
        } else { f32x4 pv[2][4];
#pragma unroll
            for (int ai = 0; ai < 2; ++ai)
#pragma unroll
                for (int m = 0; m < 4; ++m) pv[ai][m] = *(const f32x4*)(ssq + (size_t)(row0 + ai * HALF + m * 16) * 16 + 4 * fq);
#pragma unroll
            for (int ai = 0; ai < 2; ++ai)
#pragma unroll
                for (int m = 0; m < 4; ++m) { float s = (pv[ai][m][0] + pv[ai][m][1]) + (pv[ai][m][2] + pv[ai][m][3]); s += __shfl_xor(s, 16); s += __shfl_xor(s, 32); rs[ai][m] = rsqrtf(s * (1.0f / 4096.0f) + 1e-6f); } }
#pragma unroll
        for (int ai = 0; ai < 2; ++ai)
#pragma unroll
            for (int m = 0; m < 4; ++m) { const int r = row0 + ai * HALF + m * 16; const float s = rs[ai][m];
                if (!dt_tile) { bf16_t* rowp = O + (size_t)r * 13568 + col0;
#pragma unroll
                    for (int bj = 0; bj < 2; ++bj) { const f32x4 v0 = acc[ai][bj][m][0] * s, v1 = acc[ai][bj][m][1] * s;
                        u32x4 w; w.x = cvt_pk_bf16(v0[0], v0[1]); w.y = cvt_pk_bf16(v0[2], v0[3]); w.z = cvt_pk_bf16(v1[0], v1[1]); w.w = cvt_pk_bf16(v1[2], v1[3]);
                        *(u32x4*)(rowp + bj * HALF) = w; }
                } else if (wc == 0 && fq < 2) { float* rowp = dtraw + (size_t)r * 16 + 8 * fq; *(f32x4*)(rowp) = acc[ai][0][m][0] * s; *(f32x4*)(rowp + 4) = acc[ai][0][m][1] * s; } }
    }
};
struct EpiOut {
    static constexpr bool PERM = false, AFTER_DRAIN = false;
    bf16_t* xb; float* ssq; PG8_LAS float* red;
    __device__ __forceinline__ void operator()(const f32x4 (&acc)[2][2][4][2], const Unit& u, int wr, int wc, int fr, int fq) const {
        asm volatile("" : "+v"(fr), "+v"(fq));
        const int row0 = u.pm * BM + wr * 64 + fr, col0 = u.pn * BM + wc * 32 + 4 * fq;
#pragma unroll
        for (int ai = 0; ai < 2; ++ai) {
            unsigned long long xo[4][2][2];
#pragma unroll
            for (int m = 0; m < 4; ++m)
#pragma unroll
                for (int bj = 0; bj < 2; ++bj)
#pragma unroll
                    for (int n = 0; n < 2; ++n) xo[m][bj][n] = *(const unsigned long long*)(xb + (size_t)(row0 + ai * HALF + m * 16) * 4096 + col0 + bj * HALF + n * 16);
#pragma unroll
            for (int m = 0; m < 4; ++m) { const int r = row0 + ai * HALF + m * 16; const size_t off = (size_t)r * 4096 + col0; float ss = 0.f;
#pragma unroll
                for (int bj = 0; bj < 2; ++bj)
#pragma unroll
                    for (int n = 0; n < 2; ++n) { const unsigned lo = (unsigned)xo[m][bj][n], hi = (unsigned)(xo[m][bj][n] >> 32);
                        f32x4 o = acc[ai][bj][m][n]; o[0] += __uint_as_float(lo << 16); o[1] += __uint_as_float(lo & 0xffff0000u); o[2] += __uint_as_float(hi << 16); o[3] += __uint_as_float(hi & 0xffff0000u);
                        ss += (o[0] * o[0] + o[1] * o[1]) + (o[2] * o[2] + o[3] * o[3]);
                        const unsigned w0 = cvt_pk_bf16(o[0], o[1]), w1 = cvt_pk_bf16(o[2], o[3]);
                        *(unsigned long long*)(xb + off + bj * HALF + n * 16) = (unsigned long long)w0 | ((unsigned long long)w1 << 32); }
                ss += __shfl_xor(ss, 16); ss += __shfl_xor(ss, 32);
                if (fq == 0) red[(ai * HALF + wr * 64 + m * 16 + fr) * 4 + wc] = ss; }
            asm volatile("" ::: "memory"); }
        asm volatile("s_waitcnt lgkmcnt(0)" ::: "memory"); __builtin_amdgcn_s_barrier(); asm volatile("" ::: "memory");
        { const int t = (wr * 4 + wc) * 64 + fq * 16 + fr;
          if (t < 256) { const f32x4 p4 = *(const PG8_LAS f32x4*)(red + t * 4); ssq[(size_t)(u.pm * BM + t) * 16 + u.pn] = (p4[0] + p4[1]) + (p4[2] + p4[3]); } }
    }
};
struct RemapOrder : StaticOrder {
    __device__ __forceinline__ bool next(int i, Unit& u) const { if (!StaticOrder::next(i, u)) return false; if (u.pn == 35) u.pn = 52; return true; }
};
struct OneUnit {
    int pm, pn;
    __device__ __forceinline__ bool next(int i, Unit& u) const { if (i != 0) return false; u.pm = pm; u.pn = pn; return true; }
    __device__ __forceinline__ void a_ready(const Unit&) const {}
    __device__ __forceinline__ void done(const Unit&) const {}
};
}

DI int map_in_col(int n) { return n < 11264 ? n : (n < 11280 ? C_DT + (n - 11264) : n - 16); }
constexpr int TR_SB = 272;
struct TrItem { const float* W; const float* ks; bf16* WT; int N, k0, n0, is_in; };
constexpr int TR_NB_IN = (DIN + 127) / 128, TR_I_IN = 32 * TR_NB_IN, TR_I_OUT = 32 * 32, TR_I_L = TR_I_IN + TR_I_OUT;
DI bool tr_item(Frame& F, int l, int r, TrItem& t) {
    constexpr int NB_IN = TR_NB_IN, I_IN = TR_I_IN;
    if (r >= TR_I_L) return false;
    if (r < I_IN) { t.W = F.in(2) + (size_t)l * DM * DIN; t.ks = F.in(1) + l * DM; t.WT = F.WIN() + (size_t)l * NPJ * DM; t.N = DIN; t.k0 = 128 * (r / NB_IN); t.n0 = 128 * (r % NB_IN); t.is_in = 1; }
    else { const int q = r - I_IN; t.W = F.in(17) + (size_t)l * DM * DM; t.ks = nullptr; t.WT = F.WOUT() + (size_t)l * DM * DM; t.N = DM; t.k0 = 128 * (q / 32); t.n0 = 128 * (q % 32); t.is_in = 0; }
    return true;
}
DI void tr_load(const TrItem& t, int tid, f32x4 (&v)[8]) {
    const int c4 = tid & 31, n = t.n0 + 4 * c4; const bool ok = n < t.N;
#pragma unroll
    for (int p = 0; p < 8; ++p) { const int k = t.k0 + p * 16 + (tid >> 5); f32x4 x = ok ? *(const f32x4*)(t.W + (size_t)k * t.N + n) : (f32x4){0.f, 0.f, 0.f, 0.f}; if (t.ks) x *= t.ks[k]; v[p] = x; }
}
DI void tr_step(Frame& F, const TrItem& cur, f32x4 (&v)[8], int l, int r_next, TrItem& nxt, bool& hn, LAS unsigned char* tile, int tid, int lane, int w) {
    const int gq = lane >> 4, l15 = lane & 15, c4 = tid & 31;
    __syncthreads();
#pragma unroll
    for (int p = 0; p < 8; ++p) { const int kr = p * 16 + (tid >> 5); v2u o; o.x = pkbf(v[p][0], v[p][1]); o.y = pkbf(v[p][2], v[p][3]); *(LAS v2u*)(tile + kr * TR_SB + c4 * 8) = o; }
    __syncthreads();
    hn = tr_item(F, l, r_next, nxt);
    if (hn) tr_load(nxt, tid, v);
    const int n = cur.n0 + 16 * w + l15; const bool okn = n < cur.N; const int row = cur.is_in ? map_in_col(okn ? n : 0) : n; bf16* dst = cur.WT + (size_t)row * DM + cur.k0 + 8 * gq;
#pragma unroll
    for (int ks = 0; ks < 4; ++ks) { const bf16x8 f = frag_tr(tile, TR_SB, 32 * ks + 8 * gq, 32 * ks + 8 * gq + 4, 16 * w, lane); if (okn) *(bf16x8*)(dst + 32 * ks) = f; }
}
DI void tr_unit(Frame& F, int l, int r0, int cnt) {
    const int tid = F.tid(), lane = F.lane(), w = F.wave();
    TrItem ia, ib, dummy; f32x4 va[8], vb[8]; bool hn;
    tr_item(F, l, r0, ia); tr_item(F, l, r0 + 1, ib);
    tr_load(ia, tid, va); tr_load(ib, tid, vb);
    tr_step(F, ia, va, l, TR_I_L, dummy, hn, F.lds, tid, lane, w);
    tr_step(F, ib, vb, l, TR_I_L, dummy, hn, F.lds, tid, lane, w);
    __syncthreads();
}
DI void p0_prologue(Frame& F) {
    const int tid = F.tid(), lane = F.lane(), w = F.wave();
    LAS unsigned char* tile = F.lds;
    TrItem ia, ib; f32x4 va[8], vb[8];
    int it = blockIdx.x; const int G = F.G();
#define P0_IDX(i) ((i) < TR_I_IN ? (i) : TR_I_L)
    bool ha = tr_item(F, 0, P0_IDX(it), ia), hb = tr_item(F, 0, P0_IDX(it + G), ib);
    if (ha) tr_load(ia, tid, va);
    if (hb) tr_load(ib, tid, vb);
    while (ha) {
        TrItem na; bool hna;
        tr_step(F, ia, va, 0, P0_IDX(it + 2 * G), na, hna, tile, tid, lane, w);
        if (!hb) break;
        TrItem nb; bool hnb;
        tr_step(F, ib, vb, 0, P0_IDX(it + 3 * G), nb, hnb, tile, tid, lane, w);
        ia = na; ha = hna; ib = nb; hb = hnb; it += 2 * G;
    }
    const int gw = blockIdx.x * NWAVES + w, NGW = F.G() * NWAVES;
    for (int i = blockIdx.x * NTHR + tid; i < DEPTH * 240 * (DM / 8); i += F.G() * NTHR) { const int l = i / (240 * (DM / 8)), r = i % (240 * (DM / 8));
        *(v4u*)(F.WIN() + (size_t)l * NPJ * DM + (size_t)(C_DT + 16) * DM + (size_t)r * 8) = (v4u){0u, 0u, 0u, 0u}; }
    for (int i = blockIdx.x * NTHR + tid; i < DEPTH * 2 * 8 * 128 * 128; i += F.G() * NTHR) { const int d = i & 127, e = (i >> 7) & 127, nb = (i >> 14) & 7, gate = (i >> 17) & 1, l = i >> 18;
        const float* wp = (gate ? F.in(14) : F.in(12)) + ((size_t)(l * 8 + nb) * 128 + d) * 128 + e; F.LRUW()[i] = (bf16)f2bf(*wp); }
    for (int m = gw; m < MTOK; m += NGW) { const f32x4* xr = (const f32x4*)(F.in(0) + (size_t)m * DM) + lane; float ss = 0.f;
#pragma unroll
        for (int j = 0; j < 16; ++j) { const f32x4 x = xr[64 * j]; ss += (x[0] * x[0] + x[1] * x[1]) + (x[2] * x[2] + x[3] * x[3]);
            const unsigned long long o = (unsigned long long)pkbf(x[0], x[1]) | ((unsigned long long)pkbf(x[2], x[3]) << 32); *((unsigned long long*)(F.XB() + (size_t)m * DM) + 64 * j + lane) = o; }
        ss = wave_sum(ss); if (lane < 16) F.SSQ()[(size_t)m * 16 + lane] = lane == 0 ? ss : 0.f; }
}
DI void p_final(Frame& F) {
    const int gw = blockIdx.x * NWAVES + F.wave(), NGW = F.G() * NWAVES, lane = F.lane(); const float* fw = F.in(18);
    for (int m = gw; m < MTOK; m += NGW) { float ss = F.SSQ()[(size_t)m * 16 + (lane & 15)]; ss += __shfl_xor(ss, 1); ss += __shfl_xor(ss, 2); ss += __shfl_xor(ss, 4); ss += __shfl_xor(ss, 8); const float rs = rsqrtf(ss * (1.0f / 4096.0f) + EPS);
        const v4u* xr = (const v4u*)(F.XB() + (size_t)m * DM) + lane; f32x4* o = (f32x4*)(F.out() + (size_t)m * DM) + 2 * lane; const f32x4* wv = (const f32x4*)fw + 2 * lane;
#pragma unroll
        for (int j = 0; j < 8; ++j) { float x[8]; unpack8(xr[64 * j], x); const f32x4 w0 = wv[128 * j], w1 = wv[128 * j + 1];
            o[128 * j] = (f32x4){x[0] * rs * w0[0], x[1] * rs * w0[1], x[2] * rs * w0[2], x[3] * rs * w0[3]}; o[128 * j + 1] = (f32x4){x[4] * rs * w1[0], x[5] * rs * w1[1], x[6] * rs * w1[2], x[7] * rs * w1[3]}; } }
}

DI int swz(int row) { return ((row & 3) << 2) | ((row >> 2) & 3); }
DI const char* sbase(const void* p) { const char* q = (const char*)p; asm volatile("" : "+s"(q)); return q; }
DI void dma_tile256(const bf16* src, unsigned gp, LAS unsigned char* dst, int w, int lane) {
    const char* sb = (const char*)src;
#pragma unroll
    for (int i = 0; i < 4; ++i) { const int idx = w * 4 + i, row = 2 * idx + (lane >> 5), c = (lane & 31) ^ swz(row);
        __builtin_amdgcn_global_load_lds((const unsigned*)(sb + ((unsigned)row * gp + (unsigned)c * 8u) * 2u), (LAS unsigned*)(dst + idx * 1024), 16, 0, 0); }
}
DI bf16x8 frag_tr_sw512(const LAS unsigned char* t, int ra, int rb, int c0, int lane) {
    const int q = (lane & 15) >> 2, p = lane & 3, ch = (c0 >> 3) + (p >> 1), r0 = ra + q, r1 = rb + q;
    const s16x4 lo = __builtin_bit_cast(s16x4, __builtin_amdgcn_ds_read_tr16_b64_v4i16((LAS v4i16_t*)(t + 512 * r0 + 16 * (ch ^ swz(r0)) + 8 * (p & 1))));
    const s16x4 hi = __builtin_bit_cast(s16x4, __builtin_amdgcn_ds_read_tr16_b64_v4i16((LAS v4i16_t*)(t + 512 * r1 + 16 * (ch ^ swz(r1)) + 8 * (p & 1))));
    bf16x8 r; r[0] = lo[0]; r[1] = lo[1]; r[2] = lo[2]; r[3] = lo[3]; r[4] = hi[0]; r[5] = hi[1]; r[6] = hi[2]; r[7] = hi[3]; return r;
}
DI bf16x8 frag_row_sw512(const LAS unsigned char* t, int row, int ch) { return *(const LAS bf16x8*)(t + 512 * row + 16 * (ch ^ swz(row))); }
DI void ret_A(Frame& F, int unit) {
    const int c = unit & 15, bh = unit >> 4, h = bh & 3, b = bh >> 2, lane = F.lane(), w = F.wave(), gq = lane >> 4, l15 = lane & 15;
    const size_t t0 = (size_t)b * SEQ + c * 256;
    const bf16* Kp = F.P() + t0 * NPJ + C_RK + h * 256; const bf16* Vp = F.P() + t0 * NPJ + C_RV + h * 256;
    const float lg = log1pf(-exp2f(-5.f - (float)h));
    LAS unsigned char* B0 = F.lds; LAS unsigned char* B1 = F.lds + 65536;
    f32x4 acc[2][16];
#pragma unroll
    for (int a = 0; a < 2; ++a)
#pragma unroll
        for (int v = 0; v < 16; ++v) acc[a][v] = (f32x4){0.f, 0.f, 0.f, 0.f};
    float kd8[8];
#pragma unroll
    for (int e = 0; e < 8; ++e) kd8[e] = __expf(-lg * (float)(8 * gq + e));
    __syncthreads();
    dma_tile256(Kp, NPJ, B0, w, lane); dma_tile256(Vp, NPJ, B0 + 32768, w, lane);
    VM_WAIT(); __syncthreads();
    for (int jt = 0; jt < 4; ++jt) {
        LAS unsigned char* cur = (jt & 1) ? B1 : B0; LAS unsigned char* nxt = (jt & 1) ? B0 : B1;
        if (jt < 3) { dma_tile256(Kp + (size_t)(64 * (jt + 1)) * NPJ, NPJ, nxt, w, lane); dma_tile256(Vp + (size_t)(64 * (jt + 1)) * NPJ, NPJ, nxt + 32768, w, lane); }
        { int lz = lane; asm volatile("" : "+v"(lz)); const int lane = lz, gq = lz >> 4;
#pragma unroll
          for (int ks = 0; ks < 2; ++ks) { const int ra = 32 * ks + 8 * gq, rb = ra + 4;
              const float base = __expf(lg * (float)(255 - (64 * jt + 32 * ks))) * 0.0625f;
              bf16x8 A[2];
#pragma unroll
              for (int dt = 0; dt < 2; ++dt) { float f[8]; unpack8(__builtin_bit_cast(v4u, frag_tr_sw512(cur, ra, rb, 32 * w + 16 * dt, lane)), f);
#pragma unroll
                  for (int e = 0; e < 8; ++e) f[e] *= base * kd8[e];
                  A[dt] = pack8f(f); }
#pragma unroll
              for (int vt = 0; vt < 16; ++vt) { const bf16x8 B = frag_tr_sw512(cur + 32768, ra, rb, 16 * vt, lane); acc[0][vt] = mfma16(A[0], B, acc[0][vt]); acc[1][vt] = mfma16(A[1], B, acc[1][vt]); } } }
        VM_WAIT(); __syncthreads();
    }
    bf16* U = F.RU() + (size_t)unit * 65536;
#pragma unroll
    for (int dt = 0; dt < 2; ++dt)
#pragma unroll
        for (int vt = 0; vt < 16; ++vt) { v2u o; o.x = pkbf(acc[dt][vt][0], acc[dt][vt][1]); o.y = pkbf(acc[dt][vt][2], acc[dt][vt][3]); *(v2u*)(U + (16 * vt + l15) * 256 + 32 * w + 16 * dt + 4 * gq) = o; }
}
DI void ret_B(Frame& F) {
    for (int it = blockIdx.x * NTHR + F.tid(); it < 8 * 16384; it += F.G() * NTHR) { const int bh = it >> 14, e4 = it & 16383, h = bh & 3;
        const float cd = __expf(log1pf(-exp2f(-5.f - (float)h)) * 256.f); f32x4 s = (f32x4){0.f, 0.f, 0.f, 0.f};
        const size_t o0 = (size_t)(bh * 16) * 65536 + (size_t)e4 * 4; const bf16* __restrict__ ru = F.RU() + o0; bf16* __restrict__ rs = F.RS() + o0;
        f32x4 u[15];
#pragma unroll
        for (int c = 0; c < 15; ++c) { const v2u r = *(const v2u*)(ru + (size_t)c * 65536); u[c] = (f32x4){bf_lo(r.x), bf_hi(r.x), bf_lo(r.y), bf_hi(r.y)}; }
#pragma unroll
        for (int c = 0; c < 16; ++c) { *(unsigned long long*)(rs + (size_t)c * 65536) = (unsigned long long)pkbf(s[0], s[1]) | ((unsigned long long)pkbf(s[2], s[3]) << 32);
            if (c < 15) s = s * cd + u[c]; } }
}
DI void ret_C(Frame& F, int l, int unit2) {
    const int half = unit2 & 1, unit = unit2 >> 1, c = unit & 15, bh = unit >> 4, h = bh & 3, b = bh >> 2, lane = F.lane(), w = F.wave(), gq = lane >> 4, l15 = lane & 15;
    const size_t t0 = (size_t)b * SEQ + c * 256;
    const int il = half * 128 + w * 16 + l15;
    const float lg = log1pf(-exp2f(-5.f - (float)h));
    const bf16* St = F.RS() + (size_t)unit * 65536;
    const bf16* Kp = F.P() + t0 * NPJ + C_RK + h * 256; const bf16* Vp = F.P() + t0 * NPJ + C_RV + h * 256;
    LAS unsigned char* B0 = F.lds; LAS unsigned char* B1 = F.lds + 65536;
    if (c > 0) dma_tile256(St, 256, B0, w, lane); else { dma_tile256(Kp, NPJ, B0, w, lane); dma_tile256(Vp, NPJ, B0 + 32768, w, lane); }
    const bf16* Qp = F.P() + (t0 + il) * NPJ + C_RQ + h * 256;
    bf16x8 Q[8];
#pragma unroll
    for (int ks = 0; ks < 8; ++ks) Q[ks] = *(const bf16x8*)(Qp + 32 * ks + 8 * gq);
    f32x4 acc[16];
#pragma unroll
    for (int v = 0; v < 16; ++v) acc[v] = (f32x4){0.f, 0.f, 0.f, 0.f};
    const int njt = 2 * (half + 1);
    float gp[8]; const float kb = __expf(-lg * (float)(8 * gq)) * 0.0625f;
#pragma unroll
    for (int e = 0; e < 8; ++e) gp[e] = __builtin_bit_cast(float, __builtin_amdgcn_readfirstlane(__builtin_bit_cast(int, __expf(-lg * (float)e))));
    VM_WAIT(); __syncthreads();
    int par = 0;
    if (c > 0) {
#pragma unroll
        for (int sp = 0; sp < 4; ++sp) {
            LAS unsigned char* cur = (sp & 1) ? B1 : B0; LAS unsigned char* nxt = (sp & 1) ? B0 : B1;
            if (sp < 3) dma_tile256(St + (size_t)(64 * (sp + 1)) * 256, 256, nxt, w, lane); else { dma_tile256(Kp, NPJ, nxt, w, lane); dma_tile256(Vp, NPJ, nxt + 32768, w, lane); }
#pragma unroll
            for (int ks = 0; ks < 8; ++ks)
#pragma unroll
                for (int vt = 0; vt < 4; ++vt) acc[4 * sp + vt] = mfma16(frag_row_sw512(cur, 16 * vt + l15, 4 * ks + gq), Q[ks], acc[4 * sp + vt]);
            VM_WAIT(); __syncthreads();
        }
        const float qd = __expf(lg * (float)(il + 1));
#pragma unroll
        for (int v = 0; v < 16; ++v) acc[v] *= qd;
        par = 0;
    }
    for (int jt = 0; jt < njt; ++jt) {
        LAS unsigned char* cur = ((jt + par) & 1) ? B1 : B0; LAS unsigned char* nxt = ((jt + par) & 1) ? B0 : B1;
        if (jt + 1 < njt) { dma_tile256(Kp + (size_t)(64 * (jt + 1)) * NPJ, NPJ, nxt, w, lane); dma_tile256(Vp + (size_t)(64 * (jt + 1)) * NPJ, NPJ, nxt + 32768, w, lane); }
        if (64 * jt <= half * 128 + w * 16 + 15) {
            const LAS unsigned char* Kt = cur; const LAS unsigned char* Vt = cur + 32768;
#pragma unroll
            for (int js = 0; js < 2; ++js) {
                f32x4 s0 = (f32x4){0.f, 0.f, 0.f, 0.f}, s1 = s0, s0b = s0, s1b = s0;
                const int kr0 = 32 * js + 8 * (l15 >> 2) + (l15 & 3), kr1 = kr0 + 4;
#pragma unroll
                for (int ks = 0; ks < 8; ks += 2) { s0 = mfma16(frag_row_sw512(Kt, kr0, 4 * ks + gq), Q[ks], s0); s1 = mfma16(frag_row_sw512(Kt, kr1, 4 * ks + gq), Q[ks], s1);
                    s0b = mfma16(frag_row_sw512(Kt, kr0, 4 * ks + 4 + gq), Q[ks + 1], s0b); s1b = mfma16(frag_row_sw512(Kt, kr1, 4 * ks + 4 + gq), Q[ks + 1], s1b); }
                s0 += s0b; s1 += s1b;
                float p[8]; const int jbase = 64 * jt + 32 * js; const float rowf = __expf(lg * (float)(il - jbase)) * kb;
#pragma unroll
                for (int e = 0; e < 8; ++e) { const float sv = (e < 4) ? s0[e & 3] : s1[e & 3]; p[e] = sv * gp[e] * rowf; }
                if (jbase + 31 > half * 128 + w * 16) {
#pragma unroll
                    for (int e = 0; e < 8; ++e) p[e] = (il >= jbase + 8 * gq + e) ? p[e] : 0.f; }
                const bf16x8 Pf = pack8f(p);
#pragma unroll
                for (int vt = 0; vt < 16; ++vt) acc[vt] = mfma16(frag_tr_sw512(Vt, 32 * js + 8 * gq, 32 * js + 8 * gq + 4, 16 * vt, lane), Pf, acc[vt]);
            }
        }
        VM_WAIT(); __syncthreads();
    }
    float ss = 0.f;
#pragma unroll
    for (int v = 0; v < 16; ++v) ss += (acc[v][0] * acc[v][0] + acc[v][1] * acc[v][1]) + (acc[v][2] * acc[v][2] + acc[v][3] * acc[v][3]);
    ss += __shfl_xor(ss, 16); ss += __shfl_xor(ss, 32);
    const float rms = rsqrtf(ss * (1.0f / 256.0f) + EPS);
    const float* gw = F.in(3) + l * 1024 + h * 256; const bf16* Gp = F.P() + (t0 + il) * NPJ + C_RG + h * 256; bf16* Yp = F.Y() + (t0 + il) * DM + 0 + h * 256;
#pragma unroll
    for (int vt = 0; vt < 16; ++vt) { const int v = 16 * vt + 4 * gq; const v2u gv = *(const v2u*)(Gp + v); const f32x4 w4 = *(const f32x4*)(gw + v);
        const float y0 = acc[vt][0] * rms * w4[0] * silu(bf_lo(gv.x)), y1 = acc[vt][1] * rms * w4[1] * silu(bf_hi(gv.x)), y2 = acc[vt][2] * rms * w4[2] * silu(bf_lo(gv.y)), y3 = acc[vt][3] * rms * w4[3] * silu(bf_hi(gv.y));
        v2u o; o.x = pkbf(y0, y1); o.y = pkbf(y2, y3); *(v2u*)(Yp + v) = o; }
}

DI void moba_kmean(Frame& F, int unit) {
    const int blk = unit & 15, bh = unit >> 4, h = bh & 7, b = bh >> 3, tid = F.tid(), ch = tid & 15, rg = tid >> 4;
    const bf16* Kp = F.P() + ((size_t)b * SEQ + blk * 256 + rg) * NPJ + C_MK + h * 128 + ch * 8;
    v4u raw[8];
#pragma unroll
    for (int i = 0; i < 8; ++i) raw[i] = *(const v4u*)(Kp + (size_t)(32 * i) * NPJ);
    float s[8] = {0.f, 0.f, 0.f, 0.f, 0.f, 0.f, 0.f, 0.f}; float r2max = 0.f;
#pragma unroll
    for (int i = 0; i < 8; ++i) { float f[8]; unpack8(raw[i], f); float r2 = 0.f;
#pragma unroll
        for (int e = 0; e < 8; ++e) { s[e] += f[e]; r2 += f[e] * f[e]; }
        r2 += __shfl_xor(r2, 1); r2 += __shfl_xor(r2, 2); r2 += __shfl_xor(r2, 4); r2 += __shfl_xor(r2, 8);
        r2max = fmaxf(r2max, r2); }
    LAS float* red = (LAS float*)F.lds;
    __syncthreads();
    *(LAS f32x4*)(red + rg * 128 + ch * 8) = (f32x4){s[0], s[1], s[2], s[3]}; *(LAS f32x4*)(red + rg * 128 + ch * 8 + 4) = (f32x4){s[4], s[5], s[6], s[7]};
    if (ch == 0) red[4096 + rg] = r2max;
    __syncthreads();
    if (tid < 32) { float m = red[4096 + tid]; m = fmaxf(m, __shfl_xor(m, 1)); m = fmaxf(m, __shfl_xor(m, 2)); m = fmaxf(m, __shfl_xor(m, 4)); m = fmaxf(m, __shfl_xor(m, 8)); m = fmaxf(m, __shfl_xor(m, 16));
        if (tid == 0) F.KMX()[unit] = m; }
    if (tid < 128) { float t = 0.f;
#pragma unroll
        for (int g = 0; g < 32; ++g) t += red[g * 128 + tid];
        const float km = t * (1.0f / 256.0f);
        const unsigned hi = f2bf(km); const float rem = km - __uint_as_float(hi << 16);
        F.KMH()[(size_t)unit * 128 + tid] = (bf16)hi; F.KML()[(size_t)unit * 128 + tid] = (bf16)f2bf(rem); }
}
struct MobaSt {
    bf16x8 Q[2][4]; f32x4 acc[2][8]; f32x4 accl[2]; float cmi[2], kbs[8]; unsigned mym[2], wm;
    const LAS unsigned char* kptr[2][4]; const LAS unsigned char* vptr[2][8];
    unsigned voff[2]; const char* gK; LAS unsigned char* hb; bf16x8 ones;
    float scale2, slope2, slope2i, inv2; int ob, qrel_hi, qpos0, w8, gq;
};
DI void moba_dma(const MobaSt& S, int tt, int bufoff) {
    const char* g = sbase(S.gK + (size_t)tt * (64 * NPJ * 2)); const char* gv = sbase(g + (C_MV - C_MK) * 2);
#pragma unroll
    for (int i = 0; i < 2; ++i) { LAS unsigned char* d = S.hb + bufoff + (S.w8 * 2 + i) * 1024; unsigned vo = S.voff[i]; asm volatile("" : "+v"(vo));
        __builtin_amdgcn_global_load_lds((const unsigned*)(g + vo), (LAS unsigned*)d, 16, 0, 0);
        __builtin_amdgcn_global_load_lds((const unsigned*)(gv + vo), (LAS unsigned*)(d + 16384), 16, 0, 0); }
}
template <int BUF, bool SAFE> DI void moba_tile(MobaSt& S, int tt) {
    const int kb = tt >> 2, tile = tt & 3;
    if (!(((S.wm >> kb) & 1u) && (kb < S.ob || 64 * tile <= S.qrel_hi))) return;
    const bool own = (kb == S.ob);
#pragma unroll
    for (int js = 0; js < 2; ++js) {
        f32x4 s[2][2];
        const float kposf = (float)(tt * 64 + 32 * js);
#pragma unroll
        for (int qi = 0; qi < 2; ++qi) {
            float t0 = fmaf(S.slope2i, kposf, -S.cmi[qi]); t0 = ((S.mym[qi] >> kb) & 1u) ? t0 : -INFINITY;
            s[qi][0] = (f32x4){t0 + S.kbs[0], t0 + S.kbs[1], t0 + S.kbs[2], t0 + S.kbs[3]}; s[qi][1] = (f32x4){t0 + S.kbs[4], t0 + S.kbs[5], t0 + S.kbs[6], t0 + S.kbs[7]};
            if (own) { const int kp = tt * 64 + 32 * js + 8 * S.gq, qp = S.qpos0 + 16 * qi;
#pragma unroll
                for (int e = 0; e < 4; ++e) { s[qi][0][e] = (kp + e <= qp) ? s[qi][0][e] : -INFINITY; s[qi][1][e] = (kp + 4 + e <= qp) ? s[qi][1][e] : -INFINITY; } } }
#pragma unroll
        for (int ks = 0; ks < 4; ++ks) {
            const bf16x8 K0 = *(const LAS bf16x8*)(S.kptr[0][ks] + BUF + 8192 * js), K1 = *(const LAS bf16x8*)(S.kptr[1][ks] + BUF + 8192 * js);
#pragma unroll
            for (int qi = 0; qi < 2; ++qi) { s[qi][0] = mfma16(K0, S.Q[qi][ks], s[qi][0]); s[qi][1] = mfma16(K1, S.Q[qi][ks], s[qi][1]); } }
        bf16x8 Pf[2];
#pragma unroll
        for (int qi = 0; qi < 2; ++qi) {
            float p[8];
#pragma unroll
            for (int e = 0; e < 8; ++e) { const float sv = (e < 4) ? s[qi][0][e & 3] : s[qi][1][e & 3]; p[e] = sv * S.scale2; }
            if constexpr (SAFE) {
                float mx = __builtin_elementwise_maximum(__builtin_elementwise_maximum(p[0], p[1]), p[2]); mx = __builtin_elementwise_maximum(__builtin_elementwise_maximum(mx, p[3]), p[4]);
                mx = __builtin_elementwise_maximum(__builtin_elementwise_maximum(mx, p[5]), p[6]); mx = __builtin_elementwise_maximum(mx, p[7]);
                if (__any(mx > 8.0f)) {
                    mx = fmaxf(mx, __shfl_xor(mx, 16)); mx = fmaxf(mx, __shfl_xor(mx, 32));
                    const float d = fmaxf(mx, 0.f), alpha = __builtin_amdgcn_exp2f(-d);
                    S.cmi[qi] = fmaf(d, S.inv2, S.cmi[qi]); S.accl[qi] *= alpha;
#pragma unroll
                    for (int v = 0; v < 8; ++v) S.acc[qi][v] *= alpha;
#pragma unroll
                    for (int e = 0; e < 8; ++e) p[e] -= d; } }
#pragma unroll
            for (int e = 0; e < 8; ++e) p[e] = __builtin_amdgcn_exp2f(p[e]);
            Pf[qi] = pack8f(p); }
#pragma unroll
        for (int vt = 0; vt < 8; ++vt) {
            const s16x4 lo = __builtin_bit_cast(s16x4, __builtin_amdgcn_ds_read_tr16_b64_v4i16((LAS v4i16_t*)(S.vptr[0][vt] + BUF + 8192 * js)));
            const s16x4 hi = __builtin_bit_cast(s16x4, __builtin_amdgcn_ds_read_tr16_b64_v4i16((LAS v4i16_t*)(S.vptr[1][vt] + BUF + 8192 * js)));
            bf16x8 Vf; Vf[0] = lo[0]; Vf[1] = lo[1]; Vf[2] = lo[2]; Vf[3] = lo[3]; Vf[4] = hi[0]; Vf[5] = hi[1]; Vf[6] = hi[2]; Vf[7] = hi[3];
            S.acc[0][vt] = mfma16(Vf, Pf[0], S.acc[0][vt]); S.acc[1][vt] = mfma16(Vf, Pf[1], S.acc[1][vt]); }
        S.accl[0] = mfma16(S.ones, Pf[0], S.accl[0]); S.accl[1] = mfma16(S.ones, Pf[1], S.accl[1]);
    }
}
DI void moba_attn(Frame& F, int ob, int bh) {
    const int lane = F.lane(), w = F.wave(), gq = lane >> 4, l15 = lane & 15;
    const int h = bh & 7, b = bh >> 3;
    const size_t tq = (size_t)b * SEQ + ob * 256 + w * 32;
    MobaSt S;
    S.ob = ob; S.w8 = w; S.gq = gq; S.hb = F.lds;
    S.scale2 = 0.08838834764831845f * 1.4426950408889634f; S.slope2 = exp2f(-(float)(h + 1)) * 1.4426950408889634f; S.inv2 = 1.0f / S.scale2; S.slope2i = S.slope2 * S.inv2;
#pragma unroll
    for (int qi = 0; qi < 2; ++qi)
#pragma unroll
        for (int ks = 0; ks < 4; ++ks) S.Q[qi][ks] = *(const bf16x8*)(F.P() + (tq + qi * 16 + l15) * NPJ + C_MQ + h * 128 + 32 * ks + 8 * gq);
    { bf16x8 KH[4], KL[4];
#pragma unroll
      for (int ks = 0; ks < 4; ++ks) { KH[ks] = *(const bf16x8*)(F.KMH() + ((size_t)bh * 16 + l15) * 128 + 32 * ks + 8 * gq); KL[ks] = *(const bf16x8*)(F.KML() + ((size_t)bh * 16 + l15) * 128 + 32 * ks + 8 * gq); }
#pragma unroll
      for (int qi = 0; qi < 2; ++qi) { f32x4 g = (f32x4){0.f, 0.f, 0.f, 0.f};
#pragma unroll
          for (int ks = 0; ks < 4; ++ks) { g = mfma16(KH[ks], S.Q[qi][ks], g); g = mfma16(KL[ks], S.Q[qi][ks], g); }
          float gv[4];
#pragma unroll
          for (int r = 0; r < 4; ++r) gv[r] = (4 * gq + r < ob) ? g[r] : -INFINITY;
          unsigned mask = 0u;
#pragma unroll
          for (int pass = 0; pass < 3; ++pass) { float bv = -INFINITY; int bn = 31;
#pragma unroll
              for (int r = 0; r < 4; ++r) { const int n = 4 * gq + r; if (!((mask >> n) & 1u) && gv[r] > bv) { bv = gv[r]; bn = n; } }
#pragma unroll
              for (int off = 16; off <= 32; off <<= 1) { const float ov = __shfl_xor(bv, off); const int on = __shfl_xor(bn, off); if (ov > bv || (ov == bv && on < bn)) { bv = ov; bn = on; } }
              if (bv > -INFINITY) mask |= 1u << bn; }
          S.mym[qi] = mask | (1u << ob); } }
    { unsigned wm = S.mym[0] | S.mym[1]; wm |= __shfl_xor(wm, 1); wm |= __shfl_xor(wm, 2); wm |= __shfl_xor(wm, 4); wm |= __shfl_xor(wm, 8); S.wm = __builtin_amdgcn_readfirstlane(wm); }
#pragma unroll
    for (int qi = 0; qi < 2; ++qi) { const bf16* kp = F.P() + (tq + qi * 16 + l15) * NPJ + C_MK + h * 128 + 8 * gq; float d = 0.f;
#pragma unroll
        for (int ks = 0; ks < 4; ++ks) { float kf[8], qf[8]; unpack8(*(const v4u*)(kp + 32 * ks), kf); unpack8(__builtin_bit_cast(v4u, S.Q[qi][ks]), qf);
#pragma unroll
            for (int e = 0; e < 8; ++e) d += kf[e] * qf[e]; }
        d += __shfl_xor(d, 16); d += __shfl_xor(d, 32); S.cmi[qi] = d; }
    const int qrel0 = w * 32 + l15; S.qpos0 = ob * 256 + qrel0; S.qrel_hi = w * 32 + 31;
    S.cmi[0] += S.slope2i * (float)(S.qpos0 - 8 * gq); S.cmi[1] += S.slope2i * (float)(S.qpos0 + 16 - 8 * gq);
    { int z0 = 0; asm volatile("" : "+s"(z0));
#pragma unroll
      for (int e = 0; e < 8; ++e) S.kbs[e] = __builtin_bit_cast(float, __builtin_amdgcn_readfirstlane(__builtin_bit_cast(int, S.slope2i * (float)(e + z0)))); }
#pragma unroll
    for (int qi = 0; qi < 2; ++qi) { S.accl[qi] = (f32x4){0.f, 0.f, 0.f, 0.f};
#pragma unroll
        for (int v = 0; v < 8; ++v) S.acc[qi][v] = (f32x4){0.f, 0.f, 0.f, 0.f}; }
    { const short one = (l15 == 0) ? (short)0x3F80 : (short)0;
#pragma unroll
      for (int e = 0; e < 8; ++e) S.ones[e] = one; }
#pragma unroll
    for (int sub = 0; sub < 2; ++sub) { const int row = 8 * (l15 >> 2) + 4 * sub + (l15 & 3);
#pragma unroll
        for (int ks = 0; ks < 4; ++ks) { S.kptr[sub][ks] = S.hb + 256 * row + 16 * ((4 * ks + gq) ^ swz(row)); asm volatile("" : "+v"(S.kptr[sub][ks])); } }
    { const int q = l15 >> 2, pp = lane & 3;
#pragma unroll
      for (int t = 0; t < 2; ++t) { const int row = 8 * gq + 4 * t + q;
#pragma unroll
          for (int vt = 0; vt < 8; ++vt) { S.vptr[t][vt] = S.hb + 16384 + 256 * row + 16 * ((2 * vt + (pp >> 1)) ^ swz(row)) + 8 * (pp & 1); asm volatile("" : "+v"(S.vptr[t][vt])); } } }
#pragma unroll
    for (int i = 0; i < 2; ++i) { const int row = 4 * (w * 2 + i) + (lane >> 4), c = (lane & 15) ^ swz(row); S.voff[i] = (unsigned)(row * NPJ + c * 8) * 2u; }
    S.gK = (const char*)(F.P() + (size_t)b * SEQ * NPJ + h * 128 + C_MK);
    const int NT = ob * 4 + 4;
    int fast;
    { float q2 = 0.f;
#pragma unroll
      for (int qi = 0; qi < 2; ++qi) { float ss = 0.f;
#pragma unroll
          for (int ks = 0; ks < 4; ++ks) { float qf[8]; unpack8(__builtin_bit_cast(v4u, S.Q[qi][ks]), qf);
#pragma unroll
              for (int e = 0; e < 8; ++e) ss += qf[e] * qf[e]; }
          ss += __shfl_xor(ss, 16); ss += __shfl_xor(ss, 32); q2 = fmaxf(q2, ss); }
      q2 = fmaxf(q2, __shfl_xor(q2, 1)); q2 = fmaxf(q2, __shfl_xor(q2, 2)); q2 = fmaxf(q2, __shfl_xor(q2, 4)); q2 = fmaxf(q2, __shfl_xor(q2, 8));
      const float qn = sqrtf(q2) * 1.01f, kown = sqrtf(F.KMX()[bh * 16 + ob]) * 1.01f, kj = sqrtf(F.KMX()[bh * 16 + l15]) * 1.01f;
      const float dist = (float)(ob * 256 + w * 32 - (256 * l15 + 255));
      const bool zero = (l15 < ob) && (qn * (kj + kown) * S.scale2 - S.slope2 * dist < -138.0f);
      { float kall = (l15 <= ob) ? kj : 0.f; kall = fmaxf(kall, __shfl_xor(kall, 1)); kall = fmaxf(kall, __shfl_xor(kall, 2)); kall = fmaxf(kall, __shfl_xor(kall, 4)); kall = fmaxf(kall, __shfl_xor(kall, 8));
        fast = __builtin_amdgcn_readfirstlane((int)(qn * (kall + kown) * S.scale2 <= 100.0f)); }
      const unsigned zmask = (unsigned)(__ballot(zero) & 0xFFFFull);
      S.wm &= ~zmask;
      const int lead = __builtin_ctz(~zmask);
      if (lane == 0) ((volatile LAS int*)(F.lds + LDSCTL_OFF + 512))[w] = lead; }
    __syncthreads();
    int T0;
    { volatile LAS int* le = (volatile LAS int*)(F.lds + LDSCTL_OFF + 512); int m = le[0];
#pragma unroll
      for (int k = 1; k < 8; ++k) m = min(m, le[k]);
      T0 = 4 * __builtin_amdgcn_readfirstlane(m); }
    moba_dma(S, T0, 0);
    VM_WAIT(); __syncthreads();
    if (fast) {
        for (int tt = T0; tt < NT; tt += 2) {
            moba_dma(S, tt + 1, 32768);
            moba_tile<0, false>(S, tt);
            VM_WAIT(); __syncthreads();
            if (tt + 2 < NT) moba_dma(S, tt + 2, 0);
            moba_tile<32768, false>(S, tt + 1);
            VM_WAIT(); __syncthreads();
        }
    } else {
        for (int tt = T0; tt < NT; tt += 2) {
            moba_dma(S, tt + 1, 32768);
            moba_tile<0, true>(S, tt);
            VM_WAIT(); __syncthreads();
            if (tt + 2 < NT) moba_dma(S, tt + 2, 0);
            moba_tile<32768, true>(S, tt + 1);
            VM_WAIT(); __syncthreads();
        }
    }
#pragma unroll
    for (int qi = 0; qi < 2; ++qi) { const float lt = __shfl(S.accl[qi][0], l15); const float inv = 1.0f / lt; const size_t ti = tq + qi * 16 + l15;
        const bf16* Gp = F.P() + ti * NPJ + C_MG + h * 128; bf16* Yp = F.Y() + ti * DM + 1024 + h * 128;
#pragma unroll
        for (int vt = 0; vt < 8; ++vt) { const int v = 16 * vt + 4 * gq; const v2u gv = *(const v2u*)(Gp + v);
            const float y0 = S.acc[qi][vt][0] * inv * silu(bf_lo(gv.x)), y1 = S.acc[qi][vt][1] * inv * silu(bf_hi(gv.x)), y2 = S.acc[qi][vt][2] * inv * silu(bf_lo(gv.y)), y3 = S.acc[qi][vt][3] * inv * silu(bf_hi(gv.y));
            v2u o; o.x = pkbf(y0, y1); o.y = pkbf(y2, y3); *(v2u*)(Yp + v) = o; } }
}

DI void ssd_A(Frame& F, int l, int unit) {
    const int grp = unit & 3, bc = unit >> 2, c = bc & 15, b = bc >> 4, tid = F.tid(), lane = F.lane(), w = F.wave(), gq = lane >> 4;
    const size_t t0 = (size_t)b * SEQ + c * 256;
    LAS float* dtl = (LAS float*)F.lds; LAS float* dacs = dtl + 1024; LAS float* fac = dtl + 2048;
    LAS unsigned char* Bt = F.lds + 12288; LAS unsigned char* XWt = Bt + 64 * SB128;
    __syncthreads();
    for (int idx = tid; idx < 1024; idx += NTHR) { const int r = idx >> 8, t = idx & 255, head = 4 * grp + r;
        const float raw = F.DTRAW()[(t0 + t) * 16 + head] + F.in(6)[l * 16 + head]; const float dt = softplus(raw), a = -__expf(F.in(7)[l * 16 + head]);
        dtl[idx] = dt; dacs[idx] = dt * a; }
    __syncthreads();
    if (w < 4) { float x0 = dacs[w * 256 + 4 * lane], x1 = dacs[w * 256 + 4 * lane + 1], x2 = dacs[w * 256 + 4 * lane + 2], x3 = dacs[w * 256 + 4 * lane + 3];
        x1 += x0; x2 += x1; x3 += x2; float tot = x3;
#pragma unroll
        for (int o = 1; o < 64; o <<= 1) { const float y = __shfl_up(tot, o); if (lane >= o) tot += y; }
        const float ex = tot - x3;
        dacs[w * 256 + 4 * lane] = x0 + ex; dacs[w * 256 + 4 * lane + 1] = x1 + ex; dacs[w * 256 + 4 * lane + 2] = x2 + ex; dacs[w * 256 + 4 * lane + 3] = x3 + ex; }
    __syncthreads();
    for (int idx = tid; idx < 1024; idx += NTHR) { const int r = idx >> 8, t = idx & 255, head = 4 * grp + r; const float dc = dacs[idx], dt = dtl[idx];
        fac[idx] = __expf(dacs[r * 256 + 255] - dc) * dt; F.DT()[(t0 + t) * 16 + head] = dt; F.DACS()[(t0 + t) * 16 + head] = dc * 1.4426950408889634f; }
    f32x4 acc[16];
#pragma unroll
    for (int v = 0; v < 16; ++v) acc[v] = (f32x4){0.f, 0.f, 0.f, 0.f};
    const int cc = tid & 63, tg = tid >> 6;
    const int chn = cc < 32 ? grp * 256 + cc * 8 : (cc < 48 ? 1024 + grp * 128 + (cc - 32) * 8 : 1536 + grp * 128 + (cc - 48) * 8);
    float cw[4][8], cb[8];
#pragma unroll
    for (int k = 0; k < 4; ++k) { const f32x4 a = *(const f32x4*)(F.in(4) + ((size_t)l * 4 + k) * 2048 + chn), bq = *(const f32x4*)(F.in(4) + ((size_t)l * 4 + k) * 2048 + chn + 4);
        cw[k][0] = a[0]; cw[k][1] = a[1]; cw[k][2] = a[2]; cw[k][3] = a[3]; cw[k][4] = bq[0]; cw[k][5] = bq[1]; cw[k][6] = bq[2]; cw[k][7] = bq[3]; }
    { const f32x4 a = *(const f32x4*)(F.in(5) + (size_t)l * 2048 + chn), bq = *(const f32x4*)(F.in(5) + (size_t)l * 2048 + chn + 4);
      cb[0] = a[0]; cb[1] = a[1]; cb[2] = a[2]; cb[3] = a[3]; cb[4] = bq[0]; cb[5] = bq[1]; cb[6] = bq[2]; cb[7] = bq[3]; }
    const bf16* Xp = F.P() + t0 * NPJ + C_SX + chn;
    for (int jt = 0; jt < 4; ++jt) {
        __syncthreads();
        { const int tl0 = jt * 64 + tg * 8; float h0[8], h1[8], h2[8];
          { const bool z = (c == 0 && tl0 < 3);
            if (z) {
#pragma unroll
                for (int e = 0; e < 8; ++e) { h0[e] = 0.f; h1[e] = 0.f; h2[e] = 0.f; }
            } else { unpack8(*(const v4u*)(Xp + ((long)tl0 - 3) * NPJ), h0); unpack8(*(const v4u*)(Xp + ((long)tl0 - 2) * NPJ), h1); unpack8(*(const v4u*)(Xp + ((long)tl0 - 1) * NPJ), h2); } }
          v4u xraw[8];
#pragma unroll
          for (int i = 0; i < 8; ++i) xraw[i] = *(const v4u*)(Xp + (size_t)(tl0 + i) * NPJ);
#pragma unroll
          for (int i = 0; i < 8; ++i) { const int tl = tl0 + i; float x[8], y[8]; unpack8(xraw[i], x);
#pragma unroll
              for (int e = 0; e < 8; ++e) { const float v = cb[e] + cw[0][e] * h0[e] + cw[1][e] * h1[e] + cw[2][e] * h2[e] + cw[3][e] * x[e]; y[e] = silu(v); h0[e] = h1[e]; h1[e] = h2[e]; h2[e] = x[e]; }
              *(v4u*)(F.XBC() + (t0 + tl) * 2048 + chn) = pack8(y);
              if (cc < 32) { const float f = fac[(cc >> 3) * 256 + tl];
#pragma unroll
                  for (int e = 0; e < 8; ++e) y[e] *= f;
                  *(LAS v4u*)(XWt + (tg * 8 + i) * SB256 + cc * 16) = pack8(y); }
              else if (cc < 48) *(LAS v4u*)(Bt + (tg * 8 + i) * SB128 + (cc - 32) * 16) = pack8(y); } }
        __syncthreads();
#pragma unroll
        for (int ks = 0; ks < 2; ++ks) { const int ra = 32 * ks + 8 * gq, rb = ra + 4; const bf16x8 A = frag_tr(Bt, SB128, ra, rb, 16 * w, lane);
#pragma unroll
            for (int pt = 0; pt < 16; ++pt) acc[pt] = mfma16(A, frag_tr(XWt, SB256, ra, rb, 16 * pt, lane), acc[pt]); }
    }
#pragma unroll
    for (int pt = 0; pt < 16; ++pt) { const int head = 4 * grp + (pt >> 2); float* S = F.SST() + ((size_t)bc * 16 + head) * 8192;
        *(f32x4*)(S + ((pt & 3) * 16 + (lane & 15)) * 128 + 16 * w + 4 * gq) = acc[pt]; }
}
DI void ssd_B(Frame& F) {
    for (int it = blockIdx.x * NTHR + F.tid(); it < 32 * 2048; it += F.G() * NTHR) { const int e4 = it & 2047, bhd = it >> 11, head = bhd & 15, b = bhd >> 4; f32x4 s = (f32x4){0.f, 0.f, 0.f, 0.f};
        const size_t o0 = ((size_t)(b * 16) * 16 + head) * 8192 + (size_t)e4 * 4; const float* __restrict__ st = F.SST() + o0; bf16* __restrict__ hp = F.SHP() + o0;
        f32x4 u[15]; float dec[15];
#pragma unroll
        for (int c = 0; c < 15; ++c) { u[c] = *(const f32x4*)(st + (size_t)c * 16 * 8192); dec[c] = F.DACS()[((size_t)b * SEQ + c * 256 + 255) * 16 + head]; }
#pragma unroll
        for (int c = 0; c < 16; ++c) { *(unsigned long long*)(hp + (size_t)c * 16 * 8192) = (unsigned long long)pkbf(s[0], s[1]) | ((unsigned long long)pkbf(s[2], s[3]) << 32);
            if (c < 15) s = s * __builtin_amdgcn_exp2f(dec[c]) + u[c]; } }
}
template <int NROWS> DI void dma_rows128(const bf16* src, unsigned gp, LAS unsigned char* dst, int w, int lane) {
    const char* sb = (const char*)src;
#pragma unroll
    for (int i = 0; i < NROWS / 32; ++i) { const int idx = w * (NROWS / 32) + i, row = 4 * idx + (lane >> 4), c = (lane & 15) ^ swz(row);
        __builtin_amdgcn_global_load_lds((const unsigned*)(sb + ((unsigned)row * gp + (unsigned)c * 8u) * 2u), (LAS unsigned*)(dst + idx * 1024), 16, 0, 0); }
}
DI bf16x8 frag_row_sw256(const LAS unsigned char* t, int row, int ch) { return *(const LAS bf16x8*)(t + 256 * row + 16 * (ch ^ swz(row))); }
constexpr int SC_B = 0, SC_X = 16384, SC_DA = 49152, SC_DT = 50176;
DI void ssd_dma_tile(Frame& F, size_t trow, int grp, LAS unsigned char* buf, int w, int lane) {
    dma_rows128<64>(F.XBC() + trow * 2048 + 1024 + grp * 128, 2048, buf + SC_B, w, lane);
    dma_tile256(F.XBC() + trow * 2048 + grp * 256, 2048, buf + SC_X, w, lane);
    if (w == 0) __builtin_amdgcn_global_load_lds((const unsigned*)(F.DACS() + (trow + lane) * 16 + 4 * grp), (LAS unsigned*)(buf + SC_DA), 16, 0, 0);
    if (w == 1) __builtin_amdgcn_global_load_lds((const unsigned*)(F.DT() + (trow + lane) * 16 + 4 * grp), (LAS unsigned*)(buf + SC_DT), 16, 0, 0);
}
DI void ssd_C(Frame& F, int l, int unit2) {
    const int half = unit2 & 1, unit = unit2 >> 1, grp = unit & 3, bc = unit >> 2, c = bc & 15, b = bc >> 4, lane = F.lane(), w = F.wave(), gq = lane >> 4, l15 = lane & 15;
    const size_t t0 = (size_t)b * SEQ + c * 256; const int il = half * 128 + w * 16 + l15; const size_t ti = t0 + il;
    LAS unsigned char* B0 = F.lds; LAS unsigned char* B1 = F.lds + 65536;
    if (c > 0) dma_rows128<256>(F.SHP() + ((size_t)bc * 16 + 4 * grp) * 8192, 128, B0, w, lane); else ssd_dma_tile(F, t0, grp, B0, w, lane);
    bf16x8 Cf[4];
#pragma unroll
    for (int ks = 0; ks < 4; ++ks) Cf[ks] = *(const bf16x8*)(F.XBC() + ti * 2048 + 1536 + grp * 128 + 32 * ks + 8 * gq);
    f32x4 acc[4][4]; float dci[4];
    { const f32x4 d4 = *(const f32x4*)(F.DACS() + ti * 16 + 4 * grp); dci[0] = d4[0]; dci[1] = d4[1]; dci[2] = d4[2]; dci[3] = d4[3]; }
#pragma unroll
    for (int r = 0; r < 4; ++r)
#pragma unroll
        for (int pt = 0; pt < 4; ++pt) acc[r][pt] = (f32x4){0.f, 0.f, 0.f, 0.f};
    const int njt = 2 * (half + 1);
    VM_WAIT(); __syncthreads();
    int par = 0;
    if (c > 0) {
        ssd_dma_tile(F, t0, grp, B1, w, lane);
#pragma unroll
        for (int r = 0; r < 4; ++r) {
#pragma unroll
            for (int ks = 0; ks < 4; ++ks)
#pragma unroll
                for (int pt = 0; pt < 4; ++pt) acc[r][pt] = mfma16(frag_row_sw256(B0, r * 64 + 16 * pt + l15, 4 * ks + gq), Cf[ks], acc[r][pt]);
            const float ed = __builtin_amdgcn_exp2f(dci[r]);
#pragma unroll
            for (int pt = 0; pt < 4; ++pt) acc[r][pt] *= ed; }
        VM_WAIT(); __syncthreads();
        par = 1;
    }
    for (int jt = 0; jt < njt; ++jt) {
        LAS unsigned char* cur = ((jt + par) & 1) ? B1 : B0; LAS unsigned char* nxt = ((jt + par) & 1) ? B0 : B1;
        if (jt + 1 < njt) ssd_dma_tile(F, t0 + 64 * (jt + 1), grp, nxt, w, lane);
        if (64 * jt <= half * 128 + w * 16 + 15) {
            int lz = lane; asm volatile("" : "+v"(lz));
            const int gq = lz >> 4, l15 = lz & 15, lane = lz;
            const bool diag = 64 * jt + 63 > half * 128 + w * 16;
#pragma unroll
            for (int js = 0; js < 2; ++js) {
                f32x4 s0 = (f32x4){0.f, 0.f, 0.f, 0.f}, s1 = s0, s0b = s0, s1b = s0;
                const int kr0 = 32 * js + 8 * (l15 >> 2) + (l15 & 3), kr1 = kr0 + 4;
#pragma unroll
                for (int ks = 0; ks < 4; ks += 2) { s0 = mfma16(frag_row_sw256(cur + SC_B, kr0, 4 * ks + gq), Cf[ks], s0); s1 = mfma16(frag_row_sw256(cur + SC_B, kr1, 4 * ks + gq), Cf[ks], s1);
                    s0b = mfma16(frag_row_sw256(cur + SC_B, kr0, 4 * ks + 4 + gq), Cf[ks + 1], s0b); s1b = mfma16(frag_row_sw256(cur + SC_B, kr1, 4 * ks + 4 + gq), Cf[ks + 1], s1b); }
                s0 += s0b; s1 += s1b;
                float p[4][8];
#pragma unroll
                for (int e = 0; e < 8; ++e) { const int j = 64 * jt + 32 * js + 8 * gq + e; const float sv = (e < 4) ? s0[e & 3] : s1[e & 3];
                    const f32x4 dj = *(const LAS f32x4*)(cur + SC_DA + (32 * js + 8 * gq + e) * 16), dtj = *(const LAS f32x4*)(cur + SC_DT + (32 * js + 8 * gq + e) * 16);
#pragma unroll
                    for (int r = 0; r < 4; ++r) { float ex = dci[r] - dj[r]; if (diag) ex = (il >= j) ? ex : -INFINITY; p[r][e] = sv * __builtin_amdgcn_exp2f(ex) * dtj[r]; } }
#pragma unroll
                for (int r = 0; r < 4; ++r) { const bf16x8 Pf = pack8f(p[r]);
#pragma unroll
                    for (int pt = 0; pt < 4; ++pt) acc[r][pt] = mfma16(frag_tr_sw512(cur + SC_X, 32 * js + 8 * gq, 32 * js + 8 * gq + 4, r * 64 + 16 * pt, lane), Pf, acc[r][pt]); }
            }
        }
        VM_WAIT(); __syncthreads();
    }
    float ss = 0.f;
    const bf16* xb = F.XBC() + ti * 2048 + grp * 256 + 4 * gq; const bf16* zb = F.P() + ti * NPJ + C_SZ + grp * 256 + 4 * gq;
#pragma unroll
    for (int r = 0; r < 4; ++r) { const float dsk = F.in(8)[l * 16 + 4 * grp + r];
#pragma unroll
        for (int pt = 0; pt < 4; ++pt) { const v2u xv = *(const v2u*)(xb + r * 64 + 16 * pt), zv = *(const v2u*)(zb + r * 64 + 16 * pt);
            f32x4 y = acc[r][pt]; y[0] = (y[0] + dsk * bf_lo(xv.x)) * silu(bf_lo(zv.x)); y[1] = (y[1] + dsk * bf_hi(xv.x)) * silu(bf_hi(zv.x)); y[2] = (y[2] + dsk * bf_lo(xv.y)) * silu(bf_lo(zv.y)); y[3] = (y[3] + dsk * bf_hi(xv.y)) * silu(bf_hi(zv.y));
            acc[r][pt] = y; ss += (y[0] * y[0] + y[1] * y[1]) + (y[2] * y[2] + y[3] * y[3]); }
        asm volatile("" ::: "memory"); }
    ss += __shfl_xor(ss, 16); ss += __shfl_xor(ss, 32);
    const float rms = rsqrtf(ss * (1.0f / 256.0f) + EPS);
    const float* nw = F.in(9) + (size_t)l * 1024 + grp * 256 + 4 * gq; bf16* yb = F.Y() + ti * DM + 2048 + grp * 256 + 4 * gq;
#pragma unroll
    for (int r = 0; r < 4; ++r)
#pragma unroll
        for (int pt = 0; pt < 4; ++pt) { const f32x4 w4 = *(const f32x4*)(nw + r * 64 + 16 * pt); const f32x4 y = acc[r][pt] * rms * w4;
            v2u o; o.x = pkbf(y[0], y[1]); o.y = pkbf(y[2], y[3]); *(v2u*)(yb + r * 64 + 16 * pt) = o; }
}

DI void lru_A(Frame& F, int l, int unit) {
    const int nb = unit & 7, bc = unit >> 3, c256 = bc & 15, b = bc >> 4, tid = F.tid(), lane = F.lane(), w = F.wave(), gq = lane >> 4;
    const int chn0 = nb * 128;
    LAS float* xcf = (LAS float*)F.lds; LAS float* al = xcf + 8192; LAS unsigned char* xcb = F.lds + 65536;
    LAS float* sh = (LAS float*)(F.lds + 65536 + 64 * SB128); LAS float* sa = sh + 512;
    const int ch8 = tid & 15, tg = tid >> 4, chn = chn0 + ch8 * 8, tl0 = tg * 2; float cw[4][8], cb[8];
#pragma unroll
    for (int k = 0; k < 4; ++k) { const f32x4 a = *(const f32x4*)(F.in(10) + ((size_t)l * 4 + k) * 1024 + chn), bq = *(const f32x4*)(F.in(10) + ((size_t)l * 4 + k) * 1024 + chn + 4);
        cw[k][0] = a[0]; cw[k][1] = a[1]; cw[k][2] = a[2]; cw[k][3] = a[3]; cw[k][4] = bq[0]; cw[k][5] = bq[1]; cw[k][6] = bq[2]; cw[k][7] = bq[3]; }
    { const f32x4 a = *(const f32x4*)(F.in(11) + (size_t)l * 1024 + chn), bq = *(const f32x4*)(F.in(11) + (size_t)l * 1024 + chn + 4);
      cb[0] = a[0]; cb[1] = a[1]; cb[2] = a[2]; cb[3] = a[3]; cb[4] = bq[0]; cb[5] = bq[1]; cb[6] = bq[2]; cb[7] = bq[3]; }
    const int eg = 16 * w + (lane & 15), chg = chn0 + eg;
    bf16x8 Ba[4], Bx[4];
    { const bf16* WTa = F.LRUW() + ((((size_t)l * 2 + 0) * 8 + nb) * 128 + eg) * 128; const bf16* WTx = F.LRUW() + ((((size_t)l * 2 + 1) * 8 + nb) * 128 + eg) * 128;
#pragma unroll
      for (int ks = 0; ks < 4; ++ks) { Ba[ks] = *(const bf16x8*)(WTa + 32 * ks + 8 * gq); Bx[ks] = *(const bf16x8*)(WTx + 32 * ks + 8 * gq); } }
    const float ba = F.in(13)[l * 1024 + chg], bx = F.in(15)[l * 1024 + chg], spl = softplus(-F.in(16)[l * 1024 + chg]);
    const size_t tu = (size_t)b * SEQ + c256 * 256;
    const bf16* Xp0 = F.P() + tu * NPJ + C_LX + chn;
    v4u raw[5];
#pragma unroll
    for (int k = 0; k < 5; ++k) { const int tl = tl0 - 3 + k; raw[k] = (c256 == 0 && tl < 0) ? (v4u){0u, 0u, 0u, 0u} : *(const v4u*)(Xp0 + (long)tl * NPJ); }
    for (int sc = 0; sc < 4; ++sc) {
        const int cc = c256 * 4 + sc, bcc = b * 64 + cc; const size_t t0 = tu + sc * 64;
        float xr[5][8];
#pragma unroll
        for (int k = 0; k < 5; ++k) unpack8(raw[k], xr[k]);
        if (sc < 3) {
#pragma unroll
            for (int k = 0; k < 5; ++k) raw[k] = *(const v4u*)(Xp0 + (long)((sc + 1) * 64 + tl0 - 3 + k) * NPJ); }
        __syncthreads();
#pragma unroll
        for (int i = 0; i < 2; ++i) { float y[8];
#pragma unroll
            for (int e = 0; e < 8; ++e) y[e] = cb[e] + cw[0][e] * xr[i][e] + cw[1][e] * xr[i + 1][e] + cw[2][e] * xr[i + 2][e] + cw[3][e] * xr[i + 3][e];
            *(LAS f32x4*)(xcf + (tl0 + i) * 128 + ch8 * 8) = (f32x4){y[0], y[1], y[2], y[3]}; *(LAS f32x4*)(xcf + (tl0 + i) * 128 + ch8 * 8 + 4) = (f32x4){y[4], y[5], y[6], y[7]};
            *(LAS v4u*)(xcb + (tl0 + i) * SB128 + ch8 * 16) = pack8(y); }
        __syncthreads();
#pragma unroll
        for (int mt = 0; mt < 4; ++mt) { f32x4 ra = (f32x4){0.f, 0.f, 0.f, 0.f}, rx = ra;
#pragma unroll
            for (int ks = 0; ks < 4; ++ks) { const bf16x8 A = frag_row(xcb, SB128, 16 * mt, 32 * ks, lane); ra = mfma16(A, Ba[ks], ra); rx = mfma16(A, Bx[ks], rx); }
#pragma unroll
            for (int reg = 0; reg < 4; ++reg) { const int t = 16 * mt + 4 * gq + reg; const float r_ = sigm(ra[reg] + ba), i_ = sigm(rx[reg] + bx), la = -8.0f * r_ * spl;
                const float a = __expf(la), u = __builtin_amdgcn_sqrtf(one_minus_exp(2.0f * la)) * i_ * xcf[t * 128 + eg]; al[t * 128 + eg] = a; xcf[t * 128 + eg] = u; } }
        __syncthreads();
        { const int e = tid & 127, seg = tid >> 7, ch = chn0 + e; float hv[16], av[16]; float hh = 0.f, ap = 1.f;
#pragma unroll
          for (int t = 0; t < 16; ++t) { const float a = al[(seg * 16 + t) * 128 + e], u = xcf[(seg * 16 + t) * 128 + e]; hh = a * hh + u; ap *= a; hv[t] = hh; av[t] = ap; }
          sh[seg * 128 + e] = hh; sa[seg * 128 + e] = ap;
          __syncthreads();
          float cin = 0.f, ain = 1.f;
#pragma unroll
          for (int k = 0; k < 3; ++k) if (k < seg) { cin = sa[k * 128 + e] * cin + sh[k * 128 + e]; ain *= sa[k * 128 + e]; }
#pragma unroll
          for (int t = 0; t < 16; ++t) { const size_t o = (t0 + seg * 16 + t) * 1024 + ch; F.HLOC()[o] = (bf16)f2bf(hv[t] + av[t] * cin); F.ACUM()[o] = (bf16)f2bf(av[t] * ain); }
          if (seg == 3) { F.HEND()[(size_t)bcc * 1024 + ch] = hv[15] + av[15] * cin; F.AEND()[(size_t)bcc * 1024 + ch] = av[15] * ain; } }
    }
}
DI void lru_B(Frame& F) {
    for (int it = blockIdx.x * NTHR + F.tid(); it < 2048; it += F.G() * NTHR) { const int ch = it & 1023, b = it >> 10; float carry = 0.f;
        const float* __restrict__ ae = F.AEND() + (size_t)(b * 64) * 1024 + ch; const float* __restrict__ he = F.HEND() + (size_t)(b * 64) * 1024 + ch; float* __restrict__ cr = F.CARRY() + (size_t)(b * 64) * 1024 + ch;
        float a[64], hh[64];
#pragma unroll
        for (int k = 0; k < 64; ++k) { a[k] = ae[(size_t)k * 1024]; hh[k] = he[(size_t)k * 1024]; }
#pragma unroll
        for (int k = 0; k < 64; ++k) { cr[(size_t)k * 1024] = carry; carry = a[k] * carry + hh[k]; } }
}
DI void lru_C(Frame& F, int unit) {
    const size_t tb = (size_t)unit * 32;
#pragma unroll 4
    for (int idx = F.tid(); idx < 32 * 128; idx += NTHR) { const size_t t = tb + (idx >> 7); const int ch = (idx & 127) * 8; const int b = (int)(t / SEQ), cc = (int)(t % SEQ) >> 6;
        const float* cr = F.CARRY() + (size_t)(b * 64 + cc) * 1024 + ch;
        float hl[8], ac[8], g[8]; unpack8(*(const v4u*)(F.HLOC() + t * 1024 + ch), hl); unpack8(*(const v4u*)(F.ACUM() + t * 1024 + ch), ac); unpack8(*(const v4u*)(F.P() + t * NPJ + C_LG + ch), g);
        const f32x4 c0 = *(const f32x4*)cr, c1 = *(const f32x4*)(cr + 4);
        float y[8];
#pragma unroll
        for (int e = 0; e < 8; ++e) { const float cv = e < 4 ? c0[e & 3] : c1[e & 3]; y[e] = (hl[e] + ac[e] * cv) * silu(g[e]); }
        *(v4u*)(F.Y() + t * DM + 3072 + ch) = pack8(y); }
}

__global__ void __launch_bounds__(NTHR, 2) hymba_fwd(Args args) {
    extern __shared__ __attribute__((aligned(16))) unsigned char lds[];
    Frame F = mk_frame((LAS unsigned char*)lds, &args);
    for (int u = F.tid(); u < (LDS_BYTES - LDSCTL_OFF) / 4; u += NTHR) ((LAS unsigned*)(F.lds + LDSCTL_OFF))[u] = 0u;
    __syncthreads();
    const int lo = args.ph_lo, hi = args.ph_hi;
    XcdBarrier bar; bar.bar = F.ctl() + CW_BAR; bar.x = 0; bar.st = nullptr;
    if (hi - lo > 1) bar = xcd_barrier_post(F.ctl() + CW_BAR, F.MISC() + 8);
#define IN(k) (lo <= (k) && (k) < hi)
#define SEAM(k) do { if (IN(k) && IN((k) + 1)) xcd_barrier(bar); } while (0)

    if (IN(0)) { p0_prologue(F);
#ifdef PROBE_PRO2
        xcd_barrier(bar); p0_prologue(F);
#endif
        SEAM(0); }
    for (int l = 0; l < DEPTH; ++l) {
        const int pb = 1 + 5 * l;
        if (IN(pb)) { F = mk_frame((LAS unsigned char*)lds, &args);
            pg8::Gemm g{F.XB(), F.WIN() + (size_t)l * NPJ * DM, MTOK, 12288, DM}; pg8::RemapOrder S; S.init(MTOK, 12288, F.G(), (int)blockIdx.x);
            pg8::Unit u0; S.next(0, u0); const int fm = u0.pm & ~7; LAS float* rtab = (LAS float*)(F.lds + LDSCTL_OFF + 1024);
            { const float* sq = F.SSQ() + (size_t)fm * 256 * 16;
              for (int r = F.tid(); r < 2048; r += NTHR) { const f32x4* p = (const f32x4*)(sq + (size_t)r * 16); const f32x4 a = p[0], b4 = p[1], c4 = p[2], d4 = p[3];
                  const float ssum = ((a[0] + a[1]) + (a[2] + a[3])) + ((b4[0] + b4[1]) + (b4[2] + b4[3])) + ((c4[0] + c4[1]) + (c4[2] + c4[3])) + ((d4[0] + d4[1]) + (d4[2] + d4[3]));
                  rtab[r] = rsqrtf(ssum * (1.0f / 4096.0f) + EPS); }
              __syncthreads(); }
            pg8::EpiProj E{F.P(), F.DTRAW(), F.SSQ(), rtab, fm};
#ifdef PROBE_IN2
            for (int rep2 = 0; rep2 < 2; ++rep2) { pg8::gemm_phase<pg8::EpiProj, pg8::RemapOrder, true, true>(F.lds, g, S, E); if (rep2 == 0) xcd_barrier(bar); }
#else
            pg8::gemm_phase<pg8::EpiProj, pg8::RemapOrder, true, true>(F.lds, g, S, E);
#endif
            SEAM(pb);
        }
#ifdef PROBE_MIX2
        for (int rep = 0; rep < 2; ++rep) {
#else
        { constexpr int rep = 0;
#endif
        if (IN(pb + 1)) { F = mk_frame((LAS unsigned char*)lds, &args);
#ifndef NO_STAGE_A
            for (int u = (int)blockIdx.x;; u = F.G() + next_unit(F, l * 4 + 0 + 2 * rep)) { F = mk_frame((LAS unsigned char*)lds, &args);
                if (u < 160) { const int t = u >> 5; pg8::Gemm g{F.XB(), F.WIN() + (size_t)l * NPJ * DM, MTOK, NPJ, DM}; pg8::OneUnit S1{u & 31, t == 0 ? 35 : 47 + t}; pg8::EpiProj E{F.P(), F.DTRAW(), F.SSQ(), nullptr, 0};
                    pg8::gemm_phase<pg8::EpiProj, pg8::OneUnit, true, true>(F.lds, g, S1, E); }
                else if (u < 288) ssd_A(F, l, u - 160);
                else if (u < 544) lru_A(F, l, u - 288);
                else if (u < 672) ret_A(F, u - 544);
                else if (u < 928) moba_kmean(F, u - 672);
                else if (u < 928 + 512) tr_unit(F, l, TR_I_IN + 2 * (u - 928), 2);
                else if (u < 1440 + 840 && l + 1 < DEPTH) tr_unit(F, l + 1, 2 * (u - 1440), 2);
                else break; }
#endif
            SEAM(pb + 1);
        }
        if (IN(pb + 2)) { F = mk_frame((LAS unsigned char*)lds, &args);
#ifndef NO_STAGE_B
            ret_B(F); ssd_B(F); lru_B(F);
#endif
            SEAM(pb + 2);
        }
        if (IN(pb + 3)) { F = mk_frame((LAS unsigned char*)lds, &args);
#ifndef NO_STAGE_C
            for (int u = (int)blockIdx.x;; u = F.G() + next_unit(F, l * 4 + 1 + 2 * rep)) { F = mk_frame((LAS unsigned char*)lds, &args);
                if (u < 256) moba_attn(F, 15 - (u >> 4), u & 15);
                else if (u < 512) ret_C(F, l, u - 256);
                else if (u < 768) ssd_C(F, l, u - 512);
                else if (u < 1024) lru_C(F, u - 768);
                else if (u < 1024 + 840 && l + 1 < DEPTH) tr_unit(F, l + 1, 1680 + 2 * (u - 1024), 2);
                else break; }
#endif
            SEAM(pb + 3);
        }
        }
        if (IN(pb + 4)) { F = mk_frame((LAS unsigned char*)lds, &args);
            pg8::Gemm g{F.Y(), F.WOUT() + (size_t)l * DM * DM, MTOK, DM, DM}; pg8::StaticOrder S; S.init(MTOK, DM, F.G(), (int)blockIdx.x);
            pg8::EpiOut E{F.XB(), F.SSQ(), (LAS float*)(F.lds + LDSCTL_OFF + 1024)};
            pg8::gemm_phase<pg8::EpiOut, pg8::StaticOrder, true, true>(F.lds, g, S, E);
            SEAM(pb + 4);
        }
    }
    if (IN(NPHASE - 1)) { F = mk_frame((LAS unsigned char*)lds, &args); p_final(F); }
#undef IN
#undef SEAM
}

#ifndef MK_ONE_LAUNCH
#define MK_ONE_LAUNCH 1
#endif
extern "C" void kernel_launch(void* const* d_in, const int* in_sizes, int n_in, void* d_out, int out_size, void* d_ws, size_t ws_size, hipStream_t stream) {
    static int grid = 0;
    if (grid == 0) {
        if (n_in != 19 || out_size != MTOK * DM || ws_size < WS_END) { fprintf(stderr, "kernel_launch: unexpected shapes (n_in %d, out %d, ws %zu)\n", n_in, out_size, ws_size); grid = -1; return; }
        int dev = 0, cus = 0, per_cu = 0;
        if (hipGetDevice(&dev) != hipSuccess || hipDeviceGetAttribute(&cus, hipDeviceAttributeMultiprocessorCount, dev) != hipSuccess) { grid = -1; return; }
        if (hipFuncSetAttribute((const void*)hymba_fwd, hipFuncAttributeMaxDynamicSharedMemorySize, LDS_BYTES) != hipSuccess) { fprintf(stderr, "kernel_launch: hipFuncSetAttribute failed\n"); grid = -1; return; }
        if (hipOccupancyMaxActiveBlocksPerMultiprocessor(&per_cu, (const void*)hymba_fwd, NTHR, LDS_BYTES) != hipSuccess || per_cu < 1) { fprintf(stderr, "kernel_launch: occupancy query says %d\n", per_cu); }
        (void)hipGetLastError();
        grid = cus;
    }
    if (grid < 0) return;
    (void)hipMemsetAsync((char*)d_ws + WS_CTL, 0, CTL_ZERO_BYTES, stream);
    Args a{};
    for (int i = 0; i < 19; ++i) a.in[i] = (const float*)d_in[i];
    a.out = (float*)d_out; a.ws = (unsigned char*)d_ws;
#if MK_ONE_LAUNCH
    a.ph_lo = 0; a.ph_hi = NPHASE;
    hipLaunchKernelGGL(hymba_fwd, dim3(grid), dim3(NTHR), LDS_BYTES, stream, a);
#else
    for (int p = 0; p < NPHASE; ++p) { a.ph_lo = p; a.ph_hi = p + 1; hipLaunchKernelGGL(hymba_fwd, dim3(grid), dim3(NTHR), LDS_BYTES, stream, a); }
#endif
}
```

```cpp
#include <hip/hip_runtime.h>
#include <cstdio>
#include <cstdint>
#include <cmath>
namespace pg8 {
#define PG8_LAS __attribute__((address_space(3)))
typedef unsigned short bf16_t;
typedef short bf16x8 __attribute__((ext_vector_type(8)));
typedef float f32x4 __attribute__((ext_vector_type(4)));
typedef unsigned u32x4 __attribute__((ext_vector_type(4)));
constexpr int BM = 256, BK = 64, HALF = 128, HTB = HALF * BK * 2  , STAGE_BYTES = 8 * HTB, NXCD = 8, WGM = 8;

__host__ __device__ __forceinline__ int lds_byte(int r, int c) { const int st = (r >> 4) * 2 + (c >> 5), rr = r & 15, cc = c & 31, ob = rr * 64 + cc * 2; return st * 1024 + (ob ^ (((ob >> 9) & 1) << 5)); }
__host__ __device__ __forceinline__ void stage_rc(int b, int& R, int& C) { const int st = b / 1024, sb = b % 1024, swz = sb ^ (((sb >> 9) & 1) << 5); R = (st >> 1) * 16 + swz / 64; C = (st & 1) * 32 + (swz % 64) / 2; }
__host__ __device__ __forceinline__ int perm32(int rho) { const int n = rho >> 4, i = rho & 15; return 8 * (i >> 2) + 4 * n + (i & 3); }

struct Unit { int pm, pn; };
struct Gemm { const bf16_t* A; const bf16_t* Bt; int M, N, K; };

struct StaticOrder {
    int nM, nN, nwg, G, c;
    __host__ __device__ void init(int M, int N, int G_, int c_) { nM = M / BM; nN = N / BM; nwg = nM * nN; G = G_; c = c_; }
    __host__ __device__ bool next(int i, Unit& u) const {
        const long L = (long)i * G + c; if (L >= nwg) return false;
        int wgid = (int)L; { const int q = nwg / NXCD, r = nwg % NXCD, xcd = wgid % NXCD, off = wgid / NXCD; wgid = (xcd < r ? xcd * (q + 1) : r * (q + 1) + (xcd - r) * q) + off; }
        const int nig = WGM * nN, gid = wgid / nig, fm = gid * WGM, gsz = (nM - fm) < WGM ? (nM - fm) : WGM;
        u.pm = fm + ((wgid % nig) % gsz); u.pn = (wgid % nig) / gsz; return true;
    }
    __device__ __forceinline__ void a_ready(const Unit&) const {}
    __device__ __forceinline__ void done(const Unit&) const {}
};

__device__ __forceinline__ unsigned cvt_pk_bf16(float lo, float hi) { unsigned r; asm volatile("v_cvt_pk_bf16_f32 %0, %1, %2" : "=v"(r) : "v"(lo), "v"(hi)); return r; }
typedef float f32x2 __attribute__((ext_vector_type(2)));
template <class Epi, class Sched, bool ALIGN_EPI = false, bool SP2 = false>
__device__ __forceinline__ void gemm_phase(PG8_LAS unsigned char* lds, const Gemm g, const Sched& S, const Epi& E) {
    int tid_l = threadIdx.x; asm volatile("" : "+v"(tid_l));
    const int tid = tid_l, wid = __builtin_amdgcn_readfirstlane(tid >> 6), lane = tid & 63, wr = wid >> 2, wc = wid & 3, fr = lane & 15, fq = lane >> 4;
    const int K = g.K, nt = K / BK;
    unsigned voffA[2], voffB[2];
#pragma unroll
    for (int i = 0; i < 2; ++i) { int R, C; stage_rc(tid * 16 + i * 8192, R, C); const int Rb = Epi::PERM ? ((R & ~31) + perm32(R & 31)) : R;
        voffA[i] = (unsigned)(R * K + C) * 2u; voffB[i] = (unsigned)(Rb * K + C) * 2u; }
    const size_t kstep = (size_t)(BK * 2);
    const size_t hstep = (size_t)HALF * K * 2;
    const size_t tstep = 2 * hstep;
    const unsigned ldsw = (unsigned)wid * 1024u;
    const int aoff = lds_byte(wr * 64 + fr, fq * 8), boff = lds_byte(wc * 32 + fr, fq * 8);
#define PG8_SA(b, h) (((b) * 2 + (h)) * HTB)
#define PG8_SB(b, h) ((4 + (b) * 2 + (h)) * HTB)
#define PG8_STAGE(bufoff, gbase, voff) do { _Pragma("unroll") for (int _i = 0; _i < 2; ++_i) \
        __builtin_amdgcn_global_load_lds((const unsigned*)((const char*)(gbase) + (voff)[_i]), (PG8_LAS unsigned*)(lds + (bufoff) + ldsw + _i * 8192), 16, 0, 0); } while (0)
#define PG8_LDA(dst, b, h) do { _Pragma("unroll") for (int m = 0; m < 4; ++m) _Pragma("unroll") for (int k = 0; k < 2; ++k) dst[m][k] = *(const PG8_LAS bf16x8*)(lds + PG8_SA(b, h) + aoff + m * 2048 + k * 1024); } while (0)
#define PG8_LDB(dst, b, h) do { _Pragma("unroll") for (int n = 0; n < 2; ++n) _Pragma("unroll") for (int k = 0; k < 2; ++k) dst[n][k] = *(const PG8_LAS bf16x8*)(lds + PG8_SB(b, h) + boff + n * 2048 + k * 1024); } while (0)
#define PG8_MMA(ai, bj, At, Bt) do { __builtin_amdgcn_s_setprio(1); _Pragma("unroll") for (int m = 0; m < 4; ++m) _Pragma("unroll") for (int n = 0; n < 2; ++n) _Pragma("unroll") for (int k = 0; k < 2; ++k) \
        acc[ai][bj][m][n] = __builtin_amdgcn_mfma_f32_16x16x32_bf16(Bt[n][k], At[m][k], acc[ai][bj][m][n], 0, 0, 0); __builtin_amdgcn_s_setprio(0); } while (0)
#define PG8_WAIT_V(n) asm volatile("s_waitcnt vmcnt(" #n ")" ::: "memory")
#define PG8_WAIT_L(n) asm volatile("s_waitcnt lgkmcnt(" #n ")" ::: "memory")
#define PG8_BAR __builtin_amdgcn_s_barrier()
#define PG8_SCHED __builtin_amdgcn_sched_barrier(0)
    Unit cur, nxt; int ui = 0;
    if (!S.next(0, cur)) return;
    f32x4 acc[2][2][4][2];
#pragma unroll
    for (int a = 0; a < 2; ++a)
#pragma unroll
        for (int b = 0; b < 2; ++b)
#pragma unroll
            for (int m = 0; m < 4; ++m)
#pragma unroll
                for (int n = 0; n < 2; ++n) acc[a][b][m][n] = (f32x4){0.f, 0.f, 0.f, 0.f};
    bf16x8 At[4][2], B0[2][2], B1[2][2];
    const char* cA = (const char*)g.A + (size_t)cur.pm * tstep; const char* cB = (const char*)g.Bt + (size_t)cur.pn * tstep;
    S.a_ready(cur);
    if constexpr (SP2) {
        PG8_STAGE(PG8_SB(0, 0), cB, voffB); PG8_STAGE(PG8_SB(0, 1), cB + hstep, voffB); PG8_STAGE(PG8_SA(0, 0), cA, voffA); PG8_STAGE(PG8_SA(0, 1), cA + hstep, voffA);
        if (wr == 1) PG8_BAR;
        PG8_WAIT_V(2); PG8_BAR;
        PG8_STAGE(PG8_SB(1, 0), cB + kstep, voffB); PG8_STAGE(PG8_SA(1, 0), cA + kstep, voffA); PG8_STAGE(PG8_SB(1, 1), cB + hstep + kstep, voffB);
        PG8_WAIT_V(6); PG8_BAR;
    } else {
        PG8_STAGE(PG8_SB(0, 0), cB, voffB); PG8_STAGE(PG8_SA(0, 0), cA, voffA); PG8_STAGE(PG8_SB(0, 1), cB + hstep, voffB); PG8_STAGE(PG8_SA(0, 1), cA + hstep, voffA);
        if (wr == 1) PG8_BAR;
        PG8_WAIT_V(4); PG8_BAR;
        PG8_STAGE(PG8_SB(1, 0), cB + kstep, voffB); PG8_STAGE(PG8_SA(1, 0), cA + kstep, voffA); PG8_STAGE(PG8_SB(1, 1), cB + hstep + kstep, voffB);
        PG8_WAIT_V(6); PG8_BAR;
    }
    for (;;) {
        const bool has_next = S.next(ui + 1, nxt);
        const char* nA = has_next ? (const char*)g.A + (size_t)nxt.pm * tstep : cA; const char* nB = has_next ? (const char*)g.Bt + (size_t)nxt.pn * tstep : cB;
        for (int t = 0; t < nt; t += 2) {
            const bool last = (t == nt - 2);
            const char* a1 = cA + (size_t)(t + 1) * kstep;
            const char* a2 = last ? nA : cA + (size_t)(t + 2) * kstep; const char* b2 = last ? nB : cB + (size_t)(t + 2) * kstep;
            const char* a3 = a2 + kstep; const char* b3 = b2 + kstep;
            if (last && has_next) S.a_ready(nxt);
            if constexpr (SP2) {
            PG8_LDB(B0, 0, 0); PG8_LDB(B1, 0, 1); PG8_SCHED; PG8_LDA(At, 0, 0); PG8_STAGE(PG8_SA(1, 1), a1 + hstep, voffA);
            PG8_WAIT_V(8); PG8_WAIT_L(0); PG8_BAR; PG8_MMA(0, 0, At, B0); PG8_MMA(0, 1, At, B1); PG8_BAR; PG8_SCHED;
            PG8_LDA(At, 0, 1); PG8_STAGE(PG8_SB(0, 0), b2, voffB); PG8_STAGE(PG8_SB(0, 1), b2 + hstep, voffB); PG8_STAGE(PG8_SA(0, 0), a2, voffA);
            PG8_WAIT_V(8); PG8_WAIT_L(0); PG8_BAR; PG8_MMA(1, 0, At, B0); PG8_MMA(1, 1, At, B1); PG8_BAR; PG8_SCHED;
            PG8_LDB(B0, 1, 0); PG8_LDB(B1, 1, 1); PG8_SCHED; PG8_LDA(At, 1, 0); PG8_STAGE(PG8_SA(0, 1), a2 + hstep, voffA);
            PG8_WAIT_V(8); PG8_WAIT_L(0); PG8_BAR; PG8_MMA(0, 0, At, B0); PG8_MMA(0, 1, At, B1); PG8_BAR; PG8_SCHED;
            PG8_LDA(At, 1, 1); PG8_STAGE(PG8_SB(1, 0), b3, voffB); PG8_STAGE(PG8_SB(1, 1), b3 + hstep, voffB); PG8_STAGE(PG8_SA(1, 0), a3, voffA);
            PG8_WAIT_V(8); PG8_WAIT_L(0); PG8_BAR; PG8_MMA(1, 0, At, B0); PG8_MMA(1, 1, At, B1); PG8_BAR; PG8_SCHED;
            } else {
            PG8_LDB(B0, 0, 0); PG8_SCHED; PG8_LDA(At, 0, 0); PG8_STAGE(PG8_SA(1, 1), a1 + hstep, voffA);
            PG8_WAIT_L(8); PG8_BAR; PG8_WAIT_L(0); PG8_MMA(0, 0, At, B0); PG8_BAR; PG8_SCHED;
            PG8_LDB(B1, 0, 1); PG8_STAGE(PG8_SB(0, 0), b2, voffB);
            PG8_BAR; PG8_WAIT_L(0); PG8_MMA(0, 1, At, B1); PG8_BAR;
            PG8_LDA(At, 0, 1); PG8_STAGE(PG8_SA(0, 0), a2, voffA);
            PG8_BAR; PG8_WAIT_L(0); PG8_MMA(1, 0, At, B0); PG8_BAR; PG8_SCHED;
            PG8_STAGE(PG8_SB(0, 1), b2 + hstep, voffB);
            PG8_WAIT_V(6); PG8_BAR; PG8_MMA(1, 1, At, B1); PG8_BAR;
            PG8_LDB(B0, 1, 0); PG8_SCHED; PG8_LDA(At, 1, 0); PG8_STAGE(PG8_SA(0, 1), a2 + hstep, voffA);
            PG8_WAIT_L(8); PG8_BAR; PG8_WAIT_L(0); PG8_MMA(0, 0, At, B0); PG8_BAR; PG8_SCHED;
            PG8_LDB(B1, 1, 1); PG8_STAGE(PG8_SB(1, 0), b3, voffB);
            PG8_BAR; PG8_WAIT_L(0); PG8_MMA(0, 1, At, B1); PG8_BAR;
            PG8_LDA(At, 1, 1); PG8_STAGE(PG8_SA(1, 0), a3, voffA);
            PG8_BAR; PG8_WAIT_L(0); PG8_MMA(1, 0, At, B0); PG8_BAR; PG8_SCHED;
            PG8_STAGE(PG8_SB(1, 1), b3 + hstep, voffB);
            PG8_WAIT_V(6); PG8_BAR; PG8_MMA(1, 1, At, B1); PG8_BAR;
            }
        }
        if constexpr (ALIGN_EPI) { if (wr == 0) PG8_BAR; }
        if constexpr (!Epi::AFTER_DRAIN) { E(acc, cur, wr, wc, fr, fq); S.done(cur); }
        if (!has_next) break;
#pragma unroll
        for (int a = 0; a < 2; ++a)
#pragma unroll
            for (int b = 0; b < 2; ++b)
#pragma unroll
                for (int m = 0; m < 4; ++m)
#pragma unroll
                    for (int n = 0; n < 2; ++n) acc[a][b][m][n] = (f32x4){0.f, 0.f, 0.f, 0.f};
        cur = nxt; cA = nA; cB = nB; ++ui;
        if constexpr (ALIGN_EPI) { if (wr == 1) PG8_BAR; }
    }
    PG8_WAIT_V(0);
    if constexpr (!ALIGN_EPI) { if (wr == 0) PG8_BAR; }
    PG8_BAR;
    if constexpr (Epi::AFTER_DRAIN) { E.fused(acc, cur, wr, wc, fr, fq, lds, wid, lane); S.done(cur); }
#undef PG8_SA
#undef PG8_SB
#undef PG8_STAGE
#undef PG8_LDA
#undef PG8_LDB
#undef PG8_MMA
#undef PG8_WAIT_V
#undef PG8_WAIT_L
#undef PG8_BAR
#undef PG8_SCHED
}
}

#define GAS __attribute__((address_space(1)))
#define LAS __attribute__((address_space(3)))
#define DI __device__ __forceinline__
typedef unsigned short bf16;
typedef unsigned v4u __attribute__((ext_vector_type(4)));
typedef unsigned v2u __attribute__((ext_vector_type(2)));
typedef float f32x4 __attribute__((ext_vector_type(4)));
typedef short bf16x8 __attribute__((ext_vector_type(8)));
typedef short s16x4 __attribute__((ext_vector_type(4)));
typedef GAS unsigned gu32;
typedef GAS unsigned long long gu64;
#define RLX_AGENT __ATOMIC_RELAXED, __HIP_MEMORY_SCOPE_AGENT
#define LDS_WAIT() asm volatile("s_waitcnt lgkmcnt(0)" ::: "memory")
#define VM_WAIT() asm volatile("s_waitcnt vmcnt(0)" ::: "memory")
DI unsigned f2bf(float f) { unsigned u = __builtin_bit_cast(unsigned, f); return (u + 0x7fffu + ((u >> 16) & 1u)) >> 16; }
__device__ __forceinline__ unsigned pk2(float lo, float hi) { return f2bf(lo) | (f2bf(hi) << 16); }

#define XB_TMO      128
#define XB_XCNT(j)  (256  + 64 * (j))
#define XB_XSUB(j)  (1280 + 64 * (j))
#define XB_XGEN(j)  (2304 + 64 * (j))
#define XB_TOP      3328
#define XB_TOPGEN   3392
#define XCD_BAR_WORDS 3456
#define XB_SPIN_CAP (1u << 18)

__device__ __forceinline__ unsigned xb_ld(unsigned* p)              { return __hip_atomic_load(p, __ATOMIC_RELAXED, __HIP_MEMORY_SCOPE_AGENT); }
__device__ __forceinline__ unsigned xb_add(unsigned* p, unsigned v) { return __hip_atomic_fetch_add(p, v, __ATOMIC_RELAXED, __HIP_MEMORY_SCOPE_AGENT); }
__device__ __forceinline__ unsigned xb_xcc_id() { return (unsigned)__builtin_amdgcn_s_getreg((3 << 11) | 20) & 0xFu; }
#define XB_SPIN(cond, bar) do { unsigned _sp = 0; while (cond) { __builtin_amdgcn_s_sleep(1); \
    if ((++_sp & 255u) == 0u) { if (xb_ld(&(bar)[XB_TMO])) break; if (_sp > XB_SPIN_CAP) { atomicAdd(&(bar)[XB_TMO], 1u); break; } } } } while (0)

struct XcdBarrier {
    unsigned* bar; unsigned x;
    volatile LAS unsigned* st;
};

__device__ __forceinline__ XcdBarrier xcd_barrier_post(unsigned* bar, volatile LAS unsigned* st) {
    XcdBarrier b; b.bar = bar; b.x = xb_xcc_id(); b.st = st;
    if (threadIdx.x == 0) (void)xb_add(&bar[XB_XCNT(b.x)], 1u);
    return b;
}
__device__ __forceinline__ void xcd_barrier_complete(unsigned* bar, unsigned x, unsigned& nloc, unsigned& nx) {
    const unsigned G = gridDim.x * gridDim.y * gridDim.z;
    unsigned sum, cnt, mine, sp = 0u;
    for (;;) {
        sum = 0u; cnt = 0u; mine = 0u;
#pragma unroll 1
        for (unsigned j = 0; j < 16; ++j) { const unsigned c = xb_ld(&bar[XB_XCNT(j)]); sum += c; cnt += (c > 0u) ? 1u : 0u; mine = (j == x) ? c : mine; }
        if (sum == G) break;
        __builtin_amdgcn_s_sleep(1);
        if ((++sp & 255u) == 0u) { if (xb_ld(&bar[XB_TMO])) break; if (sp > XB_SPIN_CAP) { atomicAdd(&bar[XB_TMO], 1u); break; } }
    }
    nloc = mine > 0u ? mine : 1u; nx = cnt > 0u ? cnt : 1u;
}

__device__ __forceinline__ void xcd_barrier(const XcdBarrier& b) {
    asm volatile("s_waitcnt vmcnt(0)" ::: "memory");
    __syncthreads();
    if (threadIdx.x == 0) {
        unsigned* bar = b.bar;
        __builtin_amdgcn_s_waitcnt(0);
        unsigned nloc = b.st[0], nx = b.st[1];
        if (nloc == 0u) { xcd_barrier_complete(bar, b.x, nloc, nx); b.st[0] = nloc; b.st[1] = nx; }
        const unsigned old = xb_add(&bar[XB_XSUB(b.x)], 1u);
        const unsigned gen = old / nloc;
        if (old + 1u == (gen + 1u) * nloc) {
            __builtin_amdgcn_fence(__ATOMIC_RELEASE, "agent");
            asm volatile("s_waitcnt vmcnt(0)" ::: "memory");
            const unsigned og = xb_add(&bar[XB_TOP], 1u);
            const unsigned tg = og / nx;
            if (og + 1u == (tg + 1u) * nx) xb_add(&bar[XB_TOPGEN], 1u);
            else XB_SPIN(xb_ld(&bar[XB_TOPGEN]) == tg, bar);
            __builtin_amdgcn_fence(__ATOMIC_ACQUIRE, "agent");
            xb_add(&bar[XB_XGEN(b.x)], 1u);
            asm volatile("s_waitcnt vmcnt(0)" ::: "memory");
        } else {
            XB_SPIN(xb_ld(&bar[XB_XGEN(b.x)]) == gen, bar);
            __builtin_amdgcn_fence(__ATOMIC_ACQUIRE, "agent");
            asm volatile("s_waitcnt vmcnt(0)" ::: "memory");
        }
    }
    __syncthreads();
}

constexpr int BATCH = 2, SEQ = 4096, DM = 4096, DEPTH = 4, MTOK = BATCH * SEQ;
constexpr int DIN = 13328;
constexpr int NPJ = 13568;
constexpr int C_RQ = 0, C_RK = 1024, C_RV = 2048, C_RG = 3072, C_MQ = 4096, C_MK = 5120, C_MV = 6144, C_MG = 7168, C_SZ = 8192, C_SX = 9216, C_LX = 11264, C_LG = 12288, C_DT = 13312;
constexpr float EPS = 1e-6f;
constexpr int NWAVES = 8, NTHR = 512;
constexpr int NPHASE = 2 + 5 * DEPTH;

constexpr size_t MiB = 1u << 20;
constexpr size_t WS_CTL = 0, CTL_ZERO_BYTES = 1 * MiB;
constexpr size_t WS_SSQ = 2 * MiB, WS_LRUW = 4 * MiB, WS_KMEAN = 6 * MiB, WS_DT = 7 * MiB, WS_DTRAW = 8 * MiB, WS_DACS = 9 * MiB, WS_HEND = 10 * MiB, WS_AEND = 11 * MiB, WS_CARRY = 12 * MiB;
constexpr size_t WS_WIN = 16 * MiB, WIN_LAYER = (size_t)NPJ * DM * 2;
constexpr size_t WS_WOUT = 440 * MiB, WOUT_LAYER = (size_t)DM * DM * 2;
constexpr size_t WS_X = 568 * MiB, WS_XB = 696 * MiB, WS_P = 760 * MiB, WS_Y = 972 * MiB, WS_RU = 1036 * MiB, WS_RS = 1068 * MiB, WS_XBC = 1084 * MiB, WS_SST = 1116 * MiB, WS_SHP = 1132 * MiB,
                 WS_HLOC = 1140 * MiB, WS_ACUM = 1172 * MiB, WS_END = 1204 * MiB;
static_assert(WS_WIN + 4 * WIN_LAYER <= WS_WOUT && WS_P + (size_t)MTOK * NPJ * 2 <= WS_Y, "ws map");
constexpr int CW_BAR = 4096;
constexpr int CW_WQ = 16384;

constexpr int RING_BYTES = 131072, LDSCTL_OFF = RING_BYTES, MISC_OFF = LDSCTL_OFF + 320, LDS_BYTES = 147456;
constexpr int SB256 = 528, SB128 = 272;

struct Args { const float* in[19]; float* out; unsigned char* ws; int ph_lo, ph_hi; };
struct Frame {
    LAS unsigned char* lds; const Args* a; int z, tid_;
    DI int tid() const { return tid_; }
    DI int lane() const { return tid_ & 63; }
    DI int wave() const { return __builtin_amdgcn_readfirstlane(tid_ >> 6); }
    DI int G() const { return (int)gridDim.x; }
    DI volatile LAS unsigned* MISC() const { return (volatile LAS unsigned*)(lds + MISC_OFF); }
    DI unsigned char* ws() const { return a->ws + z; }
    DI unsigned* ctl() const { return (unsigned*)(a->ws + z + WS_CTL); }
    DI const float* in(int k) const { return a->in[k] + z; }
    DI float* out() const { return a->out + z; }
#define FV(T, name, off) DI T* name() const { return (T*)(a->ws + z + (off)); }
    FV(bf16, WIN, WS_WIN) FV(bf16, WOUT, WS_WOUT) FV(bf16, XB, WS_XB) FV(bf16, P, WS_P) FV(bf16, Y, WS_Y) FV(bf16, RS, WS_RS) FV(bf16, XBC, WS_XBC) FV(bf16, SHP, WS_SHP) FV(bf16, LRUW, WS_LRUW)
    FV(float, X, WS_X) FV(float, SSQ, WS_SSQ) FV(bf16, KMH, WS_KMEAN) FV(bf16, KML, WS_KMEAN + 65536) FV(float, KMX, WS_KMEAN + 131072) FV(float, DT, WS_DT) FV(float, DTRAW, WS_DTRAW) FV(float, DACS, WS_DACS) FV(float, HEND, WS_HEND) FV(float, AEND, WS_AEND)
    FV(float, CARRY, WS_CARRY) FV(bf16, RU, WS_RU) FV(float, SST, WS_SST) FV(bf16, HLOC, WS_HLOC) FV(bf16, ACUM, WS_ACUM)
#undef FV
};

DI Frame mk_frame(LAS unsigned char* lds, const Args* a) { Frame F; F.lds = lds; F.a = a; int z = 0; asm volatile("" : "+s"(z)); int t = (int)threadIdx.x; asm volatile("" : "+v"(t)); F.z = z; F.tid_ = t; return F; }
DI float bf_lo(unsigned u) { return __uint_as_float(u << 16); }
DI float bf_hi(unsigned u) { return __uint_as_float(u & 0xffff0000u); }
typedef float f32x2_t __attribute__((ext_vector_type(2))); typedef __bf16 bf16x2_t __attribute__((ext_vector_type(2)));
DI unsigned pkbf(float lo, float hi) { f32x2_t v = {lo, hi}; bf16x2_t b = __builtin_convertvector(v, bf16x2_t); return __builtin_bit_cast(unsigned, b); }
DI float wave_sum(float v) {
#pragma unroll
    for (int o = 1; o < 64; o <<= 1) v += __shfl_xor(v, o);
    return v;
}
DI float sigm(float x) { return __builtin_amdgcn_rcpf(1.f + __expf(-x)); }
DI float silu(float x) { return x * __builtin_amdgcn_rcpf(1.f + __expf(-x)); }
DI float one_minus_exp(float x) { const float p = -x * (1.0f + x * (0.5f + x * (0.16666667f + x * (0.041666668f + x * 0.008333334f)))); return x > -0.25f ? p : 1.0f - __expf(x); }
DI float softplus(float x) { return x > 20.f ? x : log1pf(__expf(x)); }
DI f32x4 mfma16(bf16x8 a, bf16x8 b, f32x4 c) { return __builtin_amdgcn_mfma_f32_16x16x32_bf16(a, b, c, 0, 0, 0); }
DI void unpack8(const v4u v, float (&f)[8]) { f[0] = bf_lo(v.x); f[1] = bf_hi(v.x); f[2] = bf_lo(v.y); f[3] = bf_hi(v.y); f[4] = bf_lo(v.z); f[5] = bf_hi(v.z); f[6] = bf_lo(v.w); f[7] = bf_hi(v.w); }
DI v4u pack8(const float (&f)[8]) { v4u v; v.x = pkbf(f[0], f[1]); v.y = pkbf(f[2], f[3]); v.z = pkbf(f[4], f[5]); v.w = pkbf(f[6], f[7]); return v; }
DI bf16x8 pack8f(const float (&f)[8]) { return __builtin_bit_cast(bf16x8, pack8(f)); }
DI bf16x8 frag_row(const LAS unsigned char* t, int sb, int r0, int k0, int lane) { return *(const LAS bf16x8*)(t + (r0 + (lane & 15)) * sb + (k0 + 8 * (lane >> 4)) * 2); }
typedef short v4i16_t __attribute__((ext_vector_type(4)));
DI bf16x8 frag_tr(const LAS unsigned char* t, int sb, int ra, int rb, int c0, int lane) {
    const int q = (lane & 15) >> 2, p = lane & 3;
    const s16x4 lo = __builtin_bit_cast(s16x4, __builtin_amdgcn_ds_read_tr16_b64_v4i16((LAS v4i16_t*)(t + (ra + q) * sb + (c0 + 4 * p) * 2)));
    const s16x4 hi = __builtin_bit_cast(s16x4, __builtin_amdgcn_ds_read_tr16_b64_v4i16((LAS v4i16_t*)(t + (rb + q) * sb + (c0 + 4 * p) * 2)));
    bf16x8 r; r[0] = lo[0]; r[1] = lo[1]; r[2] = lo[2]; r[3] = lo[3]; r[4] = hi[0]; r[5] = hi[1]; r[6] = hi[2]; r[7] = hi[3]; return r;
}
template <int COLS> DI void stage_bf16(LAS unsigned char* dst, int sb, const bf16* src, size_t gp, int rows, int tid) {
    constexpr int CPR = COLS / 8; const int total = rows * CPR;
    for (int c = tid; c < total; c += NTHR) { const int r = c / CPR, ch = c % CPR; const v4u v = *(const v4u*)(src + (size_t)r * gp + ch * 8); *(LAS v4u*)(dst + r * sb + ch * 16) = v; }
}
DI unsigned wq_issue(Frame& F, int ctr) { unsigned v = 0u; if (F.tid() == 0) v = __hip_atomic_fetch_add(F.ctl() + CW_WQ + 64 * ctr, 1u, RLX_AGENT); return v; }
DI int wq_publish(Frame& F, unsigned v) { __syncthreads(); if (F.tid() == 0) F.MISC()[0] = v; __syncthreads(); return __builtin_amdgcn_readfirstlane((int)F.MISC()[0]); }
DI int next_unit(Frame& F, int ctr) {
    __syncthreads();
    if (F.tid() == 0) F.MISC()[0] = __hip_atomic_fetch_add(F.ctl() + CW_WQ + 64 * ctr, 1u, RLX_AGENT);
    __syncthreads();
    return __builtin_amdgcn_readfirstlane((int)F.MISC()[0]);
}

namespace pg8 {
struct EpiProj {
    static constexpr bool PERM = true, AFTER_DRAIN = false;
    bf16_t* O; float* dtraw; const float* ssq;
    const PG8_LAS float* rtab; int fm;
    __device__ __forceinline__ void operator()(const f32x4 (&acc)[2][2][4][2], const Unit& u, int wr, int wc, int fr, int fq) const {
        asm volatile("" : "+v"(fr), "+v"(fq));
        const int row0 = u.pm * BM + wr * 64 + fr;
        const bool dt_tile = u.pn >= 52;
        const int col0 = u.pn * BM + wc * 32 + 8 * fq;
        const bool tab = rtab != nullptr && (unsigned)(u.pm - fm) < 8u;
        float rs[2][4];
        if (tab) { const PG8_LAS float* t = rtab + (u.pm - fm) * BM + wr * 64 + fr;
#pragma unroll
            for (int ai = 0; ai < 2; ++ai)
#pragma unroll
                for (int m = 0; m < 4; ++m) rs[ai][m] = t[ai * HALF + m * 16];
        } else { f32x4 pv[2][4];
#pragma unroll
            for (int ai = 0; ai < 2; ++ai)
#pragma unroll
                for (int m = 0; m < 4; ++m) pv[ai][m] = *(const f32x4*)(ssq + (size_t)(row0 + ai * HALF + m * 16) * 16 + 4 * fq);
#pragma unroll
            for (int ai = 0; ai < 2; ++ai)
#pragma unroll
                for (int m = 0; m < 4; ++m) { float s = (pv[ai][m][0] + pv[ai][m][1]) + (pv[ai][m][2] + pv[ai][m][3]); s += __shfl_xor(s, 16); s += __shfl_xor(s, 32); rs[ai][m] = rsqrtf(s * (1.0f / 4096.0f) + 1e-6f); } }
#pragma unroll
        for (int ai = 0; ai < 2; ++ai)
#pragma unroll
            for (int m = 0; m < 4; ++m) { const int r = row0 + ai * HALF + m * 16; const float s = rs[ai][m];
                if (!dt_tile) { bf16_t* rowp = O + (size_t)r * 13568 + col0;
#pragma unroll
                    for (int bj = 0; bj < 2; ++bj) { const f32x4 v0 = acc[ai][bj][m][0] * s, v1 = acc[ai][bj][m][1] * s;
                        u32x4 w; w.x = cvt_pk_bf16(v0[0], v0[1]); w.y = cvt_pk_bf16(v0[2], v0[3]); w.z = cvt_pk_bf16(v1[0], v1[1]); w.w = cvt_pk_bf16(v1[2], v1[3]);
                        *(u32x4*)(rowp + bj * HALF) = w; }
                } else if (wc == 0 && fq < 2) { float* rowp = dtraw + (size_t)r * 16 + 8 * fq; *(f32x4*)(rowp) = acc[ai][0][m][0] * s; *(f32x4*)(rowp + 4) = acc[ai][0][m][1] * s; } }
    }
};
struct EpiOut {
    static constexpr bool PERM = false, AFTER_DRAIN = false;
    bf16_t* xb; float* ssq; PG8_LAS float* red;
    __device__ __forceinline__ void operator()(const f32x4 (&acc)[2][2][4][2], const Unit& u, int wr, int wc, int fr, int fq) const {
        asm volatile("" : "+v"(fr), "+v"(fq));
        const int row0 = u.pm * BM + wr * 64 + fr, col0 = u.pn * BM + wc * 32 + 4 * fq;
#pragma unroll
        for (int ai = 0; ai < 2; ++ai) {
            unsigned long long xo[4][2][2];
#pragma unroll
            for (int m = 0; m < 4; ++m)
#pragma unroll
                for (int bj = 0; bj < 2; ++bj)
#pragma unroll
                    for (int n = 0; n < 2; ++n) xo[m][bj][n] = *(const unsigned long long*)(xb + (size_t)(row0 + ai * HALF + m * 16) * 4096 + col0 + bj * HALF + n * 16);
#pragma unroll
            for (int m = 0; m < 4; ++m) { const int r = row0 + ai * HALF + m * 16; const size_t off = (size_t)r * 4096 + col0; float ss = 0.f;
#pragma unroll
                for (int bj = 0; bj < 2; ++bj)
#pragma unroll
                    for (int n = 0; n < 2; ++n) { const unsigned lo = (unsigned)xo[m][bj][n], hi = (unsigned)(xo[m][bj][n] >> 32);
                        f32x4 o = acc[ai][bj][m][n]; o[0] += __uint_as_float(lo << 16); o[1] += __uint_as_float(lo & 0xffff0000u); o[2] += __uint_as_float(hi << 16); o[3] += __uint_as_float(hi & 0xffff0000u);
                        ss += (o[0] * o[0] + o[1] * o[1]) + (o[2] * o[2] + o[3] * o[3]);
                        const unsigned w0 = cvt_pk_bf16(o[0], o[1]), w1 = cvt_pk_bf16(o[2], o[3]);
                        *(unsigned long long*)(xb + off + bj * HALF + n * 16) = (unsigned long long)w0 | ((unsigned long long)w1 << 32); }
                ss += __shfl_xor(ss, 16); ss += __shfl_xor(ss, 32);
                if (fq == 0) red[(ai * HALF + wr * 64 + m * 16 + fr) * 4 + wc] = ss; }
            asm volatile("" ::: "memory"); }
        asm volatile("s_waitcnt lgkmcnt(0)" ::: "memory"); __builtin_amdgcn_s_barrier(); asm volatile("" ::: "memory");
        { const int t = (wr * 4 + wc) * 64 + fq * 16 + fr;
          if (t < 256) { const f32x4 p4 = *(const PG8_LAS f32x4*)(red + t * 4); ssq[(size_t)(u.pm * BM + t) * 16 + u.pn] = (p4[0] + p4[1]) + (p4[2] + p4[3]); } }
    }
};
struct RemapOrder : StaticOrder {
    __device__ __forceinline__ bool next(int i, Unit& u) const { if (!StaticOrder::next(i, u)) return false; if (u.pn == 35) u.pn = 52; return true; }
};
struct OneUnit {
    int pm, pn;
    __device__ __forceinline__ bool next(int i, Unit& u) const { if (i != 0) return false; u.pm = pm; u.pn = pn; return true; }
    __device__ __forceinline__ void a_ready(const Unit&) const {}
    __device__ __forceinline__ void done(const Unit&) const {}
};
}

DI int map_in_col(int n) { return n < 11264 ? n : (n < 11280 ? C_DT + (n - 11264) : n - 16); }
constexpr int TR_SB = 272;
struct TrItem { const float* W; const float* ks; bf16* WT; int N, k0, n0, is_in; };
constexpr int TR_NB_IN = (DIN + 127) / 128, TR_I_IN = 32 * TR_NB_IN, TR_I_OUT = 32 * 32, TR_I_L = TR_I_IN + TR_I_OUT;
DI bool tr_item(Frame& F, int l, int r, TrItem& t) {
    constexpr int NB_IN = TR_NB_IN, I_IN = TR_I_IN;
    if (r >= TR_I_L) return false;
    if (r < I_IN) { t.W = F.in(2) + (size_t)l * DM * DIN; t.ks = F.in(1) + l * DM; t.WT = F.WIN() + (size_t)l * NPJ * DM; t.N = DIN; t.k0 = 128 * (r / NB_IN); t.n0 = 128 * (r % NB_IN); t.is_in = 1; }
    else { const int q = r - I_IN; t.W = F.in(17) + (size_t)l * DM * DM; t.ks = nullptr; t.WT = F.WOUT() + (size_t)l * DM * DM; t.N = DM; t.k0 = 128 * (q / 32); t.n0 = 128 * (q % 32); t.is_in = 0; }
    return true;
}
DI void tr_load(const TrItem& t, int tid, f32x4 (&v)[8]) {
    const int c4 = tid & 31, n = t.n0 + 4 * c4; const bool ok = n < t.N;
#pragma unroll
    for (int p = 0; p < 8; ++p) { const int k = t.k0 + p * 16 + (tid >> 5); f32x4 x = ok ? *(const f32x4*)(t.W + (size_t)k * t.N + n) : (f32x4){0.f, 0.f, 0.f, 0.f}; if (t.ks) x *= t.ks[k]; v[p] = x; }
}
DI void tr_step(Frame& F, const TrItem& cur, f32x4 (&v)[8], int l, int r_next, TrItem& nxt, bool& hn, LAS unsigned char* tile, int tid, int lane, int w) {
    const int gq = lane >> 4, l15 = lane & 15, c4 = tid & 31;
    __syncthreads();
#pragma unroll
    for (int p = 0; p < 8; ++p) { const int kr = p * 16 + (tid >> 5); v2u o; o.x = pkbf(v[p][0], v[p][1]); o.y = pkbf(v[p][2], v[p][3]); *(LAS v2u*)(tile + kr * TR_SB + c4 * 8) = o; }
    __syncthreads();
    hn = tr_item(F, l, r_next, nxt);
    if (hn) tr_load(nxt, tid, v);
    const int n = cur.n0 + 16 * w + l15; const bool okn = n < cur.N; const int row = cur.is_in ? map_in_col(okn ? n : 0) : n; bf16* dst = cur.WT + (size_t)row * DM + cur.k0 + 8 * gq;
#pragma unroll
    for (int ks = 0; ks < 4; ++ks) { const bf16x8 f = frag_tr(tile, TR_SB, 32 * ks + 8 * gq, 32 * ks + 8 * gq + 4, 16 * w, lane); if (okn) *(bf16x8*)(dst + 32 * ks) = f; }
}
DI void tr_unit(Frame& F, int l, int r0, int cnt) {
    const int tid = F.tid(), lane = F.lane(), w = F.wave();
    TrItem ia, ib, dummy; f32x4 va[8], vb[8]; bool hn;
    tr_item(F, l, r0, ia); tr_item(F, l, r0 + 1, ib);
    tr_load(ia, tid, va); tr_load(ib, tid, vb);
    tr_step(F, ia, va, l, TR_I_L, dummy, hn, F.lds, tid, lane, w);
    tr_step(F, ib, vb, l, TR_I_L, dummy, hn, F.lds, tid, lane, w);
    __syncthreads();
}
DI void p0_prologue(Frame& F) {
    const int tid = F.tid(), lane = F.lane(), w = F.wave();
    LAS unsigned char* tile = F.lds;
    TrItem ia, ib; f32x4 va[8], vb[8];
    int it = blockIdx.x; const int G = F.G();
#define P0_IDX(i) ((i) < TR_I_IN ? (i) : TR_I_L)
    bool ha = tr_item(F, 0, P0_IDX(it), ia), hb = tr_item(F, 0, P0_IDX(it + G), ib);
    if (ha) tr_load(ia, tid, va);
    if (hb) tr_load(ib, tid, vb);
    while (ha) {
        TrItem na; bool hna;
        tr_step(F, ia, va, 0, P0_IDX(it + 2 * G), na, hna, tile, tid, lane, w);
        if (!hb) break;
        TrItem nb; bool hnb;
        tr_step(F, ib, vb, 0, P0_IDX(it + 3 * G), nb, hnb, tile, tid, lane, w);
        ia = na; ha = hna; ib = nb; hb = hnb; it += 2 * G;
    }
    const int gw = blockIdx.x * NWAVES + w, NGW = F.G() * NWAVES;
    for (int i = blockIdx.x * NTHR + tid; i < DEPTH * 240 * (DM / 8); i += F.G() * NTHR) { const int l = i / (240 * (DM / 8)), r = i % (240 * (DM / 8));
        *(v4u*)(F.WIN() + (size_t)l * NPJ * DM + (size_t)(C_DT + 16) * DM + (size_t)r * 8) = (v4u){0u, 0u, 0u, 0u}; }
    for (int i = blockIdx.x * NTHR + tid; i < DEPTH * 2 * 8 * 128 * 128; i += F.G() * NTHR) { const int d = i & 127, e = (i >> 7) & 127, nb = (i >> 14) & 7, gate = (i >> 17) & 1, l = i >> 18;
        const float* wp = (gate ? F.in(14) : F.in(12)) + ((size_t)(l * 8 + nb) * 128 + d) * 128 + e; F.LRUW()[i] = (bf16)f2bf(*wp); }
    for (int m = gw; m < MTOK; m += NGW) { const f32x4* xr = (const f32x4*)(F.in(0) + (size_t)m * DM) + lane; float ss = 0.f;
#pragma unroll
        for (int j = 0; j < 16; ++j) { const f32x4 x = xr[64 * j]; ss += (x[0] * x[0] + x[1] * x[1]) + (x[2] * x[2] + x[3] * x[3]);
            const unsigned long long o = (unsigned long long)pkbf(x[0], x[1]) | ((unsigned long long)pkbf(x[2], x[3]) << 32); *((unsigned long long*)(F.XB() + (size_t)m * DM) + 64 * j + lane) = o; }
        ss = wave_sum(ss); if (lane < 16) F.SSQ()[(size_t)m * 16 + lane] = lane == 0 ? ss : 0.f; }
}
DI void p_final(Frame& F) {
    const int gw = blockIdx.x * NWAVES + F.wave(), NGW = F.G() * NWAVES, lane = F.lane(); const float* fw = F.in(18);
    for (int m = gw; m < MTOK; m += NGW) { float ss = F.SSQ()[(size_t)m * 16 + (lane & 15)]; ss += __shfl_xor(ss, 1); ss += __shfl_xor(ss, 2); ss += __shfl_xor(ss, 4); ss += __shfl_xor(ss, 8); const float rs = rsqrtf(ss * (1.0f / 4096.0f) + EPS);
        const v4u* xr = (const v4u*)(F.XB() + (size_t)m * DM) + lane; f32x4* o = (f32x4*)(F.out() + (size_t)m * DM) + 2 * lane; const f32x4* wv = (const f32x4*)fw + 2 * lane;
#pragma unroll
        for (int j = 0; j < 8; ++j) { float x[8]; unpack8(xr[64 * j], x); const f32x4 w0 = wv[128 * j], w1 = wv[128 * j + 1];
            o[128 * j] = (f32x4){x[0] * rs * w0[0], x[1] * rs * w0[1], x[2] * rs * w0[2], x[3] * rs * w0[3]}; o[128 * j + 1] = (f32x4){x[4] * rs * w1[0], x[5] * rs * w1[1], x[6] * rs * w1[2], x[7] * rs * w1[3]}; } }
}

DI int swz(int row) { return ((row & 3) << 2) | ((row >> 2) & 3); }
DI const char* sbase(const void* p) { const char* q = (const char*)p; asm volatile("" : "+s"(q)); return q; }
DI void dma_tile256(const bf16* src, unsigned gp, LAS unsigned char* dst, int w, int lane) {
    const char* sb = sbase(src);
#pragma unroll
    for (int i = 0; i < 4; ++i) { const int idx = w * 4 + i, row = 2 * idx + (lane >> 5), c = (lane & 31) ^ swz(row);
        __builtin_amdgcn_global_load_lds((const unsigned*)(sb + ((unsigned)row * gp + (unsigned)c * 8u) * 2u), (LAS unsigned*)(dst + idx * 1024), 16, 0, 0); }
}
DI bf16x8 frag_tr_sw512(const LAS unsigned char* t, int ra, int rb, int c0, int lane) {
    const int q = (lane & 15) >> 2, p = lane & 3, ch = (c0 >> 3) + (p >> 1), r0 = ra + q, r1 = rb + q;
    const s16x4 lo = __builtin_bit_cast(s16x4, __builtin_amdgcn_ds_read_tr16_b64_v4i16((LAS v4i16_t*)(t + 512 * r0 + 16 * (ch ^ swz(r0)) + 8 * (p & 1))));
    const s16x4 hi = __builtin_bit_cast(s16x4, __builtin_amdgcn_ds_read_tr16_b64_v4i16((LAS v4i16_t*)(t + 512 * r1 + 16 * (ch ^ swz(r1)) + 8 * (p & 1))));
    bf16x8 r; r[0] = lo[0]; r[1] = lo[1]; r[2] = lo[2]; r[3] = lo[3]; r[4] = hi[0]; r[5] = hi[1]; r[6] = hi[2]; r[7] = hi[3]; return r;
}
DI bf16x8 frag_row_sw512(const LAS unsigned char* t, int row, int ch) { return *(const LAS bf16x8*)(t + 512 * row + 16 * (ch ^ swz(row))); }
DI void ret_A(Frame& F, int unit) {
    const int c = unit & 15, bh = unit >> 4, h = bh & 3, b = bh >> 2, lane = F.lane(), w = F.wave(), gq = lane >> 4, l15 = lane & 15;
    const size_t t0 = (size_t)b * SEQ + c * 256;
    const bf16* Kp = F.P() + t0 * NPJ + C_RK + h * 256; const bf16* Vp = F.P() + t0 * NPJ + C_RV + h * 256;
    const float lg = log1pf(-exp2f(-5.f - (float)h));
    LAS unsigned char* B0 = F.lds; LAS unsigned char* B1 = F.lds + 65536;
    f32x4 acc[2][16];
#pragma unroll
    for (int a = 0; a < 2; ++a)
#pragma unroll
        for (int v = 0; v < 16; ++v) acc[a][v] = (f32x4){0.f, 0.f, 0.f, 0.f};
    float kd8[8];
#pragma unroll
    for (int e = 0; e < 8; ++e) kd8[e] = __expf(-lg * (float)(8 * gq + e));
    __syncthreads();
    dma_tile256(Kp, NPJ, B0, w, lane); dma_tile256(Vp, NPJ, B0 + 32768, w, lane);
    VM_WAIT(); __syncthreads();
    for (int jt = 0; jt < 4; ++jt) {
        LAS unsigned char* cur = (jt & 1) ? B1 : B0; LAS unsigned char* nxt = (jt & 1) ? B0 : B1;
        if (jt < 3) { dma_tile256(Kp + (size_t)(64 * (jt + 1)) * NPJ, NPJ, nxt, w, lane); dma_tile256(Vp + (size_t)(64 * (jt + 1)) * NPJ, NPJ, nxt + 32768, w, lane); }
        { int lz = lane; asm volatile("" : "+v"(lz)); const int lane = lz, gq = lz >> 4;
#pragma unroll
          for (int ks = 0; ks < 2; ++ks) { const int ra = 32 * ks + 8 * gq, rb = ra + 4;
              const float base = __expf(lg * (float)(255 - (64 * jt + 32 * ks))) * 0.0625f;
              bf16x8 A[2];
#pragma unroll
              for (int dt = 0; dt < 2; ++dt) { float f[8]; unpack8(__builtin_bit_cast(v4u, frag_tr_sw512(cur, ra, rb, 32 * w + 16 * dt, lane)), f);
#pragma unroll
                  for (int e = 0; e < 8; ++e) f[e] *= base * kd8[e];
                  A[dt] = pack8f(f); }
#pragma unroll
              for (int vt = 0; vt < 16; ++vt) { const bf16x8 B = frag_tr_sw512(cur + 32768, ra, rb, 16 * vt, lane); acc[0][vt] = mfma16(A[0], B, acc[0][vt]); acc[1][vt] = mfma16(A[1], B, acc[1][vt]); } } }
        VM_WAIT(); __syncthreads();
    }
    bf16* U = F.RU() + (size_t)unit * 65536;
#pragma unroll
    for (int dt = 0; dt < 2; ++dt)
#pragma unroll
        for (int vt = 0; vt < 16; ++vt) { v2u o; o.x = pkbf(acc[dt][vt][0], acc[dt][vt][1]); o.y = pkbf(acc[dt][vt][2], acc[dt][vt][3]); *(v2u*)(U + (16 * vt + l15) * 256 + 32 * w + 16 * dt + 4 * gq) = o; }
}
DI void ret_B(Frame& F) {
    for (int it = blockIdx.x * NTHR + F.tid(); it < 8 * 16384; it += F.G() * NTHR) { const int bh = it >> 14, e4 = it & 16383, h = bh & 3;
        const float cd = __expf(log1pf(-exp2f(-5.f - (float)h)) * 256.f); f32x4 s = (f32x4){0.f, 0.f, 0.f, 0.f};
        const size_t o0 = (size_t)(bh * 16) * 65536 + (size_t)e4 * 4; const bf16* __restrict__ ru = F.RU() + o0; bf16* __restrict__ rs = F.RS() + o0;
        f32x4 u[15];
#pragma unroll
        for (int c = 0; c < 15; ++c) { const v2u r = *(const v2u*)(ru + (size_t)c * 65536); u[c] = (f32x4){bf_lo(r.x), bf_hi(r.x), bf_lo(r.y), bf_hi(r.y)}; }
#pragma unroll
        for (int c = 0; c < 16; ++c) { *(unsigned long long*)(rs + (size_t)c * 65536) = (unsigned long long)pkbf(s[0], s[1]) | ((unsigned long long)pkbf(s[2], s[3]) << 32);
            if (c < 15) s = s * cd + u[c]; } }
}
DI void ret_C(Frame& F, int l, int unit2) {
    const int half = unit2 & 1, unit = unit2 >> 1, c = unit & 15, bh = unit >> 4, h = bh & 3, b = bh >> 2, lane = F.lane(), w = F.wave(), gq = lane >> 4, l15 = lane & 15;
    const size_t t0 = (size_t)b * SEQ + c * 256;
    const int il = half * 128 + w * 16 + l15;
    const float lg = log1pf(-exp2f(-5.f - (float)h));
    const bf16* St = F.RS() + (size_t)unit * 65536;
    const bf16* Kp = F.P() + t0 * NPJ + C_RK + h * 256; const bf16* Vp = F.P() + t0 * NPJ + C_RV + h * 256;
    LAS unsigned char* B0 = F.lds; LAS unsigned char* B1 = F.lds + 65536;
    if (c > 0) dma_tile256(St, 256, B0, w, lane); else { dma_tile256(Kp, NPJ, B0, w, lane); dma_tile256(Vp, NPJ, B0 + 32768, w, lane); }
    const bf16* Qp = F.P() + (t0 + il) * NPJ + C_RQ + h * 256;
    bf16x8 Q[8];
#pragma unroll
    for (int ks = 0; ks < 8; ++ks) Q[ks] = *(const bf16x8*)(Qp + 32 * ks + 8 * gq);
    f32x4 acc[16];
#pragma unroll
    for (int v = 0; v < 16; ++v) acc[v] = (f32x4){0.f, 0.f, 0.f, 0.f};
    const int njt = 2 * (half + 1);
    float gp[8]; const float kb = __expf(-lg * (float)(8 * gq)) * 0.0625f;
#pragma unroll
    for (int e = 0; e < 8; ++e) gp[e] = __builtin_bit_cast(float, __builtin_amdgcn_readfirstlane(__builtin_bit_cast(int, __expf(-lg * (float)e))));
    VM_WAIT(); __syncthreads();
    int par = 0;
    if (c > 0) {
#pragma unroll
        for (int sp = 0; sp < 4; ++sp) {
            LAS unsigned char* cur = (sp & 1) ? B1 : B0; LAS unsigned char* nxt = (sp & 1) ? B0 : B1;
            if (sp < 3) dma_tile256(St + (size_t)(64 * (sp + 1)) * 256, 256, nxt, w, lane); else { dma_tile256(Kp, NPJ, nxt, w, lane); dma_tile256(Vp, NPJ, nxt + 32768, w, lane); }
#pragma unroll
            for (int ks = 0; ks < 8; ++ks)
#pragma unroll
                for (int vt = 0; vt < 4; ++vt) acc[4 * sp + vt] = mfma16(frag_row_sw512(cur, 16 * vt + l15, 4 * ks + gq), Q[ks], acc[4 * sp + vt]);
            VM_WAIT(); __syncthreads();
        }
        const float qd = __expf(lg * (float)(il + 1));
#pragma unroll
        for (int v = 0; v < 16; ++v) acc[v] *= qd;
        par = 0;
    }
    for (int jt = 0; jt < njt; ++jt) {
        LAS unsigned char* cur = ((jt + par) & 1) ? B1 : B0; LAS unsigned char* nxt = ((jt + par) & 1) ? B0 : B1;
        if (jt + 1 < njt) { dma_tile256(Kp + (size_t)(64 * (jt + 1)) * NPJ, NPJ, nxt, w, lane); dma_tile256(Vp + (size_t)(64 * (jt + 1)) * NPJ, NPJ, nxt + 32768, w, lane); }
        if (64 * jt <= half * 128 + w * 16 + 15) {
            const LAS unsigned char* Kt = cur; const LAS unsigned char* Vt = cur + 32768;
#pragma unroll
            for (int js = 0; js < 2; ++js) {
                f32x4 s0 = (f32x4){0.f, 0.f, 0.f, 0.f}, s1 = s0, s0b = s0, s1b = s0;
                const int kr0 = 32 * js + 8 * (l15 >> 2) + (l15 & 3), kr1 = kr0 + 4;
#pragma unroll
                for (int ks = 0; ks < 8; ks += 2) { s0 = mfma16(frag_row_sw512(Kt, kr0, 4 * ks + gq), Q[ks], s0); s1 = mfma16(frag_row_sw512(Kt, kr1, 4 * ks + gq), Q[ks], s1);
                    s0b = mfma16(frag_row_sw512(Kt, kr0, 4 * ks + 4 + gq), Q[ks + 1], s0b); s1b = mfma16(frag_row_sw512(Kt, kr1, 4 * ks + 4 + gq), Q[ks + 1], s1b); }
                s0 += s0b; s1 += s1b;
                float p[8]; const int jbase = 64 * jt + 32 * js; const float rowf = __expf(lg * (float)(il - jbase)) * kb;
#pragma unroll
                for (int e = 0; e < 8; ++e) { const float sv = (e < 4) ? s0[e & 3] : s1[e & 3]; p[e] = sv * gp[e] * rowf; }
                if (jbase + 31 > half * 128 + w * 16) {
#pragma unroll
                    for (int e = 0; e < 8; ++e) p[e] = (il >= jbase + 8 * gq + e) ? p[e] : 0.f; }
                const bf16x8 Pf = pack8f(p);
#pragma unroll
                for (int vt = 0; vt < 16; ++vt) acc[vt] = mfma16(frag_tr_sw512(Vt, 32 * js + 8 * gq, 32 * js + 8 * gq + 4, 16 * vt, lane), Pf, acc[vt]);
            }
        }
        VM_WAIT(); __syncthreads();
    }
    float ss = 0.f;
#pragma unroll
    for (int v = 0; v < 16; ++v) ss += (acc[v][0] * acc[v][0] + acc[v][1] * acc[v][1]) + (acc[v][2] * acc[v][2] + acc[v][3] * acc[v][3]);
    ss += __shfl_xor(ss, 16); ss += __shfl_xor(ss, 32);
    const float rms = rsqrtf(ss * (1.0f / 256.0f) + EPS);
    const float* gw = F.in(3) + l * 1024 + h * 256; const bf16* Gp = F.P() + (t0 + il) * NPJ + C_RG + h * 256; bf16* Yp = F.Y() + (t0 + il) * DM + 0 + h * 256;
#pragma unroll
    for (int vt = 0; vt < 16; ++vt) { const int v = 16 * vt + 4 * gq; const v2u gv = *(const v2u*)(Gp + v); const f32x4 w4 = *(const f32x4*)(gw + v);
        const float y0 = acc[vt][0] * rms * w4[0] * silu(bf_lo(gv.x)), y1 = acc[vt][1] * rms * w4[1] * silu(bf_hi(gv.x)), y2 = acc[vt][2] * rms * w4[2] * silu(bf_lo(gv.y)), y3 = acc[vt][3] * rms * w4[3] * silu(bf_hi(gv.y));
        v2u o; o.x = pkbf(y0, y1); o.y = pkbf(y2, y3); *(v2u*)(Yp + v) = o; }
}

DI void moba_kmean(Frame& F, int unit) {
    const int blk = unit & 15, bh = unit >> 4, h = bh & 7, b = bh >> 3, tid = F.tid(), ch = tid & 15, rg = tid >> 4;
    const bf16* Kp = F.P() + ((size_t)b * SEQ + blk * 256 + rg) * NPJ + C_MK + h * 128 + ch * 8;
    v4u raw[8];
#pragma unroll
    for (int i = 0; i < 8; ++i) raw[i] = *(const v4u*)(Kp + (size_t)(32 * i) * NPJ);
    float s[8] = {0.f, 0.f, 0.f, 0.f, 0.f, 0.f, 0.f, 0.f}; float r2max = 0.f;
#pragma unroll
    for (int i = 0; i < 8; ++i) { float f[8]; unpack8(raw[i], f); float r2 = 0.f;
#pragma unroll
        for (int e = 0; e < 8; ++e) { s[e] += f[e]; r2 += f[e] * f[e]; }
        r2 += __shfl_xor(r2, 1); r2 += __shfl_xor(r2, 2); r2 += __shfl_xor(r2, 4); r2 += __shfl_xor(r2, 8);
        r2max = fmaxf(r2max, r2); }
    LAS float* red = (LAS float*)F.lds;
    __syncthreads();
    *(LAS f32x4*)(red + rg * 128 + ch * 8) = (f32x4){s[0], s[1], s[2], s[3]}; *(LAS f32x4*)(red + rg * 128 + ch * 8 + 4) = (f32x4){s[4], s[5], s[6], s[7]};
    if (ch == 0) red[4096 + rg] = r2max;
    __syncthreads();
    if (tid < 32) { float m = red[4096 + tid]; m = fmaxf(m, __shfl_xor(m, 1)); m = fmaxf(m, __shfl_xor(m, 2)); m = fmaxf(m, __shfl_xor(m, 4)); m = fmaxf(m, __shfl_xor(m, 8)); m = fmaxf(m, __shfl_xor(m, 16));
        if (tid == 0) F.KMX()[unit] = m; }
    if (tid < 128) { float t = 0.f;
#pragma unroll
        for (int g = 0; g < 32; ++g) t += red[g * 128 + tid];
        const float km = t * (1.0f / 256.0f);
        const unsigned hi = f2bf(km); const float rem = km - __uint_as_float(hi << 16);
        F.KMH()[(size_t)unit * 128 + tid] = (bf16)hi; F.KML()[(size_t)unit * 128 + tid] = (bf16)f2bf(rem); }
}
struct MobaSt {
    bf16x8 Q[2][4]; f32x4 acc[2][8]; f32x4 accl[2]; float cmi[2], kbs[8]; unsigned mym[2], wm;
    const LAS unsigned char* kptr[2][4]; const LAS unsigned char* vptr[2][8];
    unsigned voff[2]; const char* gK; LAS unsigned char* hb; bf16x8 ones;
    float scale2, slope2, slope2i, inv2; int ob, qrel_hi, qpos0, w8, gq;
};
DI void moba_dma(const MobaSt& S, int tt, int bufoff) {
    const char* g = sbase(S.gK + (size_t)tt * (64 * NPJ * 2)); const char* gv = sbase(g + (C_MV - C_MK) * 2);
#pragma unroll
    for (int i = 0; i < 2; ++i) { LAS unsigned char* d = S.hb + bufoff + (S.w8 * 2 + i) * 1024; unsigned vo = S.voff[i]; asm volatile("" : "+v"(vo));
        __builtin_amdgcn_global_load_lds((const unsigned*)(g + vo), (LAS unsigned*)d, 16, 0, 0);
        __builtin_amdgcn_global_load_lds((const unsigned*)(gv + vo), (LAS unsigned*)(d + 16384), 16, 0, 0); }
}
template <int BUF, bool SAFE> DI void moba_tile(MobaSt& S, int tt) {
    const int kb = tt >> 2, tile = tt & 3;
    if (!(((S.wm >> kb) & 1u) && (kb < S.ob || 64 * tile <= S.qrel_hi))) return;
    const bool own = (kb == S.ob);
#pragma unroll
    for (int js = 0; js < 2; ++js) {
        f32x4 s[2][2];
        const float kposf = (float)(tt * 64 + 32 * js);
#pragma unroll
        for (int qi = 0; qi < 2; ++qi) {
            float t0 = fmaf(S.slope2i, kposf, -S.cmi[qi]); t0 = ((S.mym[qi] >> kb) & 1u) ? t0 : -INFINITY;
            s[qi][0] = (f32x4){t0 + S.kbs[0], t0 + S.kbs[1], t0 + S.kbs[2], t0 + S.kbs[3]}; s[qi][1] = (f32x4){t0 + S.kbs[4], t0 + S.kbs[5], t0 + S.kbs[6], t0 + S.kbs[7]};
            if (own) { const int kp = tt * 64 + 32 * js + 8 * S.gq, qp = S.qpos0 + 16 * qi;
#pragma unroll
                for (int e = 0; e < 4; ++e) { s[qi][0][e] = (kp + e <= qp) ? s[qi][0][e] : -INFINITY; s[qi][1][e] = (kp + 4 + e <= qp) ? s[qi][1][e] : -INFINITY; } } }
#pragma unroll
        for (int ks = 0; ks < 4; ++ks) {
            const bf16x8 K0 = *(const LAS bf16x8*)(S.kptr[0][ks] + BUF + 8192 * js), K1 = *(const LAS bf16x8*)(S.kptr[1][ks] + BUF + 8192 * js);
#pragma unroll
            for (int qi = 0; qi < 2; ++qi) { s[qi][0] = mfma16(K0, S.Q[qi][ks], s[qi][0]); s[qi][1] = mfma16(K1, S.Q[qi][ks], s[qi][1]); } }
        bf16x8 Pf[2];
#pragma unroll
        for (int qi = 0; qi < 2; ++qi) {
            float p[8];
#pragma unroll
            for (int e = 0; e < 8; ++e) { const float sv = (e < 4) ? s[qi][0][e & 3] : s[qi][1][e & 3]; p[e] = sv * S.scale2; }
            if constexpr (SAFE) {
                float mx = __builtin_elementwise_maximum(__builtin_elementwise_maximum(p[0], p[1]), p[2]); mx = __builtin_elementwise_maximum(__builtin_elementwise_maximum(mx, p[3]), p[4]);
                mx = __builtin_elementwise_maximum(__builtin_elementwise_maximum(mx, p[5]), p[6]); mx = __builtin_elementwise_maximum(mx, p[7]);
                if (__any(mx > 8.0f)) {
                    mx = fmaxf(mx, __shfl_xor(mx, 16)); mx = fmaxf(mx, __shfl_xor(mx, 32));
                    const float d = fmaxf(mx, 0.f), alpha = __builtin_amdgcn_exp2f(-d);
                    S.cmi[qi] = fmaf(d, S.inv2, S.cmi[qi]); S.accl[qi] *= alpha;
#pragma unroll
                    for (int v = 0; v < 8; ++v) S.acc[qi][v] *= alpha;
#pragma unroll
                    for (int e = 0; e < 8; ++e) p[e] -= d; } }
#pragma unroll
            for (int e = 0; e < 8; ++e) p[e] = __builtin_amdgcn_exp2f(p[e]);
            Pf[qi] = pack8f(p); }
#pragma unroll
        for (int vt = 0; vt < 8; ++vt) {
            const s16x4 lo = __builtin_bit_cast(s16x4, __builtin_amdgcn_ds_read_tr16_b64_v4i16((LAS v4i16_t*)(S.vptr[0][vt] + BUF + 8192 * js)));
            const s16x4 hi = __builtin_bit_cast(s16x4, __builtin_amdgcn_ds_read_tr16_b64_v4i16((LAS v4i16_t*)(S.vptr[1][vt] + BUF + 8192 * js)));
            bf16x8 Vf; Vf[0] = lo[0]; Vf[1] = lo[1]; Vf[2] = lo[2]; Vf[3] = lo[3]; Vf[4] = hi[0]; Vf[5] = hi[1]; Vf[6] = hi[2]; Vf[7] = hi[3];
            S.acc[0][vt] = mfma16(Vf, Pf[0], S.acc[0][vt]); S.acc[1][vt] = mfma16(Vf, Pf[1], S.acc[1][vt]); }
        S.accl[0] = mfma16(S.ones, Pf[0], S.accl[0]); S.accl[1] = mfma16(S.ones, Pf[1], S.accl[1]);
    }
}
DI void moba_attn(Frame& F, int ob, int bh) {
    const int lane = F.lane(), w = F.wave(), gq = lane >> 4, l15 = lane & 15;
    const int h = bh & 7, b = bh >> 3;
    const size_t tq = (size_t)b * SEQ + ob * 256 + w * 32;
    MobaSt S;
    S.ob = ob; S.w8 = w; S.gq = gq; S.hb = F.lds;
    S.scale2 = 0.08838834764831845f * 1.4426950408889634f; S.slope2 = exp2f(-(float)(h + 1)) * 1.4426950408889634f; S.inv2 = 1.0f / S.scale2; S.slope2i = S.slope2 * S.inv2;
#pragma unroll
    for (int qi = 0; qi < 2; ++qi)
#pragma unroll
        for (int ks = 0; ks < 4; ++ks) S.Q[qi][ks] = *(const bf16x8*)(F.P() + (tq + qi * 16 + l15) * NPJ + C_MQ + h * 128 + 32 * ks + 8 * gq);
    { bf16x8 KH[4], KL[4];
#pragma unroll
      for (int ks = 0; ks < 4; ++ks) { KH[ks] = *(const bf16x8*)(F.KMH() + ((size_t)bh * 16 + l15) * 128 + 32 * ks + 8 * gq); KL[ks] = *(const bf16x8*)(F.KML() + ((size_t)bh * 16 + l15) * 128 + 32 * ks + 8 * gq); }
#pragma unroll
      for (int qi = 0; qi < 2; ++qi) { f32x4 g = (f32x4){0.f, 0.f, 0.f, 0.f};
#pragma unroll
          for (int ks = 0; ks < 4; ++ks) { g = mfma16(KH[ks], S.Q[qi][ks], g); g = mfma16(KL[ks], S.Q[qi][ks], g); }
          float gv[4];
#pragma unroll
          for (int r = 0; r < 4; ++r) gv[r] = (4 * gq + r < ob) ? g[r] : -INFINITY;
          unsigned mask = 0u;
#pragma unroll
          for (int pass = 0; pass < 3; ++pass) { float bv = -INFINITY; int bn = 31;
#pragma unroll
              for (int r = 0; r < 4; ++r) { const int n = 4 * gq + r; if (!((mask >> n) & 1u) && gv[r] > bv) { bv = gv[r]; bn = n; } }
#pragma unroll
              for (int off = 16; off <= 32; off <<= 1) { const float ov = __shfl_xor(bv, off); const int on = __shfl_xor(bn, off); if (ov > bv || (ov == bv && on < bn)) { bv = ov; bn = on; } }
              if (bv > -INFINITY) mask |= 1u << bn; }
          S.mym[qi] = mask | (1u << ob); } }
    { unsigned wm = S.mym[0] | S.mym[1]; wm |= __shfl_xor(wm, 1); wm |= __shfl_xor(wm, 2); wm |= __shfl_xor(wm, 4); wm |= __shfl_xor(wm, 8); S.wm = __builtin_amdgcn_readfirstlane(wm); }
#pragma unroll
    for (int qi = 0; qi < 2; ++qi) { const bf16* kp = F.P() + (tq + qi * 16 + l15) * NPJ + C_MK + h * 128 + 8 * gq; float d = 0.f;
#pragma unroll
        for (int ks = 0; ks < 4; ++ks) { float kf[8], qf[8]; unpack8(*(const v4u*)(kp + 32 * ks), kf); unpack8(__builtin_bit_cast(v4u, S.Q[qi][ks]), qf);
#pragma unroll
            for (int e = 0; e < 8; ++e) d += kf[e] * qf[e]; }
        d += __shfl_xor(d, 16); d += __shfl_xor(d, 32); S.cmi[qi] = d; }
    const int qrel0 = w * 32 + l15; S.qpos0 = ob * 256 + qrel0; S.qrel_hi = w * 32 + 31;
    S.cmi[0] += S.slope2i * (float)(S.qpos0 - 8 * gq); S.cmi[1] += S.slope2i * (float)(S.qpos0 + 16 - 8 * gq);
    { int z0 = 0; asm volatile("" : "+s"(z0));
#pragma unroll
      for (int e = 0; e < 8; ++e) S.kbs[e] = __builtin_bit_cast(float, __builtin_amdgcn_readfirstlane(__builtin_bit_cast(int, S.slope2i * (float)(e + z0)))); }
#pragma unroll
    for (int qi = 0; qi < 2; ++qi) { S.accl[qi] = (f32x4){0.f, 0.f, 0.f, 0.f};
#pragma unroll
        for (int v = 0; v < 8; ++v) S.acc[qi][v] = (f32x4){0.f, 0.f, 0.f, 0.f}; }
    { const short one = (l15 == 0) ? (short)0x3F80 : (short)0;
#pragma unroll
      for (int e = 0; e < 8; ++e) S.ones[e] = one; }
#pragma unroll
    for (int sub = 0; sub < 2; ++sub) { const int row = 8 * (l15 >> 2) + 4 * sub + (l15 & 3);
#pragma unroll
        for (int ks = 0; ks < 4; ++ks) { S.kptr[sub][ks] = S.hb + 256 * row + 16 * ((4 * ks + gq) ^ swz(row)); asm volatile("" : "+v"(S.kptr[sub][ks])); } }
    { const int q = l15 >> 2, pp = lane & 3;
#pragma unroll
      for (int t = 0; t < 2; ++t) { const int row = 8 * gq + 4 * t + q;
#pragma unroll
          for (int vt = 0; vt < 8; ++vt) { S.vptr[t][vt] = S.hb + 16384 + 256 * row + 16 * ((2 * vt + (pp >> 1)) ^ swz(row)) + 8 * (pp & 1); asm volatile("" : "+v"(S.vptr[t][vt])); } } }
#pragma unroll
    for (int i = 0; i < 2; ++i) { const int row = 4 * (w * 2 + i) + (lane >> 4), c = (lane & 15) ^ swz(row); S.voff[i] = (unsigned)(row * NPJ + c * 8) * 2u; }
    S.gK = (const char*)(F.P() + (size_t)b * SEQ * NPJ + h * 128 + C_MK);
    const int NT = ob * 4 + 4;
    int fast;
    { float q2 = 0.f;
#pragma unroll
      for (int qi = 0; qi < 2; ++qi) { float ss = 0.f;
#pragma unroll
          for (int ks = 0; ks < 4; ++ks) { float qf[8]; unpack8(__builtin_bit_cast(v4u, S.Q[qi][ks]), qf);
#pragma unroll
              for (int e = 0; e < 8; ++e) ss += qf[e] * qf[e]; }
          ss += __shfl_xor(ss, 16); ss += __shfl_xor(ss, 32); q2 = fmaxf(q2, ss); }
      q2 = fmaxf(q2, __shfl_xor(q2, 1)); q2 = fmaxf(q2, __shfl_xor(q2, 2)); q2 = fmaxf(q2, __shfl_xor(q2, 4)); q2 = fmaxf(q2, __shfl_xor(q2, 8));
      const float qn = sqrtf(q2) * 1.01f, kown = sqrtf(F.KMX()[bh * 16 + ob]) * 1.01f, kj = sqrtf(F.KMX()[bh * 16 + l15]) * 1.01f;
      const float dist = (float)(ob * 256 + w * 32 - (256 * l15 + 255));
      const bool zero = (l15 < ob) && (qn * (kj + kown) * S.scale2 - S.slope2 * dist < -138.0f);
      { float kall = (l15 <= ob) ? kj : 0.f; kall = fmaxf(kall, __shfl_xor(kall, 1)); kall = fmaxf(kall, __shfl_xor(kall, 2)); kall = fmaxf(kall, __shfl_xor(kall, 4)); kall = fmaxf(kall, __shfl_xor(kall, 8));
        fast = __builtin_amdgcn_readfirstlane((int)(qn * (kall + kown) * S.scale2 <= 100.0f)); }
      const unsigned zmask = (unsigned)(__ballot(zero) & 0xFFFFull);
      S.wm &= ~zmask;
      const int lead = __builtin_ctz(~zmask);
      if (lane == 0) ((volatile LAS int*)(F.lds + LDSCTL_OFF + 512))[w] = lead; }
    __syncthreads();
    int T0;
    { volatile LAS int* le = (volatile LAS int*)(F.lds + LDSCTL_OFF + 512); int m = le[0];
#pragma unroll
      for (int k = 1; k < 8; ++k) m = min(m, le[k]);
      T0 = 4 * __builtin_amdgcn_readfirstlane(m); }
    moba_dma(S, T0, 0);
    VM_WAIT(); __syncthreads();
    if (fast) {
        for (int tt = T0; tt < NT; tt += 2) {
            moba_dma(S, tt + 1, 32768);
            moba_tile<0, false>(S, tt);
            VM_WAIT(); __syncthreads();
            if (tt + 2 < NT) moba_dma(S, tt + 2, 0);
            moba_tile<32768, false>(S, tt + 1);
            VM_WAIT(); __syncthreads();
        }
    } else {
        for (int tt = T0; tt < NT; tt += 2) {
            moba_dma(S, tt + 1, 32768);
            moba_tile<0, true>(S, tt);
            VM_WAIT(); __syncthreads();
            if (tt + 2 < NT) moba_dma(S, tt + 2, 0);
            moba_tile<32768, true>(S, tt + 1);
            VM_WAIT(); __syncthreads();
        }
    }
#pragma unroll
    for (int qi = 0; qi < 2; ++qi) { const float lt = __shfl(S.accl[qi][0], l15); const float inv = 1.0f / lt; const size_t ti = tq + qi * 16 + l15;
        const bf16* Gp = F.P() + ti * NPJ + C_MG + h * 128; bf16* Yp = F.Y() + ti * DM + 1024 + h * 128;
#pragma unroll
        for (int vt = 0; vt < 8; ++vt) { const int v = 16 * vt + 4 * gq; const v2u gv = *(const v2u*)(Gp + v);
            const float y0 = S.acc[qi][vt][0] * inv * silu(bf_lo(gv.x)), y1 = S.acc[qi][vt][1] * inv * silu(bf_hi(gv.x)), y2 = S.acc[qi][vt][2] * inv * silu(bf_lo(gv.y)), y3 = S.acc[qi][vt][3] * inv * silu(bf_hi(gv.y));
            v2u o; o.x = pkbf(y0, y1); o.y = pkbf(y2, y3); *(v2u*)(Yp + v) = o; } }
}

DI void ssd_A(Frame& F, int l, int unit) {
    const int grp = unit & 3, bc = unit >> 2, c = bc & 15, b = bc >> 4, tid = F.tid(), lane = F.lane(), w = F.wave(), gq = lane >> 4;
    const size_t t0 = (size_t)b * SEQ + c * 256;
    LAS float* dtl = (LAS float*)F.lds; LAS float* dacs = dtl + 1024; LAS float* fac = dtl + 2048;
    LAS unsigned char* Bt = F.lds + 12288; LAS unsigned char* XWt = Bt + 64 * SB128;
    __syncthreads();
    for (int idx = tid; idx < 1024; idx += NTHR) { const int r = idx >> 8, t = idx & 255, head = 4 * grp + r;
        const float raw = F.DTRAW()[(t0 + t) * 16 + head] + F.in(6)[l * 16 + head]; const float dt = softplus(raw), a = -__expf(F.in(7)[l * 16 + head]);
        dtl[idx] = dt; dacs[idx] = dt * a; }
    __syncthreads();
    if (w < 4) { float x0 = dacs[w * 256 + 4 * lane], x1 = dacs[w * 256 + 4 * lane + 1], x2 = dacs[w * 256 + 4 * lane + 2], x3 = dacs[w * 256 + 4 * lane + 3];
        x1 += x0; x2 += x1; x3 += x2; float tot = x3;
#pragma unroll
        for (int o = 1; o < 64; o <<= 1) { const float y = __shfl_up(tot, o); if (lane >= o) tot += y; }
        const float ex = tot - x3;
        dacs[w * 256 + 4 * lane] = x0 + ex; dacs[w * 256 + 4 * lane + 1] = x1 + ex; dacs[w * 256 + 4 * lane + 2] = x2 + ex; dacs[w * 256 + 4 * lane + 3] = x3 + ex; }
    __syncthreads();
    for (int idx = tid; idx < 1024; idx += NTHR) { const int r = idx >> 8, t = idx & 255, head = 4 * grp + r; const float dc = dacs[idx], dt = dtl[idx];
        fac[idx] = __expf(dacs[r * 256 + 255] - dc) * dt; F.DT()[(t0 + t) * 16 + head] = dc * 1.4426950408889634f - __log2f(dt); F.DACS()[(t0 + t) * 16 + head] = dc * 1.4426950408889634f; }
    f32x4 acc[16];
#pragma unroll
    for (int v = 0; v < 16; ++v) acc[v] = (f32x4){0.f, 0.f, 0.f, 0.f};
    const int cc = tid & 63, tg = tid >> 6;
    const int chn = cc < 32 ? grp * 256 + cc * 8 : (cc < 48 ? 1024 + grp * 128 + (cc - 32) * 8 : 1536 + grp * 128 + (cc - 48) * 8);
    float cw[4][8], cb[8];
#pragma unroll
    for (int k = 0; k < 4; ++k) { const f32x4 a = *(const f32x4*)(F.in(4) + ((size_t)l * 4 + k) * 2048 + chn), bq = *(const f32x4*)(F.in(4) + ((size_t)l * 4 + k) * 2048 + chn + 4);
        cw[k][0] = a[0]; cw[k][1] = a[1]; cw[k][2] = a[2]; cw[k][3] = a[3]; cw[k][4] = bq[0]; cw[k][5] = bq[1]; cw[k][6] = bq[2]; cw[k][7] = bq[3]; }
    { const f32x4 a = *(const f32x4*)(F.in(5) + (size_t)l * 2048 + chn), bq = *(const f32x4*)(F.in(5) + (size_t)l * 2048 + chn + 4);
      cb[0] = a[0]; cb[1] = a[1]; cb[2] = a[2]; cb[3] = a[3]; cb[4] = bq[0]; cb[5] = bq[1]; cb[6] = bq[2]; cb[7] = bq[3]; }
    const bf16* Xp = F.P() + t0 * NPJ + C_SX + chn;
    for (int jt = 0; jt < 4; ++jt) {
        __syncthreads();
        { const int tl0 = jt * 64 + tg * 8; float h0[8], h1[8], h2[8];
          { const bool z = (c == 0 && tl0 < 3);
            if (z) {
#pragma unroll
                for (int e = 0; e < 8; ++e) { h0[e] = 0.f; h1[e] = 0.f; h2[e] = 0.f; }
            } else { unpack8(*(const v4u*)(Xp + ((long)tl0 - 3) * NPJ), h0); unpack8(*(const v4u*)(Xp + ((long)tl0 - 2) * NPJ), h1); unpack8(*(const v4u*)(Xp + ((long)tl0 - 1) * NPJ), h2); } }
          v4u xraw[8];
#pragma unroll
          for (int i = 0; i < 8; ++i) xraw[i] = *(const v4u*)(Xp + (size_t)(tl0 + i) * NPJ);
#pragma unroll
          for (int i = 0; i < 8; ++i) { const int tl = tl0 + i; float x[8], y[8]; unpack8(xraw[i], x);
#pragma unroll
              for (int e = 0; e < 8; ++e) { const float v = cb[e] + cw[0][e] * h0[e] + cw[1][e] * h1[e] + cw[2][e] * h2[e] + cw[3][e] * x[e]; y[e] = silu(v); h0[e] = h1[e]; h1[e] = h2[e]; h2[e] = x[e]; }
              *(v4u*)(F.XBC() + (t0 + tl) * 2048 + chn) = pack8(y);
              if (cc < 32) { const float f = fac[(cc >> 3) * 256 + tl];
#pragma unroll
                  for (int e = 0; e < 8; ++e) y[e] *= f;
                  *(LAS v4u*)(XWt + (tg * 8 + i) * SB256 + cc * 16) = pack8(y); }
              else if (cc < 48) *(LAS v4u*)(Bt + (tg * 8 + i) * SB128 + (cc - 32) * 16) = pack8(y); } }
        __syncthreads();
#pragma unroll
        for (int ks = 0; ks < 2; ++ks) { const int ra = 32 * ks + 8 * gq, rb = ra + 4; const bf16x8 A = frag_tr(Bt, SB128, ra, rb, 16 * w, lane);
#pragma unroll
            for (int pt = 0; pt < 16; ++pt) acc[pt] = mfma16(A, frag_tr(XWt, SB256, ra, rb, 16 * pt, lane), acc[pt]); }
    }
#pragma unroll
    for (int pt = 0; pt < 16; ++pt) { const int head = 4 * grp + (pt >> 2); float* S = F.SST() + ((size_t)bc * 16 + head) * 8192;
        *(f32x4*)(S + ((pt & 3) * 16 + (lane & 15)) * 128 + 16 * w + 4 * gq) = acc[pt]; }
}
DI void ssd_B(Frame& F) {
    for (int it = blockIdx.x * NTHR + F.tid(); it < 32 * 2048; it += F.G() * NTHR) { const int e4 = it & 2047, bhd = it >> 11, head = bhd & 15, b = bhd >> 4; f32x4 s = (f32x4){0.f, 0.f, 0.f, 0.f};
        const size_t o0 = ((size_t)(b * 16) * 16 + head) * 8192 + (size_t)e4 * 4; const float* __restrict__ st = F.SST() + o0; bf16* __restrict__ hp = F.SHP() + o0;
        f32x4 u[15]; float dec[15];
#pragma unroll
        for (int c = 0; c < 15; ++c) { u[c] = *(const f32x4*)(st + (size_t)c * 16 * 8192); dec[c] = F.DACS()[((size_t)b * SEQ + c * 256 + 255) * 16 + head]; }
#pragma unroll
        for (int c = 0; c < 16; ++c) { *(unsigned long long*)(hp + (size_t)c * 16 * 8192) = (unsigned long long)pkbf(s[0], s[1]) | ((unsigned long long)pkbf(s[2], s[3]) << 32);
            if (c < 15) s = s * __builtin_amdgcn_exp2f(dec[c]) + u[c]; } }
}
template <int NROWS> DI void dma_rows128(const bf16* src, unsigned gp, LAS unsigned char* dst, int w, int lane) {
    const char* sb = sbase(src);
#pragma unroll
    for (int i = 0; i < NROWS / 32; ++i) { const int idx = w * (NROWS / 32) + i, row = 4 * idx + (lane >> 4), c = (lane & 15) ^ swz(row);
        __builtin_amdgcn_global_load_lds((const unsigned*)(sb + ((unsigned)row * gp + (unsigned)c * 8u) * 2u), (LAS unsigned*)(dst + idx * 1024), 16, 0, 0); }
}
DI bf16x8 frag_row_sw256(const LAS unsigned char* t, int row, int ch) { return *(const LAS bf16x8*)(t + 256 * row + 16 * (ch ^ swz(row))); }
constexpr int SC_B = 0, SC_X = 16384, SC_DA = 49152, SC_DT = 50176;
DI void ssd_dma_tile(Frame& F, size_t trow, int grp, LAS unsigned char* buf, int w, int lane) {
    dma_rows128<64>(F.XBC() + trow * 2048 + 1024 + grp * 128, 2048, buf + SC_B, w, lane);
    dma_tile256(F.XBC() + trow * 2048 + grp * 256, 2048, buf + SC_X, w, lane);
    if (w == 1) __builtin_amdgcn_global_load_lds((const unsigned*)(F.DT() + (trow + lane) * 16 + 4 * grp), (LAS unsigned*)(buf + SC_DT), 16, 0, 0);
}
DI void ssd_C(Frame& F, int l, int unit2) {
    const int half = unit2 & 1, unit = unit2 >> 1, grp = unit & 3, bc = unit >> 2, c = bc & 15, b = bc >> 4, lane = F.lane(), w = F.wave(), gq = lane >> 4, l15 = lane & 15;
    const size_t t0 = (size_t)b * SEQ + c * 256; const int il = half * 128 + w * 16 + l15; const size_t ti = t0 + il;
    LAS unsigned char* B0 = F.lds; LAS unsigned char* B1 = F.lds + 65536;
    if (c > 0) dma_rows128<256>(F.SHP() + ((size_t)bc * 16 + 4 * grp) * 8192, 128, B0, w, lane); else ssd_dma_tile(F, t0, grp, B0, w, lane);
    bf16x8 Cf[4];
#pragma unroll
    for (int ks = 0; ks < 4; ++ks) Cf[ks] = *(const bf16x8*)(F.XBC() + ti * 2048 + 1536 + grp * 128 + 32 * ks + 8 * gq);
    f32x4 acc[4][4]; float dci[4];
    { const f32x4 d4 = *(const f32x4*)(F.DACS() + ti * 16 + 4 * grp); dci[0] = d4[0]; dci[1] = d4[1]; dci[2] = d4[2]; dci[3] = d4[3]; }
#pragma unroll
    for (int r = 0; r < 4; ++r)
#pragma unroll
        for (int pt = 0; pt < 4; ++pt) acc[r][pt] = (f32x4){0.f, 0.f, 0.f, 0.f};
    const int njt = 2 * (half + 1);
    VM_WAIT(); __syncthreads();
    int par = 0;
    if (c > 0) {
        ssd_dma_tile(F, t0, grp, B1, w, lane);
#pragma unroll
        for (int r = 0; r < 4; ++r) {
#pragma unroll
            for (int ks = 0; ks < 4; ++ks)
#pragma unroll
                for (int pt = 0; pt < 4; ++pt) acc[r][pt] = mfma16(frag_row_sw256(B0, r * 64 + 16 * pt + l15, 4 * ks + gq), Cf[ks], acc[r][pt]);
            const float ed = __builtin_amdgcn_exp2f(dci[r]);
#pragma unroll
            for (int pt = 0; pt < 4; ++pt) acc[r][pt] *= ed; }
        VM_WAIT(); __syncthreads();
        par = 1;
    }
    for (int jt = 0; jt < njt; ++jt) {
        LAS unsigned char* cur = ((jt + par) & 1) ? B1 : B0; LAS unsigned char* nxt = ((jt + par) & 1) ? B0 : B1;
        if (jt + 1 < njt) ssd_dma_tile(F, t0 + 64 * (jt + 1), grp, nxt, w, lane);
        if (64 * jt <= half * 128 + w * 16 + 15) {
            int lz = lane; asm volatile("" : "+v"(lz));
            const int gq = lz >> 4, l15 = lz & 15, lane = lz;
            const bool diag = 64 * jt + 63 > half * 128 + w * 16;
#pragma unroll
            for (int js = 0; js < 2; ++js) {
                f32x4 s0 = (f32x4){0.f, 0.f, 0.f, 0.f}, s1 = s0, s0b = s0, s1b = s0;
                const int kr0 = 32 * js + 8 * (l15 >> 2) + (l15 & 3), kr1 = kr0 + 4;
#pragma unroll
                for (int ks = 0; ks < 4; ks += 2) { s0 = mfma16(frag_row_sw256(cur + SC_B, kr0, 4 * ks + gq), Cf[ks], s0); s1 = mfma16(frag_row_sw256(cur + SC_B, kr1, 4 * ks + gq), Cf[ks], s1);
                    s0b = mfma16(frag_row_sw256(cur + SC_B, kr0, 4 * ks + 4 + gq), Cf[ks + 1], s0b); s1b = mfma16(frag_row_sw256(cur + SC_B, kr1, 4 * ks + 4 + gq), Cf[ks + 1], s1b); }
                s0 += s0b; s1 += s1b;
                float p[4][8];
#pragma unroll
                for (int e = 0; e < 8; ++e) { const int j = 64 * jt + 32 * js + 8 * gq + e; const float sv = (e < 4) ? s0[e & 3] : s1[e & 3];
                    const f32x4 dj = *(const LAS f32x4*)(cur + SC_DT + (32 * js + 8 * gq + e) * 16);
#pragma unroll
                    for (int r = 0; r < 4; ++r) { float ex = dci[r] - dj[r]; if (diag) ex = (il >= j) ? ex : -INFINITY; p[r][e] = sv * __builtin_amdgcn_exp2f(ex); } }
#pragma unroll
                for (int r = 0; r < 4; ++r) { const bf16x8 Pf = pack8f(p[r]);
#pragma unroll
                    for (int pt = 0; pt < 4; ++pt) acc[r][pt] = mfma16(frag_tr_sw512(cur + SC_X, 32 * js + 8 * gq, 32 * js + 8 * gq + 4, r * 64 + 16 * pt, lane), Pf, acc[r][pt]); }
            }
        }
        VM_WAIT(); __syncthreads();
    }
    float ss = 0.f;
    const bf16* xb = F.XBC() + ti * 2048 + grp * 256 + 4 * gq; const bf16* zb = F.P() + ti * NPJ + C_SZ + grp * 256 + 4 * gq;
#pragma unroll
    for (int r = 0; r < 4; ++r) { const float dsk = F.in(8)[l * 16 + 4 * grp + r];
#pragma unroll
        for (int pt = 0; pt < 4; ++pt) { const v2u xv = *(const v2u*)(xb + r * 64 + 16 * pt), zv = *(const v2u*)(zb + r * 64 + 16 * pt);
            f32x4 y = acc[r][pt]; y[0] = (y[0] + dsk * bf_lo(xv.x)) * silu(bf_lo(zv.x)); y[1] = (y[1] + dsk * bf_hi(xv.x)) * silu(bf_hi(zv.x)); y[2] = (y[2] + dsk * bf_lo(xv.y)) * silu(bf_lo(zv.y)); y[3] = (y[3] + dsk * bf_hi(xv.y)) * silu(bf_hi(zv.y));
            acc[r][pt] = y; ss += (y[0] * y[0] + y[1] * y[1]) + (y[2] * y[2] + y[3] * y[3]); }
        asm volatile("" ::: "memory"); }
    ss += __shfl_xor(ss, 16); ss += __shfl_xor(ss, 32);
    const float rms = rsqrtf(ss * (1.0f / 256.0f) + EPS);
    const float* nw = F.in(9) + (size_t)l * 1024 + grp * 256 + 4 * gq; bf16* yb = F.Y() + ti * DM + 2048 + grp * 256 + 4 * gq;
#pragma unroll
    for (int r = 0; r < 4; ++r)
#pragma unroll
        for (int pt = 0; pt < 4; ++pt) { const f32x4 w4 = *(const f32x4*)(nw + r * 64 + 16 * pt); const f32x4 y = acc[r][pt] * rms * w4;
            v2u o; o.x = pkbf(y[0], y[1]); o.y = pkbf(y[2], y[3]); *(v2u*)(yb + r * 64 + 16 * pt) = o; }
}

DI void lru_A(Frame& F, int l, int unit) {
    const int nb = unit & 7, bc = unit >> 3, c256 = bc & 15, b = bc >> 4, tid = F.tid(), lane = F.lane(), w = F.wave(), gq = lane >> 4;
    const int chn0 = nb * 128;
    LAS float* xcf = (LAS float*)F.lds; LAS float* al = xcf + 8192; LAS unsigned char* xcb = F.lds + 65536;
    LAS float* sh = (LAS float*)(F.lds + 65536 + 64 * SB128); LAS float* sa = sh + 512;
    const int ch8 = tid & 15, tg = tid >> 4, chn = chn0 + ch8 * 8, tl0 = tg * 2; float cw[4][8], cb[8];
#pragma unroll
    for (int k = 0; k < 4; ++k) { const f32x4 a = *(const f32x4*)(F.in(10) + ((size_t)l * 4 + k) * 1024 + chn), bq = *(const f32x4*)(F.in(10) + ((size_t)l * 4 + k) * 1024 + chn + 4);
        cw[k][0] = a[0]; cw[k][1] = a[1]; cw[k][2] = a[2]; cw[k][3] = a[3]; cw[k][4] = bq[0]; cw[k][5] = bq[1]; cw[k][6] = bq[2]; cw[k][7] = bq[3]; }
    { const f32x4 a = *(const f32x4*)(F.in(11) + (size_t)l * 1024 + chn), bq = *(const f32x4*)(F.in(11) + (size_t)l * 1024 + chn + 4);
      cb[0] = a[0]; cb[1] = a[1]; cb[2] = a[2]; cb[3] = a[3]; cb[4] = bq[0]; cb[5] = bq[1]; cb[6] = bq[2]; cb[7] = bq[3]; }
    const int eg = 16 * w + (lane & 15), chg = chn0 + eg;
    bf16x8 Ba[4], Bx[4];
    { const bf16* WTa = F.LRUW() + ((((size_t)l * 2 + 0) * 8 + nb) * 128 + eg) * 128; const bf16* WTx = F.LRUW() + ((((size_t)l * 2 + 1) * 8 + nb) * 128 + eg) * 128;
#pragma unroll
      for (int ks = 0; ks < 4; ++ks) { Ba[ks] = *(const bf16x8*)(WTa + 32 * ks + 8 * gq); Bx[ks] = *(const bf16x8*)(WTx + 32 * ks + 8 * gq); } }
    const float ba = F.in(13)[l * 1024 + chg], bx = F.in(15)[l * 1024 + chg], spl = softplus(-F.in(16)[l * 1024 + chg]);
    const size_t tu = (size_t)b * SEQ + c256 * 256;
    const bf16* Xp0 = F.P() + tu * NPJ + C_LX + chn;
    v4u raw[5];
#pragma unroll
    for (int k = 0; k < 5; ++k) { const int tl = tl0 - 3 + k; raw[k] = (c256 == 0 && tl < 0) ? (v4u){0u, 0u, 0u, 0u} : *(const v4u*)(Xp0 + (long)tl * NPJ); }
    for (int sc = 0; sc < 4; ++sc) {
        const int cc = c256 * 4 + sc, bcc = b * 64 + cc; const size_t t0 = tu + sc * 64;
        float xr[5][8];
#pragma unroll
        for (int k = 0; k < 5; ++k) unpack8(raw[k], xr[k]);
        if (sc < 3) {
#pragma unroll
            for (int k = 0; k < 5; ++k) raw[k] = *(const v4u*)(Xp0 + (long)((sc + 1) * 64 + tl0 - 3 + k) * NPJ); }
        __syncthreads();
#pragma unroll
        for (int i = 0; i < 2; ++i) { float y[8];
#pragma unroll
            for (int e = 0; e < 8; ++e) y[e] = cb[e] + cw[0][e] * xr[i][e] + cw[1][e] * xr[i + 1][e] + cw[2][e] * xr[i + 2][e] + cw[3][e] * xr[i + 3][e];
            *(LAS f32x4*)(xcf + (tl0 + i) * 128 + ch8 * 8) = (f32x4){y[0], y[1], y[2], y[3]}; *(LAS f32x4*)(xcf + (tl0 + i) * 128 + ch8 * 8 + 4) = (f32x4){y[4], y[5], y[6], y[7]};
            *(LAS v4u*)(xcb + (tl0 + i) * SB128 + ch8 * 16) = pack8(y); }
        __syncthreads();
#pragma unroll
        for (int mt = 0; mt < 4; ++mt) { f32x4 ra = (f32x4){0.f, 0.f, 0.f, 0.f}, rx = ra;
#pragma unroll
            for (int ks = 0; ks < 4; ++ks) { const bf16x8 A = frag_row(xcb, SB128, 16 * mt, 32 * ks, lane); ra = mfma16(A, Ba[ks], ra); rx = mfma16(A, Bx[ks], rx); }
#pragma unroll
            for (int reg = 0; reg < 4; ++reg) { const int t = 16 * mt + 4 * gq + reg; const float r_ = sigm(ra[reg] + ba), i_ = sigm(rx[reg] + bx), la = -8.0f * r_ * spl;
                const float a = __expf(la), u = __builtin_amdgcn_sqrtf(one_minus_exp(2.0f * la)) * i_ * xcf[t * 128 + eg]; al[t * 128 + eg] = a; xcf[t * 128 + eg] = u; } }
        __syncthreads();
        { const int e = tid & 127, seg = tid >> 7, ch = chn0 + e; float hv[16], av[16]; float hh = 0.f, ap = 1.f;
#pragma unroll
          for (int t = 0; t < 16; ++t) { const float a = al[(seg * 16 + t) * 128 + e], u = xcf[(seg * 16 + t) * 128 + e]; hh = a * hh + u; ap *= a; hv[t] = hh; av[t] = ap; }
          sh[seg * 128 + e] = hh; sa[seg * 128 + e] = ap;
          __syncthreads();
          float cin = 0.f, ain = 1.f;
#pragma unroll
          for (int k = 0; k < 3; ++k) if (k < seg) { cin = sa[k * 128 + e] * cin + sh[k * 128 + e]; ain *= sa[k * 128 + e]; }
#pragma unroll
          for (int t = 0; t < 16; ++t) { const size_t o = (t0 + seg * 16 + t) * 1024 + ch; F.HLOC()[o] = (bf16)f2bf(hv[t] + av[t] * cin); F.ACUM()[o] = (bf16)f2bf(av[t] * ain); }
          if (seg == 3) { F.HEND()[(size_t)bcc * 1024 + ch] = hv[15] + av[15] * cin; F.AEND()[(size_t)bcc * 1024 + ch] = av[15] * ain; } }
    }
}
DI void lru_B(Frame& F) {
    for (int it = blockIdx.x * NTHR + F.tid(); it < 2048; it += F.G() * NTHR) { const int ch = it & 1023, b = it >> 10; float carry = 0.f;
        const float* __restrict__ ae = F.AEND() + (size_t)(b * 64) * 1024 + ch; const float* __restrict__ he = F.HEND() + (size_t)(b * 64) * 1024 + ch; float* __restrict__ cr = F.CARRY() + (size_t)(b * 64) * 1024 + ch;
        float a[64], hh[64];
#pragma unroll
        for (int k = 0; k < 64; ++k) { a[k] = ae[(size_t)k * 1024]; hh[k] = he[(size_t)k * 1024]; }
#pragma unroll
        for (int k = 0; k < 64; ++k) { cr[(size_t)k * 1024] = carry; carry = a[k] * carry + hh[k]; } }
}
DI void lru_C(Frame& F, int unit) {
    const size_t tb = (size_t)unit * 32;
#pragma unroll 4
    for (int idx = F.tid(); idx < 32 * 128; idx += NTHR) { const size_t t = tb + (idx >> 7); const int ch = (idx & 127) * 8; const int b = (int)(t / SEQ), cc = (int)(t % SEQ) >> 6;
        const float* cr = F.CARRY() + (size_t)(b * 64 + cc) * 1024 + ch;
        float hl[8], ac[8], g[8]; unpack8(*(const v4u*)(F.HLOC() + t * 1024 + ch), hl); unpack8(*(const v4u*)(F.ACUM() + t * 1024 + ch), ac); unpack8(*(const v4u*)(F.P() + t * NPJ + C_LG + ch), g);
        const f32x4 c0 = *(const f32x4*)cr, c1 = *(const f32x4*)(cr + 4);
        float y[8];
#pragma unroll
        for (int e = 0; e < 8; ++e) { const float cv = e < 4 ? c0[e & 3] : c1[e & 3]; y[e] = (hl[e] + ac[e] * cv) * silu(g[e]); }
        *(v4u*)(F.Y() + t * DM + 3072 + ch) = pack8(y); }
}

__global__ void __launch_bounds__(NTHR, 2) hymba_fwd(Args args) {
    extern __shared__ __attribute__((aligned(16))) unsigned char lds[];
    Frame F = mk_frame((LAS unsigned char*)lds, &args);
    for (int u = F.tid(); u < (LDS_BYTES - LDSCTL_OFF) / 4; u += NTHR) ((LAS unsigned*)(F.lds + LDSCTL_OFF))[u] = 0u;
    __syncthreads();
    const int lo = args.ph_lo, hi = args.ph_hi;
    XcdBarrier bar; bar.bar = F.ctl() + CW_BAR; bar.x = 0; bar.st = nullptr;
    if (hi - lo > 1) bar = xcd_barrier_post(F.ctl() + CW_BAR, F.MISC() + 8);
#define IN(k) (lo <= (k) && (k) < hi)
#define SEAM(k) do { if (IN(k) && IN((k) + 1)) xcd_barrier(bar); } while (0)

    if (IN(0)) { p0_prologue(F);
#ifdef PROBE_PRO2
        xcd_barrier(bar); p0_prologue(F);
#endif
        SEAM(0); }
    for (int l = 0; l < DEPTH; ++l) {
        const int pb = 1 + 5 * l;
        if (IN(pb)) { F = mk_frame((LAS unsigned char*)lds, &args);
            pg8::Gemm g{F.XB(), F.WIN() + (size_t)l * NPJ * DM, MTOK, 12288, DM}; pg8::RemapOrder S; S.init(MTOK, 12288, F.G(), (int)blockIdx.x);
            pg8::Unit u0; S.next(0, u0); const int fm = u0.pm & ~7; LAS float* rtab = (LAS float*)(F.lds + LDSCTL_OFF + 1024);
            { const float* sq = F.SSQ() + (size_t)fm * 256 * 16;
              for (int r = F.tid(); r < 2048; r += NTHR) { const f32x4* p = (const f32x4*)(sq + (size_t)r * 16); const f32x4 a = p[0], b4 = p[1], c4 = p[2], d4 = p[3];
                  const float ssum = ((a[0] + a[1]) + (a[2] + a[3])) + ((b4[0] + b4[1]) + (b4[2] + b4[3])) + ((c4[0] + c4[1]) + (c4[2] + c4[3])) + ((d4[0] + d4[1]) + (d4[2] + d4[3]));
                  rtab[r] = rsqrtf(ssum * (1.0f / 4096.0f) + EPS); }
              __syncthreads(); }
            pg8::EpiProj E{F.P(), F.DTRAW(), F.SSQ(), rtab, fm};
#ifdef PROBE_IN2
            for (int rep2 = 0; rep2 < 2; ++rep2) { pg8::gemm_phase<pg8::EpiProj, pg8::RemapOrder, true, true>(F.lds, g, S, E); if (rep2 == 0) xcd_barrier(bar); }
#else
            pg8::gemm_phase<pg8::EpiProj, pg8::RemapOrder, true, true>(F.lds, g, S, E);
#endif
            SEAM(pb);
        }
#ifdef PROBE_MIX2
        for (int rep = 0; rep < 2; ++rep) {
#else
        { constexpr int rep = 0;
#endif
        if (IN(pb + 1)) { F = mk_frame((LAS unsigned char*)lds, &args);
#ifndef NO_STAGE_A
            for (int u = (int)blockIdx.x;; u = F.G() + next_unit(F, l * 4 + 0 + 2 * rep)) { F = mk_frame((LAS unsigned char*)lds, &args);
                if (u < 160) { const int t = u >> 5; pg8::Gemm g{F.XB(), F.WIN() + (size_t)l * NPJ * DM, MTOK, NPJ, DM}; pg8::OneUnit S1{u & 31, t == 0 ? 35 : 47 + t}; pg8::EpiProj E{F.P(), F.DTRAW(), F.SSQ(), nullptr, 0};
                    pg8::gemm_phase<pg8::EpiProj, pg8::OneUnit, true, true>(F.lds, g, S1, E); }
                else if (u < 288) ssd_A(F, l, u - 160);
                else if (u < 544) lru_A(F, l, u - 288);
                else if (u < 672) ret_A(F, u - 544);
                else if (u < 928) moba_kmean(F, u - 672);
                else if (u < 928 + 512) tr_unit(F, l, TR_I_IN + 2 * (u - 928), 2);
                else if (u < 1440 + 840 && l + 1 < DEPTH) tr_unit(F, l + 1, 2 * (u - 1440), 2);
                else break; }
#endif
            SEAM(pb + 1);
        }
        if (IN(pb + 2)) { F = mk_frame((LAS unsigned char*)lds, &args);
#ifndef NO_STAGE_B
            ret_B(F); ssd_B(F); lru_B(F);
#endif
            SEAM(pb + 2);
        }
        if (IN(pb + 3)) { F = mk_frame((LAS unsigned char*)lds, &args);
#ifndef NO_STAGE_C
            for (int u = (int)blockIdx.x;; u = F.G() + next_unit(F, l * 4 + 1 + 2 * rep)) { F = mk_frame((LAS unsigned char*)lds, &args);
                if (u < 256) moba_attn(F, 15 - (u >> 4), u & 15);
                else if (u < 512) ret_C(F, l, u - 256);
                else if (u < 768) ssd_C(F, l, u - 512);
                else if (u < 1024) lru_C(F, u - 768);
                else if (u < 1024 + 840 && l + 1 < DEPTH) tr_unit(F, l + 1, 1680 + 2 * (u - 1024), 2);
                else break; }
#endif
            SEAM(pb + 3);
        }
        }
        if (IN(pb + 4)) { F = mk_frame((LAS unsigned char*)lds, &args);
            pg8::Gemm g{F.Y(), F.WOUT() + (size_t)l * DM * DM, MTOK, DM, DM}; pg8::StaticOrder S; S.init(MTOK, DM, F.G(), (int)blockIdx.x);
            pg8::EpiOut E{F.XB(), F.SSQ(), (LAS float*)(F.lds + LDSCTL_OFF + 1024)};
            pg8::gemm_phase<pg8::EpiOut, pg8::StaticOrder, true, true>(F.lds, g, S, E);
            SEAM(pb + 4);
        }
    }
    if (IN(NPHASE - 1)) { F = mk_frame((LAS unsigned char*)lds, &args); p_final(F); }
#undef IN
#undef SEAM
}

#ifndef MK_ONE_LAUNCH
#define MK_ONE_LAUNCH 1
#endif
extern "C" void kernel_launch(void* const* d_in, const int* in_sizes, int n_in, void* d_out, int out_size, void* d_ws, size_t ws_size, hipStream_t stream) {
    static int grid = 0;
    if (grid == 0) {
        if (n_in != 19 || out_size != MTOK * DM || ws_size < WS_END) { fprintf(stderr, "kernel_launch: unexpected shapes (n_in %d, out %d, ws %zu)\n", n_in, out_size, ws_size); grid = -1; return; }
        int dev = 0, cus = 0, per_cu = 0;
        if (hipGetDevice(&dev) != hipSuccess || hipDeviceGetAttribute(&cus, hipDeviceAttributeMultiprocessorCount, dev) != hipSuccess) { grid = -1; return; }
        if (hipFuncSetAttribute((const void*)hymba_fwd, hipFuncAttributeMaxDynamicSharedMemorySize, LDS_BYTES) != hipSuccess) { fprintf(stderr, "kernel_launch: hipFuncSetAttribute failed\n"); grid = -1; return; }
        if (hipOccupancyMaxActiveBlocksPerMultiprocessor(&per_cu, (const void*)hymba_fwd, NTHR, LDS_BYTES) != hipSuccess || per_cu < 1) { fprintf(stderr, "kernel_launch: occupancy query says %d\n", per_cu); }
        (void)hipGetLastError();
        grid = cus;
    }
    if (grid < 0) return;
    (void)hipMemsetAsync((char*)d_ws + WS_CTL, 0, CTL_ZERO_BYTES, stream);
    Args a{};
    for (int i = 0; i < 19; ++i) a.in[i] = (const float*)d_in[i];
    a.out = (float*)d_out; a.ws = (unsigned char*)d_ws;
#if MK_ONE_LAUNCH
    a.ph_lo = 0; a.ph_hi = NPHASE;
    hipLaunchKernelGGL(hymba_fwd, dim3(grid), dim3(NTHR), LDS_BYTES, stream, a);
#else
    for (int p = 0; p < NPHASE; ++p) { a.ph_lo = p; a.ph_hi = p + 1; hipLaunchKernelGGL(hymba_fwd, dim3(grid), dim3(NTHR), LDS_BYTES, stream, a); }
#endif
}
```

```cpp
#include <hip/hip_runtime.h>
#include <cstdio>
#include <cstdint>
#include <cmath>
namespace pg8 {
#define PG8_LAS __attribute__((address_space(3)))
typedef unsigned short bf16_t;
typedef short bf16x8 __attribute__((ext_vector_type(8)));
typedef float f32x4 __attribute__((ext_vector_type(4)));
typedef unsigned u32x4 __attribute__((ext_vector_type(4)));
constexpr int BM = 256, BK = 64, HALF = 128, HTB = HALF * BK * 2  , STAGE_BYTES = 8 * HTB, NXCD = 8, WGM = 8;

__host__ __device__ __forceinline__ int lds_byte(int r, int c) { const int st = (r >> 4) * 2 + (c >> 5), rr = r & 15, cc = c & 31, ob = rr * 64 + cc * 2; return st * 1024 + (ob ^ (((ob >> 9) & 1) << 5)); }
__host__ __device__ __forceinline__ void stage_rc(int b, int& R, int& C) { const int st = b / 1024, sb = b % 1024, swz = sb ^ (((sb >> 9) & 1) << 5); R = (st >> 1) * 16 + swz / 64; C = (st & 1) * 32 + (swz % 64) / 2; }
__host__ __device__ __forceinline__ int perm32(int rho) { const int n = rho >> 4, i = rho & 15; return 8 * (i >> 2) + 4 * n + (i & 3); }

struct Unit { int pm, pn; };
struct Gemm { const bf16_t* A; const bf16_t* Bt; int M, N, K; };

struct StaticOrder {
    int nM, nN, nwg, G, c;
    __host__ __device__ void init(int M, int N, int G_, int c_) { nM = M / BM; nN = N / BM; nwg = nM * nN; G = G_; c = c_; }
    __host__ __device__ bool next(int i, Unit& u) const {
        const long L = (long)i * G + c; if (L >= nwg) return false;
        int wgid = (int)L; { const int q = nwg / NXCD, r = nwg % NXCD, xcd = wgid % NXCD, off = wgid / NXCD; wgid = (xcd < r ? xcd * (q + 1) : r * (q + 1) + (xcd - r) * q) + off; }
        const int nig = WGM * nN, gid = wgid / nig, fm = gid * WGM, gsz = (nM - fm) < WGM ? (nM - fm) : WGM;
        u.pm = fm + ((wgid % nig) % gsz); u.pn = (wgid % nig) / gsz; return true;
    }
    __device__ __forceinline__ void a_ready(const Unit&) const {}
    __device__ __forceinline__ void done(const Unit&) const {}
};

__device__ __forceinline__ unsigned cvt_pk_bf16(float lo, float hi) { unsigned r; asm volatile("v_cvt_pk_bf16_f32 %0, %1, %2" : "=v"(r) : "v"(lo), "v"(hi)); return r; }
typedef float f32x2 __attribute__((ext_vector_type(2)));
template <class Epi, class Sched, bool ALIGN_EPI = false, bool SP2 = false>
__device__ __forceinline__ void gemm_phase(PG8_LAS unsigned char* lds, const Gemm g, const Sched& S, const Epi& E) {
    int tid_l = threadIdx.x; asm volatile("" : "+v"(tid_l));
    const int tid = tid_l, wid = __builtin_amdgcn_readfirstlane(tid >> 6), lane = tid & 63, wr = wid >> 2, wc = wid & 3, fr = lane & 15, fq = lane >> 4;
    const int K = g.K, nt = K / BK;
    unsigned voffA[2], voffB[2];
#pragma unroll
    for (int i = 0; i < 2; ++i) { int R, C; stage_rc(tid * 16 + i * 8192, R, C); const int Rb = Epi::PERM ? ((R & ~31) + perm32(R & 31)) : R;
        voffA[i] = (unsigned)(R * K + C) * 2u; voffB[i] = (unsigned)(Rb * K + C) * 2u; }
    const size_t kstep = (size_t)(BK * 2);
    const size_t hstep = (size_t)HALF * K * 2;
    const size_t tstep = 2 * hstep;
    const unsigned ldsw = (unsigned)wid * 1024u;
    const int aoff = lds_byte(wr * 64 + fr, fq * 8), boff = lds_byte(wc * 32 + fr, fq * 8);
#define PG8_SA(b, h) (((b) * 2 + (h)) * HTB)
#define PG8_SB(b, h) ((4 + (b) * 2 + (h)) * HTB)
#define PG8_STAGE(bufoff, gbase, voff) do { _Pragma("unroll") for (int _i = 0; _i < 2; ++_i) \
        __builtin_amdgcn_global_load_lds((const unsigned*)((const char*)(gbase) + (voff)[_i]), (PG8_LAS unsigned*)(lds + (bufoff) + ldsw + _i * 8192), 16, 0, 0); } while (0)
#define PG8_LDA(dst, b, h) do { _Pragma("unroll") for (int m = 0; m < 4; ++m) _Pragma("unroll") for (int k = 0; k < 2; ++k) dst[m][k] = *(const PG8_LAS bf16x8*)(lds + PG8_SA(b, h) + aoff + m * 2048 + k * 1024); } while (0)
#define PG8_LDB(dst, b, h) do { _Pragma("unroll") for (int n = 0; n < 2; ++n) _Pragma("unroll") for (int k = 0; k < 2; ++k) dst[n][k] = *(const PG8_LAS bf16x8*)(lds + PG8_SB(b, h) + boff + n * 2048 + k * 1024); } while (0)
#define PG8_MMA(ai, bj, At, Bt) do { __builtin_amdgcn_s_setprio(1); _Pragma("unroll") for (int m = 0; m < 4; ++m) _Pragma("unroll") for (int n = 0; n < 2; ++n) _Pragma("unroll") for (int k = 0; k < 2; ++k) \
        acc[ai][bj][m][n] = __builtin_amdgcn_mfma_f32_16x16x32_bf16(Bt[n][k], At[m][k], acc[ai][bj][m][n], 0, 0, 0); __builtin_amdgcn_s_setprio(0); } while (0)
#define PG8_WAIT_V(n) asm volatile("s_waitcnt vmcnt(" #n ")" ::: "memory")
#define PG8_WAIT_L(n) asm volatile("s_waitcnt lgkmcnt(" #n ")" ::: "memory")
#define PG8_BAR __builtin_amdgcn_s_barrier()
#define PG8_SCHED __builtin_amdgcn_sched_barrier(0)
    Unit cur, nxt; int ui = 0;
    if (!S.next(0, cur)) return;
    f32x4 acc[2][2][4][2];
#pragma unroll
    for (int a = 0; a < 2; ++a)
#pragma unroll
        for (int b = 0; b < 2; ++b)
#pragma unroll
            for (int m = 0; m < 4; ++m)
#pragma unroll
                for (int n = 0; n < 2; ++n) acc[a][b][m][n] = (f32x4){0.f, 0.f, 0.f, 0.f};
    bf16x8 At[4][2], B0[2][2], B1[2][2];
    const char* cA = (const char*)g.A + (size_t)cur.pm * tstep; const char* cB = (const char*)g.Bt + (size_t)cur.pn * tstep;
    S.a_ready(cur);
    if constexpr (SP2) {
        PG8_STAGE(PG8_SB(0, 0), cB, voffB); PG8_STAGE(PG8_SB(0, 1), cB + hstep, voffB); PG8_STAGE(PG8_SA(0, 0), cA, voffA); PG8_STAGE(PG8_SA(0, 1), cA + hstep, voffA);
        if (wr == 1) PG8_BAR;
        PG8_WAIT_V(2); PG8_BAR;
        PG8_STAGE(PG8_SB(1, 0), cB + kstep, voffB); PG8_STAGE(PG8_SA(1, 0), cA + kstep, voffA); PG8_STAGE(PG8_SB(1, 1), cB + hstep + kstep, voffB);
        PG8_WAIT_V(6); PG8_BAR;
    } else {
        PG8_STAGE(PG8_SB(0, 0), cB, voffB); PG8_STAGE(PG8_SA(0, 0), cA, voffA); PG8_STAGE(PG8_SB(0, 1), cB + hstep, voffB); PG8_STAGE(PG8_SA(0, 1), cA + hstep, voffA);
        if (wr == 1) PG8_BAR;
        PG8_WAIT_V(4); PG8_BAR;
        PG8_STAGE(PG8_SB(1, 0), cB + kstep, voffB); PG8_STAGE(PG8_SA(1, 0), cA + kstep, voffA); PG8_STAGE(PG8_SB(1, 1), cB + hstep + kstep, voffB);
        PG8_WAIT_V(6); PG8_BAR;
    }
    for (;;) {
        const bool has_next = S.next(ui + 1, nxt);
        const char* nA = has_next ? (const char*)g.A + (size_t)nxt.pm * tstep : cA; const char* nB = has_next ? (const char*)g.Bt + (size_t)nxt.pn * tstep : cB;
        for (int t = 0; t < nt; t += 2) {
            const bool last = (t == nt - 2);
            const char* a1 = cA + (size_t)(t + 1) * kstep;
            const char* a2 = last ? nA : cA + (size_t)(t + 2) * kstep; const char* b2 = last ? nB : cB + (size_t)(t + 2) * kstep;
            const char* a3 = a2 + kstep; const char* b3 = b2 + kstep;
            if (last && has_next) S.a_ready(nxt);
            if constexpr (SP2) {
            PG8_LDB(B0, 0, 0); PG8_LDB(B1, 0, 1); PG8_SCHED; PG8_LDA(At, 0, 0); PG8_STAGE(PG8_SA(1, 1), a1 + hstep, voffA);
            PG8_WAIT_V(8); PG8_WAIT_L(0); PG8_BAR; PG8_MMA(0, 0, At, B0); PG8_MMA(0, 1, At, B1); PG8_BAR; PG8_SCHED;
            PG8_LDA(At, 0, 1); PG8_STAGE(PG8_SB(0, 0), b2, voffB); PG8_STAGE(PG8_SB(0, 1), b2 + hstep, voffB); PG8_STAGE(PG8_SA(0, 0), a2, voffA);
            PG8_WAIT_V(8); PG8_WAIT_L(0); PG8_BAR; PG8_MMA(1, 0, At, B0); PG8_MMA(1, 1, At, B1); PG8_BAR; PG8_SCHED;
            PG8_LDB(B0, 1, 0); PG8_LDB(B1, 1, 1); PG8_SCHED; PG8_LDA(At, 1, 0); PG8_STAGE(PG8_SA(0, 1), a2 + hstep, voffA);
            PG8_WAIT_V(8); PG8_WAIT_L(0); PG8_BAR; PG8_MMA(0, 0, At, B0); PG8_MMA(0, 1, At, B1); PG8_BAR; PG8_SCHED;
            PG8_LDA(At, 1, 1); PG8_STAGE(PG8_SB(1, 0), b3, voffB); PG8_STAGE(PG8_SB(1, 1), b3 + hstep, voffB); PG8_STAGE(PG8_SA(1, 0), a3, voffA);
            PG8_WAIT_V(8); PG8_WAIT_L(0); PG8_BAR; PG8_MMA(1, 0, At, B0); PG8_MMA(1, 1, At, B1); PG8_BAR; PG8_SCHED;
            } else {
            PG8_LDB(B0, 0, 0); PG8_SCHED; PG8_LDA(At, 0, 0); PG8_STAGE(PG8_SA(1, 1), a1 + hstep, voffA);
            PG8_WAIT_L(8); PG8_BAR; PG8_WAIT_L(0); PG8_MMA(0, 0, At, B0); PG8_BAR; PG8_SCHED;
            PG8_LDB(B1, 0, 1); PG8_STAGE(PG8_SB(0, 0), b2, voffB);
            PG8_BAR; PG8_WAIT_L(0); PG8_MMA(0, 1, At, B1); PG8_BAR;
            PG8_LDA(At, 0, 1); PG8_STAGE(PG8_SA(0, 0), a2, voffA);
            PG8_BAR; PG8_WAIT_L(0); PG8_MMA(1, 0, At, B0); PG8_BAR; PG8_SCHED;
            PG8_STAGE(PG8_SB(0, 1), b2 + hstep, voffB);
            PG8_WAIT_V(6); PG8_BAR; PG8_MMA(1, 1, At, B1); PG8_BAR;
            PG8_LDB(B0, 1, 0); PG8_SCHED; PG8_LDA(At, 1, 0); PG8_STAGE(PG8_SA(0, 1), a2 + hstep, voffA);
            PG8_WAIT_L(8); PG8_BAR; PG8_WAIT_L(0); PG8_MMA(0, 0, At, B0); PG8_BAR; PG8_SCHED;
            PG8_LDB(B1, 1, 1); PG8_STAGE(PG8_SB(1, 0), b3, voffB);
            PG8_BAR; PG8_WAIT_L(0); PG8_MMA(0, 1, At, B1); PG8_BAR;
            PG8_LDA(At, 1, 1); PG8_STAGE(PG8_SA(1, 0), a3, voffA);
            PG8_BAR; PG8_WAIT_L(0); PG8_MMA(1, 0, At, B0); PG8_BAR; PG8_SCHED;
            PG8_STAGE(PG8_SB(1, 1), b3 + hstep, voffB);
            PG8_WAIT_V(6); PG8_BAR; PG8_MMA(1, 1, At, B1); PG8_BAR;
            }
        }
        if constexpr (ALIGN_EPI) { if (wr == 0) PG8_BAR; }
        if constexpr (!Epi::AFTER_DRAIN) { E(acc, cur, wr, wc, fr, fq); S.done(cur); }
        if (!has_next) break;
#pragma unroll
        for (int a = 0; a < 2; ++a)
#pragma unroll
            for (int b = 0; b < 2; ++b)
#pragma unroll
                for (int m = 0; m < 4; ++m)
#pragma unroll
                    for (int n = 0; n < 2; ++n) acc[a][b][m][n] = (f32x4){0.f, 0.f, 0.f, 0.f};
        cur = nxt; cA = nA; cB = nB; ++ui;
        if constexpr (ALIGN_EPI) { if (wr == 1) PG8_BAR; }
    }
    PG8_WAIT_V(0);
    if constexpr (!ALIGN_EPI) { if (wr == 0) PG8_BAR; }
    PG8_BAR;
    if constexpr (Epi::AFTER_DRAIN) { E.fused(acc, cur, wr, wc, fr, fq, lds, wid, lane); S.done(cur); }
#undef PG8_SA
#undef PG8_SB
#undef PG8_STAGE
#undef PG8_LDA
#undef PG8_LDB
#undef PG8_MMA
#undef PG8_WAIT_V
#undef PG8_WAIT_L
#undef PG8_BAR
#undef PG8_SCHED
}
}

#define GAS __attribute__((address_space(1)))
#define LAS __attribute__((address_space(3)))
#define DI __device__ __forceinline__
typedef unsigned short bf16;
typedef unsigned v4u __attribute__((ext_vector_type(4)));
typedef unsigned v2u __attribute__((ext_vector_type(2)));
typedef float f32x4 __attribute__((ext_vector_type(4)));
typedef short bf16x8 __attribute__((ext_vector_type(8)));
typedef short s16x4 __attribute__((ext_vector_type(4)));
typedef GAS unsigned gu32;
typedef GAS unsigned long long gu64;
#define RLX_AGENT __ATOMIC_RELAXED, __HIP_MEMORY_SCOPE_AGENT
#define LDS_WAIT() asm volatile("s_waitcnt lgkmcnt(0)" ::: "memory")
#define VM_WAIT() asm volatile("s_waitcnt vmcnt(0)" ::: "memory")
DI unsigned f2bf(float f) { unsigned u = __builtin_bit_cast(unsigned, f); return (u + 0x7fffu + ((u >> 16) & 1u)) >> 16; }
__device__ __forceinline__ unsigned pk2(float lo, float hi) { return f2bf(lo) | (f2bf(hi) << 16); }

#define XB_TMO      128
#define XB_XCNT(j)  (256  + 64 * (j))
#define XB_XSUB(j)  (1280 + 64 * (j))
#define XB_XGEN(j)  (2304 + 64 * (j))
#define XB_TOP      3328
#define XB_TOPGEN   3392
#define XCD_BAR_WORDS 3456
#define XB_SPIN_CAP (1u << 18)

__device__ __forceinline__ unsigned xb_ld(unsigned* p)              { return __hip_atomic_load(p, __ATOMIC_RELAXED, __HIP_MEMORY_SCOPE_AGENT); }
__device__ __forceinline__ unsigned xb_add(unsigned* p, unsigned v) { return __hip_atomic_fetch_add(p, v, __ATOMIC_RELAXED, __HIP_MEMORY_SCOPE_AGENT); }
__device__ __forceinline__ unsigned xb_xcc_id() { return (unsigned)__builtin_amdgcn_s_getreg((3 << 11) | 20) & 0xFu; }
#define XB_SPIN(cond, bar) do { unsigned _sp = 0; while (cond) { __builtin_amdgcn_s_sleep(1); \
    if ((++_sp & 255u) == 0u) { if (xb_ld(&(bar)[XB_TMO])) break; if (_sp > XB_SPIN_CAP) { atomicAdd(&(bar)[XB_TMO], 1u); break; } } } } while (0)

struct XcdBarrier {
    unsigned* bar; unsigned x;
    volatile LAS unsigned* st;
};

__device__ __forceinline__ XcdBarrier xcd_barrier_post(unsigned* bar, volatile LAS unsigned* st) {
    XcdBarrier b; b.bar = bar; b.x = xb_xcc_id(); b.st = st;
    if (threadIdx.x == 0) (void)xb_add(&bar[XB_XCNT(b.x)], 1u);
    return b;
}
__device__ __forceinline__ void xcd_barrier_complete(unsigned* bar, unsigned x, unsigned& nloc, unsigned& nx) {
    const unsigned G = gridDim.x * gridDim.y * gridDim.z;
    unsigned sum, cnt, mine, sp = 0u;
    for (;;) {
        sum = 0u; cnt = 0u; mine = 0u;
#pragma unroll 1
        for (unsigned j = 0; j < 16; ++j) { const unsigned c = xb_ld(&bar[XB_XCNT(j)]); sum += c; cnt += (c > 0u) ? 1u : 0u; mine = (j == x) ? c : mine; }
        if (sum == G) break;
        __builtin_amdgcn_s_sleep(1);
        if ((++sp & 255u) == 0u) { if (xb_ld(&bar[XB_TMO])) break; if (sp > XB_SPIN_CAP) { atomicAdd(&bar[XB_TMO], 1u); break; } }
    }
    nloc = mine > 0u ? mine : 1u; nx = cnt > 0u ? cnt : 1u;
}

__device__ __forceinline__ void xcd_barrier(const XcdBarrier& b) {
    asm volatile("s_waitcnt vmcnt(0)" ::: "memory");
    __syncthreads();
    if (threadIdx.x == 0) {
        unsigned* bar = b.bar;
        __builtin_amdgcn_s_waitcnt(0);
        unsigned nloc = b.st[0], nx = b.st[1];
        if (nloc == 0u) { xcd_barrier_complete(bar, b.x, nloc, nx); b.st[0] = nloc; b.st[1] = nx; }
        const unsigned old = xb_add(&bar[XB_XSUB(b.x)], 1u);
        const unsigned gen = old / nloc;
        if (old + 1u == (gen + 1u) * nloc) {
            __builtin_amdgcn_fence(__ATOMIC_RELEASE, "agent");
            asm volatile("s_waitcnt vmcnt(0)" ::: "memory");
            const unsigned og = xb_add(&bar[XB_TOP], 1u);
            const unsigned tg = og / nx;
            if (og + 1u == (tg + 1u) * nx) xb_add(&bar[XB_TOPGEN], 1u);
            else XB_SPIN(xb_ld(&bar[XB_TOPGEN]) == tg, bar);
            __builtin_amdgcn_fence(__ATOMIC_ACQUIRE, "agent");
            xb_add(&bar[XB_XGEN(b.x)], 1u);
            asm volatile("s_waitcnt vmcnt(0)" ::: "memory");
        } else {
            XB_SPIN(xb_ld(&bar[XB_XGEN(b.x)]) == gen, bar);
            __builtin_amdgcn_fence(__ATOMIC_ACQUIRE, "agent");
            asm volatile("s_waitcnt vmcnt(0)" ::: "memory");
        }
    }
    __syncthreads();
}

constexpr int BATCH = 2, SEQ = 4096, DM = 4096, DEPTH = 4, MTOK = BATCH * SEQ;
constexpr int DIN = 13328;
constexpr int NPJ = 13568;
constexpr int C_RQ = 0, C_RK = 1024, C_RV = 2048, C_RG = 3072, C_MQ = 4096, C_MK = 5120, C_MV = 6144, C_MG = 7168, C_SZ = 8192, C_SX = 9216, C_LX = 11264, C_LG = 12288, C_DT = 13312;
constexpr float EPS = 1e-6f;
constexpr int NWAVES = 8, NTHR = 512;
constexpr int NPHASE = 2 + 5 * DEPTH;

constexpr size_t MiB = 1u << 20;
constexpr size_t WS_CTL = 0, CTL_ZERO_BYTES = 1 * MiB;
constexpr size_t WS_SSQ = 2 * MiB, WS_LRUW = 4 * MiB, WS_KMEAN = 6 * MiB, WS_DT = 7 * MiB, WS_DTRAW = 8 * MiB, WS_DACS = 9 * MiB, WS_HEND = 10 * MiB, WS_AEND = 11 * MiB, WS_CARRY = 12 * MiB;
constexpr size_t WS_WIN = 16 * MiB, WIN_LAYER = (size_t)NPJ * DM * 2;
constexpr size_t WS_WOUT = 440 * MiB, WOUT_LAYER = (size_t)DM * DM * 2;
constexpr size_t WS_X = 568 * MiB, WS_XB = 696 * MiB, WS_P = 760 * MiB, WS_Y = 972 * MiB, WS_RU = 1036 * MiB, WS_RS = 1068 * MiB, WS_XBC = 1084 * MiB, WS_SST = 1116 * MiB, WS_SHP = 1132 * MiB,
                 WS_HLOC = 1140 * MiB, WS_ACUM = 1172 * MiB, WS_END = 1204 * MiB;
static_assert(WS_WIN + 4 * WIN_LAYER <= WS_WOUT && WS_P + (size_t)MTOK * NPJ * 2 <= WS_Y, "ws map");
constexpr int CW_BAR = 4096;
constexpr int CW_WQ = 16384;

constexpr int RING_BYTES = 131072, LDSCTL_OFF = RING_BYTES, MISC_OFF = LDSCTL_OFF + 320, LDS_BYTES = 147456;
constexpr int SB256 = 528, SB128 = 272;

struct Args { const float* in[19]; float* out; unsigned char* ws; int ph_lo, ph_hi; };
struct Frame {
    LAS unsigned char* lds; const Args* a; int z, tid_;
    DI int tid() const { return tid_; }
    DI int lane() const { return tid_ & 63; }
    DI int wave() const { return __builtin_amdgcn_readfirstlane(tid_ >> 6); }
    DI int G() const { return (int)gridDim.x; }
    DI volatile LAS unsigned* MISC() const { return (volatile LAS unsigned*)(lds + MISC_OFF); }
    DI unsigned char* ws() const { return a->ws + z; }
    DI unsigned* ctl() const { return (unsigned*)(a->ws + z + WS_CTL); }
    DI const float* in(int k) const { return a->in[k] + z; }
    DI float* out() const { return a->out + z; }
#define FV(T, name, off) DI T* name() const { return (T*)(a->ws + z + (off)); }
    FV(bf16, WIN, WS_WIN) FV(bf16, WOUT, WS_WOUT) FV(bf16, XB, WS_XB) FV(bf16, P, WS_P) FV(bf16, Y, WS_Y) FV(bf16, RS, WS_RS) FV(bf16, XBC, WS_XBC) FV(bf16, SHP, WS_SHP) FV(bf16, LRUW, WS_LRUW)
    FV(float, X, WS_X) FV(float, SSQ, WS_SSQ) FV(bf16, KMH, WS_KMEAN) FV(bf16, KML, WS_KMEAN + 65536) FV(float, KMX, WS_KMEAN + 131072) FV(float, DT, WS_DT) FV(float, DTRAW, WS_DTRAW) FV(float, DACS, WS_DACS) FV(float, HEND, WS_HEND) FV(float, AEND, WS_AEND)
    FV(float, CARRY, WS_CARRY) FV(bf16, RU, WS_RU) FV(float, SST, WS_SST) FV(bf16, HLOC, WS_HLOC) FV(bf16, ACUM, WS_ACUM)
#undef FV
};

DI Frame mk_frame(LAS unsigned char* lds, const Args* a) { Frame F; F.lds = lds; F.a = a; int z = 0; asm volatile("" : "+s"(z)); int t = (int)threadIdx.x; asm volatile("" : "+v"(t)); F.z = z; F.tid_ = t; return F; }
DI float bf_lo(unsigned u) { return __uint_as_float(u << 16); }
DI float bf_hi(unsigned u) { return __uint_as_float(u & 0xffff0000u); }
typedef float f32x2_t __attribute__((ext_vector_type(2))); typedef __bf16 bf16x2_t __attribute__((ext_vector_type(2)));
DI unsigned pkbf(float lo, float hi) { f32x2_t v = {lo, hi}; bf16x2_t b = __builtin_convertvector(v, bf16x2_t); return __builtin_bit_cast(unsigned, b); }
DI float wave_sum(float v) {
#pragma unroll
    for (int o = 1; o < 64; o <<= 1) v += __shfl_xor(v, o);
    return v;
}
DI float sigm(float x) { return __builtin_amdgcn_rcpf(1.f + __expf(-x)); }
DI float silu(float x) { return x * __builtin_amdgcn_rcpf(1.f + __expf(-x)); }
DI float one_minus_exp(float x) { const float p = -x * (1.0f + x * (0.5f + x * (0.16666667f + x * (0.041666668f + x * 0.008333334f)))); return x > -0.25f ? p : 1.0f - __expf(x); }
DI float softplus(float x) { return x > 20.f ? x : log1pf(__expf(x)); }
DI f32x4 mfma16(bf16x8 a, bf16x8 b, f32x4 c) { return __builtin_amdgcn_mfma_f32_16x16x32_bf16(a, b, c, 0, 0, 0); }
DI void unpack8(const v4u v, float (&f)[8]) { f[0] = bf_lo(v.x); f[1] = bf_hi(v.x); f[2] = bf_lo(v.y); f[3] = bf_hi(v.y); f[4] = bf_lo(v.z); f[5] = bf_hi(v.z); f[6] = bf_lo(v.w); f[7] = bf_hi(v.w); }
DI v4u pack8(const float (&f)[8]) { v4u v; v.x = pkbf(f[0], f[1]); v.y = pkbf(f[2], f[3]); v.z = pkbf(f[4], f[5]); v.w = pkbf(f[6], f[7]); return v; }
DI bf16x8 pack8f(const float (&f)[8]) { return __builtin_bit_cast(bf16x8, pack8(f)); }
DI bf16x8 frag_row(const LAS unsigned char* t, int sb, int r0, int k0, int lane) { return *(const LAS bf16x8*)(t + (r0 + (lane & 15)) * sb + (k0 + 8 * (lane >> 4)) * 2); }
typedef short v4i16_t __attribute__((ext_vector_type(4)));
DI bf16x8 frag_tr(const LAS unsigned char* t, int sb, int ra, int rb, int c0, int lane) {
    const int q = (lane & 15) >> 2, p = lane & 3;
    const s16x4 lo = __builtin_bit_cast(s16x4, __builtin_amdgcn_ds_read_tr16_b64_v4i16((LAS v4i16_t*)(t + (ra + q) * sb + (c0 + 4 * p) * 2)));
    const s16x4 hi = __builtin_bit_cast(s16x4, __builtin_amdgcn_ds_read_tr16_b64_v4i16((LAS v4i16_t*)(t + (rb + q) * sb + (c0 + 4 * p) * 2)));
    bf16x8 r; r[0] = lo[0]; r[1] = lo[1]; r[2] = lo[2]; r[3] = lo[3]; r[4] = hi[0]; r[5] = hi[1]; r[6] = hi[2]; r[7] = hi[3]; return r;
}
template <int COLS> DI void stage_bf16(LAS unsigned char* dst, int sb, const bf16* src, size_t gp, int rows, int tid) {
    constexpr int CPR = COLS / 8; const int total = rows * CPR;
    for (int c = tid; c < total; c += NTHR) { const int r = c / CPR, ch = c % CPR; const v4u v = *(const v4u*)(src + (size_t)r * gp + ch * 8); *(LAS v4u*)(dst + r * sb + ch * 16) = v; }
}
DI unsigned wq_issue(Frame& F, int ctr) { unsigned v = 0u; if (F.tid() == 0) v = __hip_atomic_fetch_add(F.ctl() + CW_WQ + 64 * ctr, 1u, RLX_AGENT); return v; }
DI int wq_publish(Frame& F, unsigned v) { __syncthreads(); if (F.tid() == 0) F.MISC()[0] = v; __syncthreads(); return __builtin_amdgcn_readfirstlane((int)F.MISC()[0]); }
DI int next_unit(Frame& F, int ctr) {
    __syncthreads();
    if (F.tid() == 0) F.MISC()[0] = __hip_atomic_fetch_add(F.ctl() + CW_WQ + 64 * ctr, 1u, RLX_AGENT);
    __syncthreads();
    return __builtin_amdgcn_readfirstlane((int)F.MISC()[0]);
}

namespace pg8 {
struct EpiProj {
    static constexpr bool PERM = true, AFTER_DRAIN = false;
    bf16_t* O; float* dtraw; const float* ssq;
    const PG8_LAS float* rtab; int fm;
    __device__ __forceinline__ void operator()(const f32x4 (&acc)[2][2][4][2], const Unit& u, int wr, int wc, int fr, int fq) const {
        asm volatile("" : "+v"(fr), "+v"(fq));
        const int row0 = u.pm * BM + wr * 64 + fr;
        const bool dt_tile = u.pn >= 52;
        const int col0 = u.pn * BM + wc * 32 + 8 * fq;
        const bool tab = rtab != nullptr && (unsigned)(u.pm - fm) < 8u;
        float rs[2][4];
        if (tab) { const PG8_LAS float* t = rtab + (u.pm - fm) * BM + wr * 64 + fr;
#pragma unroll
            for (int ai = 0; ai < 2; ++ai)
#pragma unroll
                for (int m = 0; m < 4; ++m) rs[ai][m] = t[ai * HALF + m * 16];
        } else { f32x4 pv[2][4];
#pragma unroll
            for (int ai = 0; ai < 2; ++ai)
#pragma unroll
                for (int m = 0; m < 4; ++m) pv[ai][m] = *(const f32x4*)(ssq + (size_t)(row0 + ai * HALF + m * 16) * 16 + 4 * fq);
#pragma unroll
            for (int ai = 0; ai < 2; ++ai)
#pragma unroll
                for (int m = 0; m < 4; ++m) { float s = (pv[ai][m][0] + pv[ai][m][1]) + (pv[ai][m][2] + pv[ai][m][3]); s += __shfl_xor(s, 16); s += __shfl_xor(s, 32); rs[ai][m] = rsqrtf(s * (1.0f / 4096.0f) + 1e-6f); } }
#pragma unroll
        for (int ai = 0; ai < 2; ++ai)
#pragma unroll
            for (int m = 0; m < 4; ++m) { const int r = row0 + ai * HALF + m * 16; const float s = rs[ai][m];
                if (!dt_tile) { bf16_t* rowp = O + (size_t)r * 13568 + col0;
#pragma unroll
                    for (int bj = 0; bj < 2; ++bj) { const f32x4 v0 = acc[ai][bj][m][0] * s, v1 = acc[ai][bj][m][1] * s;
                        u32x4 w; w.x = cvt_pk_bf16(v0[0], v0[1]); w.y = cvt_pk_bf16(v0[2], v0[3]); w.z = cvt_pk_bf16(v1[0], v1[1]); w.w = cvt_pk_bf16(v1[2], v1[3]);
                        *(u32x4*)(rowp + bj * HALF) = w; }
                } else if (wc == 0 && fq < 2) { float* rowp = dtraw + (size_t)r * 16 + 8 * fq; *(f32x4*)(rowp) = acc[ai][0][m][0] * s; *(f32x4*)(rowp + 4) = acc[ai][0][m][1] * s; } }
    }
};
struct EpiOut {
    static constexpr bool PERM = false, AFTER_DRAIN = false;
    bf16_t* xb; float* ssq; PG8_LAS float* red;
    __device__ __forceinline__ void operator()(const f32x4 (&acc)[2][2][4][2], const Unit& u, int wr, int wc, int fr, int fq) const {
        asm volatile("" : "+v"(fr), "+v"(fq));
        const int row0 = u.pm * BM + wr * 64 + fr, col0 = u.pn * BM + wc * 32 + 4 * fq;
#pragma unroll
        for (int ai = 0; ai < 2; ++ai) {
            unsigned long long xo[4][2][2];
#pragma unroll
            for (int m = 0; m < 4; ++m)
#pragma unroll
                for (int bj = 0; bj < 2; ++bj)
#pragma unroll
                    for (int n = 0; n < 2; ++n) xo[m][bj][n] = *(const unsigned long long*)(xb + (size_t)(row0 + ai * HALF + m * 16) * 4096 + col0 + bj * HALF + n * 16);
#pragma unroll
            for (int m = 0; m < 4; ++m) { const int r = row0 + ai * HALF + m * 16; const size_t off = (size_t)r * 4096 + col0; float ss = 0.f;
#pragma unroll
                for (int bj = 0; bj < 2; ++bj)
#pragma unroll
                    for (int n = 0; n < 2; ++n) { const unsigned lo = (unsigned)xo[m][bj][n], hi = (unsigned)(xo[m][bj][n] >> 32);
                        f32x4 o = acc[ai][bj][m][n]; o[0] += __uint_as_float(lo << 16); o[1] += __uint_as_float(lo & 0xffff0000u); o[2] += __uint_as_float(hi << 16); o[3] += __uint_as_float(hi & 0xffff0000u);
                        ss += (o[0] * o[0] + o[1] * o[1]) + (o[2] * o[2] + o[3] * o[3]);
                        const unsigned w0 = cvt_pk_bf16(o[0], o[1]), w1 = cvt_pk_bf16(o[2], o[3]);
                        *(unsigned long long*)(xb + off + bj * HALF + n * 16) = (unsigned long long)w0 | ((unsigned long long)w1 << 32); }
                ss += __shfl_xor(ss, 16); ss += __shfl_xor(ss, 32);
                if (fq == 0) red[(ai * HALF + wr * 64 + m * 16 + fr) * 4 + wc] = ss; }
            asm volatile("" ::: "memory"); }
        asm volatile("s_waitcnt lgkmcnt(0)" ::: "memory"); __builtin_amdgcn_s_barrier(); asm volatile("" ::: "memory");
        { const int t = (wr * 4 + wc) * 64 + fq * 16 + fr;
          if (t < 256) { const f32x4 p4 = *(const PG8_LAS f32x4*)(red + t * 4); ssq[(size_t)(u.pm * BM + t) * 16 + u.pn] = (p4[0] + p4[1]) + (p4[2] + p4[3]); } }
    }
};
struct RemapOrder : StaticOrder {
    __device__ __forceinline__ bool next(int i, Unit& u) const { if (!StaticOrder::next(i, u)) return false; if (u.pn == 35) u.pn = 52; return true; }
};
struct OneUnit {
    int pm, pn;
    __device__ __forceinline__ bool next(int i, Unit& u) const { if (i != 0) return false; u.pm = pm; u.pn = pn; return true; }
    __device__ __forceinline__ void a_ready(const Unit&) const {}
    __device__ __forceinline__ void done(const Unit&) const {}
};
}

DI int map_in_col(int n) { return n < 11264 ? n : (n < 11280 ? C_DT + (n - 11264) : n - 16); }
constexpr int TR_SB = 272;
struct TrItem { const float* W; const float* ks; bf16* WT; int N, k0, n0, is_in; };
constexpr int TR_NB_IN = (DIN + 127) / 128, TR_I_IN = 32 * TR_NB_IN, TR_I_OUT = 32 * 32, TR_I_L = TR_I_IN + TR_I_OUT;
DI bool tr_item(Frame& F, int l, int r, TrItem& t) {
    constexpr int NB_IN = TR_NB_IN, I_IN = TR_I_IN;
    if (r >= TR_I_L) return false;
    if (r < I_IN) { t.W = F.in(2) + (size_t)l * DM * DIN; t.ks = F.in(1) + l * DM; t.WT = F.WIN() + (size_t)l * NPJ * DM; t.N = DIN; t.k0 = 128 * (r / NB_IN); t.n0 = 128 * (r % NB_IN); t.is_in = 1; }
    else { const int q = r - I_IN; t.W = F.in(17) + (size_t)l * DM * DM; t.ks = nullptr; t.WT = F.WOUT() + (size_t)l * DM * DM; t.N = DM; t.k0 = 128 * (q / 32); t.n0 = 128 * (q % 32); t.is_in = 0; }
    return true;
}
DI void tr_load(const TrItem& t, int tid, f32x4 (&v)[8]) {
    const int c4 = tid & 31, n = t.n0 + 4 * c4; const bool ok = n < t.N;
#pragma unroll
    for (int p = 0; p < 8; ++p) { const int k = t.k0 + p * 16 + (tid >> 5); f32x4 x = ok ? *(const f32x4*)(t.W + (size_t)k * t.N + n) : (f32x4){0.f, 0.f, 0.f, 0.f}; if (t.ks) x *= t.ks[k]; v[p] = x; }
}
DI void tr_step(Frame& F, const TrItem& cur, f32x4 (&v)[8], int l, int r_next, TrItem& nxt, bool& hn, LAS unsigned char* tile, int tid, int lane, int w) {
    const int gq = lane >> 4, l15 = lane & 15, c4 = tid & 31;
    __syncthreads();
#pragma unroll
    for (int p = 0; p < 8; ++p) { const int kr = p * 16 + (tid >> 5); v2u o; o.x = pkbf(v[p][0], v[p][1]); o.y = pkbf(v[p][2], v[p][3]); *(LAS v2u*)(tile + kr * TR_SB + c4 * 8) = o; }
    __syncthreads();
    hn = tr_item(F, l, r_next, nxt);
    if (hn) tr_load(nxt, tid, v);
    const int n = cur.n0 + 16 * w + l15; const bool okn = n < cur.N; const int row = cur.is_in ? map_in_col(okn ? n : 0) : n; bf16* dst = cur.WT + (size_t)row * DM + cur.k0 + 8 * gq;
#pragma unroll
    for (int ks = 0; ks < 4; ++ks) { const bf16x8 f = frag_tr(tile, TR_SB, 32 * ks + 8 * gq, 32 * ks + 8 * gq + 4, 16 * w, lane); if (okn) *(bf16x8*)(dst + 32 * ks) = f; }
}
DI void tr_unit(Frame& F, int l, int r0, int cnt) {
    const int tid = F.tid(), lane = F.lane(), w = F.wave();
    TrItem ia, ib, dummy; f32x4 va[8], vb[8]; bool hn;
    tr_item(F, l, r0, ia); tr_item(F, l, r0 + 1, ib);
    tr_load(ia, tid, va); tr_load(ib, tid, vb);
    tr_step(F, ia, va, l, TR_I_L, dummy, hn, F.lds, tid, lane, w);
    tr_step(F, ib, vb, l, TR_I_L, dummy, hn, F.lds, tid, lane, w);
    __syncthreads();
}
DI void p0_prologue(Frame& F) {
    const int tid = F.tid(), lane = F.lane(), w = F.wave();
    LAS unsigned char* tile = F.lds;
    TrItem ia, ib; f32x4 va[8], vb[8];
    int it = blockIdx.x; const int G = F.G();
#define P0_IDX(i) ((i) < TR_I_IN ? (i) : TR_I_L)
    bool ha = tr_item(F, 0, P0_IDX(it), ia), hb = tr_item(F, 0, P0_IDX(it + G), ib);
    if (ha) tr_load(ia, tid, va);
    if (hb) tr_load(ib, tid, vb);
    while (ha) {
        TrItem na; bool hna;
        tr_step(F, ia, va, 0, P0_IDX(it + 2 * G), na, hna, tile, tid, lane, w);
        if (!hb) break;
        TrItem nb; bool hnb;
        tr_step(F, ib, vb, 0, P0_IDX(it + 3 * G), nb, hnb, tile, tid, lane, w);
        ia = na; ha = hna; ib = nb; hb = hnb; it += 2 * G;
    }
    const int gw = blockIdx.x * NWAVES + w, NGW = F.G() * NWAVES;
    for (int i = blockIdx.x * NTHR + tid; i < DEPTH * 240 * (DM / 8); i += F.G() * NTHR) { const int l = i / (240 * (DM / 8)), r = i % (240 * (DM / 8));
        *(v4u*)(F.WIN() + (size_t)l * NPJ * DM + (size_t)(C_DT + 16) * DM + (size_t)r * 8) = (v4u){0u, 0u, 0u, 0u}; }
    for (int i = blockIdx.x * NTHR + tid; i < DEPTH * 2 * 8 * 128 * 128; i += F.G() * NTHR) { const int d = i & 127, e = (i >> 7) & 127, nb = (i >> 14) & 7, gate = (i >> 17) & 1, l = i >> 18;
        const float* wp = (gate ? F.in(14) : F.in(12)) + ((size_t)(l * 8 + nb) * 128 + d) * 128 + e; F.LRUW()[i] = (bf16)f2bf(*wp); }
    for (int m = gw; m < MTOK; m += NGW) { const f32x4* xr = (const f32x4*)(F.in(0) + (size_t)m * DM) + lane; float ss = 0.f;
#pragma unroll
        for (int j = 0; j < 16; ++j) { const f32x4 x = xr[64 * j]; ss += (x[0] * x[0] + x[1] * x[1]) + (x[2] * x[2] + x[3] * x[3]);
            const unsigned long long o = (unsigned long long)pkbf(x[0], x[1]) | ((unsigned long long)pkbf(x[2], x[3]) << 32); *((unsigned long long*)(F.XB() + (size_t)m * DM) + 64 * j + lane) = o; }
        ss = wave_sum(ss); if (lane < 16) F.SSQ()[(size_t)m * 16 + lane] = lane == 0 ? ss : 0.f; }
}
DI void p_final(Frame& F) {
    const int gw = blockIdx.x * NWAVES + F.wave(), NGW = F.G() * NWAVES, lane = F.lane(); const float* fw = F.in(18);
    for (int m = gw; m < MTOK; m += NGW) { float ss = F.SSQ()[(size_t)m * 16 + (lane & 15)]; ss += __shfl_xor(ss, 1); ss += __shfl_xor(ss, 2); ss += __shfl_xor(ss, 4); ss += __shfl_xor(ss, 8); const float rs = rsqrtf(ss * (1.0f / 4096.0f) + EPS);
        const v4u* xr = (const v4u*)(F.XB() + (size_t)m * DM) + lane; f32x4* o = (f32x4*)(F.out() + (size_t)m * DM) + 2 * lane; const f32x4* wv = (const f32x4*)fw + 2 * lane;
#pragma unroll
        for (int j = 0; j < 8; ++j) { float x[8]; unpack8(xr[64 * j], x); const f32x4 w0 = wv[128 * j], w1 = wv[128 * j + 1];
            o[128 * j] = (f32x4){x[0] * rs * w0[0], x[1] * rs * w0[1], x[2] * rs * w0[2], x[3] * rs * w0[3]}; o[128 * j + 1] = (f32x4){x[4] * rs * w1[0], x[5] * rs * w1[1], x[6] * rs * w1[2], x[7] * rs * w1[3]}; } }
}

DI int swz(int row) { return ((row & 3) << 2) | ((row >> 2) & 3); }
DI const char* sbase(const void* p) { const char* q = (const char*)p; asm volatile("" : "+s"(q)); return q; }
DI void dma_tile256(const bf16* src, unsigned gp, LAS unsigned char* dst, int w, int lane) {
    const char* sb = sbase(src);
#pragma unroll
    for (int i = 0; i < 4; ++i) { const int idx = w * 4 + i, row = 2 * idx + (lane >> 5), c = (lane & 31) ^ swz(row);
        __builtin_amdgcn_global_load_lds((const unsigned*)(sb + ((unsigned)row * gp + (unsigned)c * 8u) * 2u), (LAS unsigned*)(dst + idx * 1024), 16, 0, 0); }
}
DI bf16x8 frag_tr_sw512(const LAS unsigned char* t, int ra, int rb, int c0, int lane) {
    const int q = (lane & 15) >> 2, p = lane & 3, ch = (c0 >> 3) + (p >> 1), r0 = ra + q, r1 = rb + q;
    const s16x4 lo = __builtin_bit_cast(s16x4, __builtin_amdgcn_ds_read_tr16_b64_v4i16((LAS v4i16_t*)(t + 512 * r0 + 16 * (ch ^ swz(r0)) + 8 * (p & 1))));
    const s16x4 hi = __builtin_bit_cast(s16x4, __builtin_amdgcn_ds_read_tr16_b64_v4i16((LAS v4i16_t*)(t + 512 * r1 + 16 * (ch ^ swz(r1)) + 8 * (p & 1))));
    bf16x8 r; r[0] = lo[0]; r[1] = lo[1]; r[2] = lo[2]; r[3] = lo[3]; r[4] = hi[0]; r[5] = hi[1]; r[6] = hi[2]; r[7] = hi[3]; return r;
}
DI bf16x8 frag_row_sw512(const LAS unsigned char* t, int row, int ch) { return *(const LAS bf16x8*)(t + 512 * row + 16 * (ch ^ swz(row))); }
DI const LAS unsigned char* lptr(unsigned a) { return (const LAS unsigned char*)(uintptr_t)a; }
DI unsigned laddr(const LAS unsigned char* p) { return (unsigned)(uintptr_t)p; }
DI unsigned rowbase512(int row, int gq) { const int sw = swz(row); return 512 * row + 16 * ((gq ^ (sw & 3)) | (sw & 12)); }
DI unsigned rowbase256(int row, int gq) { const int sw = swz(row); return 256 * row + 16 * ((gq ^ (sw & 3)) | (sw & 12)); }
DI unsigned trbase512(int row, int lane) { const int p = lane & 3; return 512 * row + 8 * (p & 1) + 16 * ((p >> 1) ^ swz(row)); }
DI bf16x8 frag_tr2(unsigned a0, unsigned a1, int imm) {
    const s16x4 lo = __builtin_bit_cast(s16x4, __builtin_amdgcn_ds_read_tr16_b64_v4i16((LAS v4i16_t*)(lptr(a0) + imm)));
    const s16x4 hi = __builtin_bit_cast(s16x4, __builtin_amdgcn_ds_read_tr16_b64_v4i16((LAS v4i16_t*)(lptr(a1) + imm)));
    bf16x8 r; r[0] = lo[0]; r[1] = lo[1]; r[2] = lo[2]; r[3] = lo[3]; r[4] = hi[0]; r[5] = hi[1]; r[6] = hi[2]; r[7] = hi[3]; return r;
}
DI void ret_A(Frame& F, int unit) {
    const int c = unit & 15, bh = unit >> 4, h = bh & 3, b = bh >> 2, lane = F.lane(), w = F.wave(), gq = lane >> 4, l15 = lane & 15;
    const size_t t0 = (size_t)b * SEQ + c * 256;
    const bf16* Kp = F.P() + t0 * NPJ + C_RK + h * 256; const bf16* Vp = F.P() + t0 * NPJ + C_RV + h * 256;
    const float lg = log1pf(-exp2f(-5.f - (float)h));
    LAS unsigned char* B0 = F.lds; LAS unsigned char* B1 = F.lds + 65536;
    f32x4 acc[2][16];
#pragma unroll
    for (int a = 0; a < 2; ++a)
#pragma unroll
        for (int v = 0; v < 16; ++v) acc[a][v] = (f32x4){0.f, 0.f, 0.f, 0.f};
    float kd8[8];
#pragma unroll
    for (int e = 0; e < 8; ++e) kd8[e] = __expf(-lg * (float)(8 * gq + e));
    __syncthreads();
    dma_tile256(Kp, NPJ, B0, w, lane); dma_tile256(Vp, NPJ, B0 + 32768, w, lane);
    VM_WAIT(); __syncthreads();
    for (int jt = 0; jt < 4; ++jt) {
        LAS unsigned char* cur = (jt & 1) ? B1 : B0; LAS unsigned char* nxt = (jt & 1) ? B0 : B1;
        if (jt < 3) { dma_tile256(Kp + (size_t)(64 * (jt + 1)) * NPJ, NPJ, nxt, w, lane); dma_tile256(Vp + (size_t)(64 * (jt + 1)) * NPJ, NPJ, nxt + 32768, w, lane); }
        { int lz = lane; asm volatile("" : "+v"(lz)); const int lane = lz, gq = lz >> 4;
#pragma unroll
          for (int ks = 0; ks < 2; ++ks) { const int ra = 32 * ks + 8 * gq, rb = ra + 4;
              const float base = __expf(lg * (float)(255 - (64 * jt + 32 * ks))) * 0.0625f;
              bf16x8 A[2];
#pragma unroll
              for (int dt = 0; dt < 2; ++dt) { float f[8]; unpack8(__builtin_bit_cast(v4u, frag_tr_sw512(cur, ra, rb, 32 * w + 16 * dt, lane)), f);
#pragma unroll
                  for (int e = 0; e < 8; ++e) f[e] *= base * kd8[e];
                  A[dt] = pack8f(f); }
#pragma unroll
              for (int vt = 0; vt < 16; ++vt) { const bf16x8 B = frag_tr_sw512(cur + 32768, ra, rb, 16 * vt, lane); acc[0][vt] = mfma16(A[0], B, acc[0][vt]); acc[1][vt] = mfma16(A[1], B, acc[1][vt]); } } }
        VM_WAIT(); __syncthreads();
    }
    bf16* U = F.RU() + (size_t)unit * 65536;
#pragma unroll
    for (int dt = 0; dt < 2; ++dt)
#pragma unroll
        for (int vt = 0; vt < 16; ++vt) { v2u o; o.x = pkbf(acc[dt][vt][0], acc[dt][vt][1]); o.y = pkbf(acc[dt][vt][2], acc[dt][vt][3]); *(v2u*)(U + (16 * vt + l15) * 256 + 32 * w + 16 * dt + 4 * gq) = o; }
}
DI void ret_B(Frame& F) {
    for (int it = blockIdx.x * NTHR + F.tid(); it < 8 * 16384; it += F.G() * NTHR) { const int bh = it >> 14, e4 = it & 16383, h = bh & 3;
        const float cd = __expf(log1pf(-exp2f(-5.f - (float)h)) * 256.f); f32x4 s = (f32x4){0.f, 0.f, 0.f, 0.f};
        const size_t o0 = (size_t)(bh * 16) * 65536 + (size_t)e4 * 4; const bf16* __restrict__ ru = F.RU() + o0; bf16* __restrict__ rs = F.RS() + o0;
        f32x4 u[15];
#pragma unroll
        for (int c = 0; c < 15; ++c) { const v2u r = *(const v2u*)(ru + (size_t)c * 65536); u[c] = (f32x4){bf_lo(r.x), bf_hi(r.x), bf_lo(r.y), bf_hi(r.y)}; }
#pragma unroll
        for (int c = 0; c < 16; ++c) { *(unsigned long long*)(rs + (size_t)c * 65536) = (unsigned long long)pkbf(s[0], s[1]) | ((unsigned long long)pkbf(s[2], s[3]) << 32);
            if (c < 15) s = s * cd + u[c]; } }
}
DI void ret_C(Frame& F, int l, int unit2) {
    const int half = unit2 & 1, unit = unit2 >> 1, c = unit & 15, bh = unit >> 4, h = bh & 3, b = bh >> 2, lane = F.lane(), w = F.wave(), gq = lane >> 4, l15 = lane & 15;
    const size_t t0 = (size_t)b * SEQ + c * 256;
    const int il = half * 128 + w * 16 + l15;
    const float lg = log1pf(-exp2f(-5.f - (float)h));
    const bf16* St = F.RS() + (size_t)unit * 65536;
    const bf16* Kp = F.P() + t0 * NPJ + C_RK + h * 256; const bf16* Vp = F.P() + t0 * NPJ + C_RV + h * 256;
    LAS unsigned char* B0 = F.lds; LAS unsigned char* B1 = F.lds + 65536;
    if (c > 0) dma_tile256(St, 256, B0, w, lane); else { dma_tile256(Kp, NPJ, B0, w, lane); dma_tile256(Vp, NPJ, B0 + 32768, w, lane); }
    const bf16* Qp = F.P() + (t0 + il) * NPJ + C_RQ + h * 256;
    bf16x8 Q[8];
#pragma unroll
    for (int ks = 0; ks < 8; ++ks) Q[ks] = *(const bf16x8*)(Qp + 32 * ks + 8 * gq);
    f32x4 acc[16];
#pragma unroll
    for (int v = 0; v < 16; ++v) acc[v] = (f32x4){0.f, 0.f, 0.f, 0.f};
    const int njt = 2 * (half + 1);
    unsigned kb0 = rowbase512(8 * (l15 >> 2) + (l15 & 3), gq), kb1 = rowbase512(8 * (l15 >> 2) + (l15 & 3) + 4, gq);
    unsigned vb0 = trbase512(8 * gq + (l15 >> 2), lane), vb1 = trbase512(8 * gq + 4 + (l15 >> 2), lane), sb0 = rowbase512(l15, gq);
    asm volatile("" : "+v"(kb0), "+v"(kb1), "+v"(vb0), "+v"(vb1), "+v"(sb0));
    const int il_lo = half * 128 + w * 16, jdw = il_lo >> 5;
    float gp[8]; const float kb = __expf(-lg * (float)(8 * gq)) * 0.0625f;
#pragma unroll
    for (int e = 0; e < 8; ++e) gp[e] = __builtin_bit_cast(float, __builtin_amdgcn_readfirstlane(__builtin_bit_cast(int, __expf(-lg * (float)e))));
    VM_WAIT(); __syncthreads();
    int par = 0;
    if (c > 0) {
#pragma unroll
        for (int sp = 0; sp < 4; ++sp) {
            LAS unsigned char* cur = (sp & 1) ? B1 : B0; LAS unsigned char* nxt = (sp & 1) ? B0 : B1;
            if (sp < 3) dma_tile256(St + (size_t)(64 * (sp + 1)) * 256, 256, nxt, w, lane); else { dma_tile256(Kp, NPJ, nxt, w, lane); dma_tile256(Vp, NPJ, nxt + 32768, w, lane); }
            const unsigned sA = laddr(cur) + sb0;
#pragma unroll
            for (int ks = 0; ks < 8; ++ks)
#pragma unroll
                for (int vt = 0; vt < 4; ++vt) acc[4 * sp + vt] = mfma16(*(const LAS bf16x8*)(lptr(sA ^ (64 * ks)) + 8192 * vt), Q[ks], acc[4 * sp + vt]);
            VM_WAIT(); __syncthreads();
        }
        const float qd = __expf(lg * (float)(il + 1));
#pragma unroll
        for (int v = 0; v < 16; ++v) acc[v] *= qd;
        par = 0;
    }
    for (int jt = 0; jt < njt; ++jt) {
        LAS unsigned char* cur = ((jt + par) & 1) ? B1 : B0; LAS unsigned char* nxt = ((jt + par) & 1) ? B0 : B1;
        if (jt + 1 < njt) { dma_tile256(Kp + (size_t)(64 * (jt + 1)) * NPJ, NPJ, nxt, w, lane); dma_tile256(Vp + (size_t)(64 * (jt + 1)) * NPJ, NPJ, nxt + 32768, w, lane); }
        if (2 * jt <= jdw) {
            const unsigned cb = laddr(cur), kA0 = cb + kb0, kA1 = cb + kb1, vA0 = cb + 32768 + vb0, vA1 = cb + 32768 + vb1;
#pragma unroll
            for (int js = 0; js < 2; ++js) {
                if (2 * jt + js > jdw) break;
                f32x4 s0 = (f32x4){0.f, 0.f, 0.f, 0.f}, s1 = s0, s0b = s0, s1b = s0;
#pragma unroll
                for (int ks = 0; ks < 8; ks += 2) { s0 = mfma16(*(const LAS bf16x8*)(lptr(kA0 ^ (64 * ks)) + 16384 * js), Q[ks], s0); s1 = mfma16(*(const LAS bf16x8*)(lptr(kA1 ^ (64 * ks)) + 16384 * js), Q[ks], s1);
                    s0b = mfma16(*(const LAS bf16x8*)(lptr(kA0 ^ (64 * ks + 64)) + 16384 * js), Q[ks + 1], s0b); s1b = mfma16(*(const LAS bf16x8*)(lptr(kA1 ^ (64 * ks + 64)) + 16384 * js), Q[ks + 1], s1b); }
                s0 += s0b; s1 += s1b;
                float p[8]; const int jbase = 64 * jt + 32 * js; const float rowf = __expf(lg * (float)(il - jbase)) * kb;
#pragma unroll
                for (int e = 0; e < 8; ++e) { const float sv = (e < 4) ? s0[e & 3] : s1[e & 3]; p[e] = sv * gp[e] * rowf; }
                if (2 * jt + js == jdw) {
#pragma unroll
                    for (int e = 0; e < 8; ++e) p[e] = (il >= jbase + 8 * gq + e) ? p[e] : 0.f; }
                const bf16x8 Pf = pack8f(p);
#pragma unroll
                for (int vt = 0; vt < 16; ++vt) acc[vt] = mfma16(frag_tr2(vA0 ^ (32 * vt), vA1 ^ (32 * vt), 16384 * js), Pf, acc[vt]);
            }
        }
        VM_WAIT(); __syncthreads();
    }
    float ss = 0.f;
#pragma unroll
    for (int v = 0; v < 16; ++v) ss += (acc[v][0] * acc[v][0] + acc[v][1] * acc[v][1]) + (acc[v][2] * acc[v][2] + acc[v][3] * acc[v][3]);
    ss += __shfl_xor(ss, 16); ss += __shfl_xor(ss, 32);
    const float rms = rsqrtf(ss * (1.0f / 256.0f) + EPS);
    const float* gw = F.in(3) + l * 1024 + h * 256; const bf16* Gp = F.P() + (t0 + il) * NPJ + C_RG + h * 256; bf16* Yp = F.Y() + (t0 + il) * DM + 0 + h * 256;
#pragma unroll
    for (int vt = 0; vt < 16; ++vt) { const int v = 16 * vt + 4 * gq; const v2u gv = *(const v2u*)(Gp + v); const f32x4 w4 = *(const f32x4*)(gw + v);
        const float y0 = acc[vt][0] * rms * w4[0] * silu(bf_lo(gv.x)), y1 = acc[vt][1] * rms * w4[1] * silu(bf_hi(gv.x)), y2 = acc[vt][2] * rms * w4[2] * silu(bf_lo(gv.y)), y3 = acc[vt][3] * rms * w4[3] * silu(bf_hi(gv.y));
        v2u o; o.x = pkbf(y0, y1); o.y = pkbf(y2, y3); *(v2u*)(Yp + v) = o; }
}

DI void moba_kmean(Frame& F, int unit) {
    const int blk = unit & 15, bh = unit >> 4, h = bh & 7, b = bh >> 3, tid = F.tid(), ch = tid & 15, rg = tid >> 4;
    const bf16* Kp = F.P() + ((size_t)b * SEQ + blk * 256 + rg) * NPJ + C_MK + h * 128 + ch * 8;
    v4u raw[8];
#pragma unroll
    for (int i = 0; i < 8; ++i) raw[i] = *(const v4u*)(Kp + (size_t)(32 * i) * NPJ);
    float s[8] = {0.f, 0.f, 0.f, 0.f, 0.f, 0.f, 0.f, 0.f}; float r2max = 0.f;
#pragma unroll
    for (int i = 0; i < 8; ++i) { float f[8]; unpack8(raw[i], f); float r2 = 0.f;
#pragma unroll
        for (int e = 0; e < 8; ++e) { s[e] += f[e]; r2 += f[e] * f[e]; }
        r2 += __shfl_xor(r2, 1); r2 += __shfl_xor(r2, 2); r2 += __shfl_xor(r2, 4); r2 += __shfl_xor(r2, 8);
        r2max = fmaxf(r2max, r2); }
    LAS float* red = (LAS float*)F.lds;
    __syncthreads();
    *(LAS f32x4*)(red + rg * 128 + ch * 8) = (f32x4){s[0], s[1], s[2], s[3]}; *(LAS f32x4*)(red + rg * 128 + ch * 8 + 4) = (f32x4){s[4], s[5], s[6], s[7]};
    if (ch == 0) red[4096 + rg] = r2max;
    __syncthreads();
    if (tid < 32) { float m = red[4096 + tid]; m = fmaxf(m, __shfl_xor(m, 1)); m = fmaxf(m, __shfl_xor(m, 2)); m = fmaxf(m, __shfl_xor(m, 4)); m = fmaxf(m, __shfl_xor(m, 8)); m = fmaxf(m, __shfl_xor(m, 16));
        if (tid == 0) F.KMX()[unit] = m; }
    if (tid < 128) { float t = 0.f;
#pragma unroll
        for (int g = 0; g < 32; ++g) t += red[g * 128 + tid];
        const float km = t * (1.0f / 256.0f);
        const unsigned hi = f2bf(km); const float rem = km - __uint_as_float(hi << 16);
        F.KMH()[(size_t)unit * 128 + tid] = (bf16)hi; F.KML()[(size_t)unit * 128 + tid] = (bf16)f2bf(rem); }
}
struct MobaSt {
    bf16x8 Q[2][4]; f32x4 acc[2][8]; f32x4 accl[2]; float cmi[2], kbs[8]; unsigned mym[2], wm;
    const LAS unsigned char* kptr[2][4]; const LAS unsigned char* vptr[2][8];
    unsigned voff[2]; const char* gK; LAS unsigned char* hb; bf16x8 ones;
    float scale2, slope2, slope2i, inv2; int ob, qrel_hi, qpos0, w8, gq;
};
DI void moba_dma(const MobaSt& S, int tt, int bufoff) {
    const char* g = sbase(S.gK + (size_t)tt * (64 * NPJ * 2)); const char* gv = sbase(g + (C_MV - C_MK) * 2);
#pragma unroll
    for (int i = 0; i < 2; ++i) { LAS unsigned char* d = S.hb + bufoff + (S.w8 * 2 + i) * 1024; unsigned vo = S.voff[i]; asm volatile("" : "+v"(vo));
        __builtin_amdgcn_global_load_lds((const unsigned*)(g + vo), (LAS unsigned*)d, 16, 0, 0);
        __builtin_amdgcn_global_load_lds((const unsigned*)(gv + vo), (LAS unsigned*)(d + 16384), 16, 0, 0); }
}
template <int BUF, bool SAFE> DI void moba_tile(MobaSt& S, int tt) {
    const int kb = tt >> 2, tile = tt & 3;
    if (!(((S.wm >> kb) & 1u) && (kb < S.ob || 64 * tile <= S.qrel_hi))) return;
    const bool own = (kb == S.ob);
#pragma unroll
    for (int js = 0; js < 2; ++js) {
        f32x4 s[2][2];
        const float kposf = (float)(tt * 64 + 32 * js);
#pragma unroll
        for (int qi = 0; qi < 2; ++qi) {
            float t0 = fmaf(S.slope2i, kposf, -S.cmi[qi]); t0 = ((S.mym[qi] >> kb) & 1u) ? t0 : -INFINITY;
            s[qi][0] = (f32x4){t0 + S.kbs[0], t0 + S.kbs[1], t0 + S.kbs[2], t0 + S.kbs[3]}; s[qi][1] = (f32x4){t0 + S.kbs[4], t0 + S.kbs[5], t0 + S.kbs[6], t0 + S.kbs[7]};
            if (own) { const int kp = tt * 64 + 32 * js + 8 * S.gq, qp = S.qpos0 + 16 * qi;
#pragma unroll
                for (int e = 0; e < 4; ++e) { s[qi][0][e] = (kp + e <= qp) ? s[qi][0][e] : -INFINITY; s[qi][1][e] = (kp + 4 + e <= qp) ? s[qi][1][e] : -INFINITY; } } }
#pragma unroll
        for (int ks = 0; ks < 4; ++ks) {
            const bf16x8 K0 = *(const LAS bf16x8*)(S.kptr[0][ks] + BUF + 8192 * js), K1 = *(const LAS bf16x8*)(S.kptr[1][ks] + BUF + 8192 * js);
#pragma unroll
            for (int qi = 0; qi < 2; ++qi) { s[qi][0] = mfma16(K0, S.Q[qi][ks], s[qi][0]); s[qi][1] = mfma16(K1, S.Q[qi][ks], s[qi][1]); } }
        bf16x8 Pf[2];
#pragma unroll
        for (int qi = 0; qi < 2; ++qi) {
            float p[8];
#pragma unroll
            for (int e = 0; e < 8; ++e) { const float sv = (e < 4) ? s[qi][0][e & 3] : s[qi][1][e & 3]; p[e] = sv * S.scale2; }
            if constexpr (SAFE) {
                float mx = __builtin_elementwise_maximum(__builtin_elementwise_maximum(p[0], p[1]), p[2]); mx = __builtin_elementwise_maximum(__builtin_elementwise_maximum(mx, p[3]), p[4]);
                mx = __builtin_elementwise_maximum(__builtin_elementwise_maximum(mx, p[5]), p[6]); mx = __builtin_elementwise_maximum(mx, p[7]);
                if (__any(mx > 8.0f)) {
                    mx = fmaxf(mx, __shfl_xor(mx, 16)); mx = fmaxf(mx, __shfl_xor(mx, 32));
                    const float d = fmaxf(mx, 0.f), alpha = __builtin_amdgcn_exp2f(-d);
                    S.cmi[qi] = fmaf(d, S.inv2, S.cmi[qi]); S.accl[qi] *= alpha;
#pragma unroll
                    for (int v = 0; v < 8; ++v) S.acc[qi][v] *= alpha;
#pragma unroll
                    for (int e = 0; e < 8; ++e) p[e] -= d; } }
#pragma unroll
            for (int e = 0; e < 8; ++e) p[e] = __builtin_amdgcn_exp2f(p[e]);
            Pf[qi] = pack8f(p); }
#pragma unroll
        for (int vt = 0; vt < 8; ++vt) {
            const s16x4 lo = __builtin_bit_cast(s16x4, __builtin_amdgcn_ds_read_tr16_b64_v4i16((LAS v4i16_t*)(S.vptr[0][vt] + BUF + 8192 * js)));
            const s16x4 hi = __builtin_bit_cast(s16x4, __builtin_amdgcn_ds_read_tr16_b64_v4i16((LAS v4i16_t*)(S.vptr[1][vt] + BUF + 8192 * js)));
            bf16x8 Vf; Vf[0] = lo[0]; Vf[1] = lo[1]; Vf[2] = lo[2]; Vf[3] = lo[3]; Vf[4] = hi[0]; Vf[5] = hi[1]; Vf[6] = hi[2]; Vf[7] = hi[3];
            S.acc[0][vt] = mfma16(Vf, Pf[0], S.acc[0][vt]); S.acc[1][vt] = mfma16(Vf, Pf[1], S.acc[1][vt]); }
        S.accl[0] = mfma16(S.ones, Pf[0], S.accl[0]); S.accl[1] = mfma16(S.ones, Pf[1], S.accl[1]);
    }
}
DI void moba_attn(Frame& F, int ob, int bh) {
    const int lane = F.lane(), w = F.wave(), gq = lane >> 4, l15 = lane & 15;
    const int h = bh & 7, b = bh >> 3;
    const size_t tq = (size_t)b * SEQ + ob * 256 + w * 32;
    MobaSt S;
    S.ob = ob; S.w8 = w; S.gq = gq; S.hb = F.lds;
    S.scale2 = 0.08838834764831845f * 1.4426950408889634f; S.slope2 = exp2f(-(float)(h + 1)) * 1.4426950408889634f; S.inv2 = 1.0f / S.scale2; S.slope2i = S.slope2 * S.inv2;
#pragma unroll
    for (int qi = 0; qi < 2; ++qi)
#pragma unroll
        for (int ks = 0; ks < 4; ++ks) S.Q[qi][ks] = *(const bf16x8*)(F.P() + (tq + qi * 16 + l15) * NPJ + C_MQ + h * 128 + 32 * ks + 8 * gq);
    { bf16x8 KH[4], KL[4];
#pragma unroll
      for (int ks = 0; ks < 4; ++ks) { KH[ks] = *(const bf16x8*)(F.KMH() + ((size_t)bh * 16 + l15) * 128 + 32 * ks + 8 * gq); KL[ks] = *(const bf16x8*)(F.KML() + ((size_t)bh * 16 + l15) * 128 + 32 * ks + 8 * gq); }
#pragma unroll
      for (int qi = 0; qi < 2; ++qi) { f32x4 g = (f32x4){0.f, 0.f, 0.f, 0.f};
#pragma unroll
          for (int ks = 0; ks < 4; ++ks) { g = mfma16(KH[ks], S.Q[qi][ks], g); g = mfma16(KL[ks], S.Q[qi][ks], g); }
          float gv[4];
#pragma unroll
          for (int r = 0; r < 4; ++r) gv[r] = (4 * gq + r < ob) ? g[r] : -INFINITY;
          unsigned mask = 0u;
#pragma unroll
          for (int pass = 0; pass < 3; ++pass) { float bv = -INFINITY; int bn = 31;
#pragma unroll
              for (int r = 0; r < 4; ++r) { const int n = 4 * gq + r; if (!((mask >> n) & 1u) && gv[r] > bv) { bv = gv[r]; bn = n; } }
#pragma unroll
              for (int off = 16; off <= 32; off <<= 1) { const float ov = __shfl_xor(bv, off); const int on = __shfl_xor(bn, off); if (ov > bv || (ov == bv && on < bn)) { bv = ov; bn = on; } }
              if (bv > -INFINITY) mask |= 1u << bn; }
          S.mym[qi] = mask | (1u << ob); } }
    { unsigned wm = S.mym[0] | S.mym[1]; wm |= __shfl_xor(wm, 1); wm |= __shfl_xor(wm, 2); wm |= __shfl_xor(wm, 4); wm |= __shfl_xor(wm, 8); S.wm = __builtin_amdgcn_readfirstlane(wm); }
#pragma unroll
    for (int qi = 0; qi < 2; ++qi) { const bf16* kp = F.P() + (tq + qi * 16 + l15) * NPJ + C_MK + h * 128 + 8 * gq; float d = 0.f;
#pragma unroll
        for (int ks = 0; ks < 4; ++ks) { float kf[8], qf[8]; unpack8(*(const v4u*)(kp + 32 * ks), kf); unpack8(__builtin_bit_cast(v4u, S.Q[qi][ks]), qf);
#pragma unroll
            for (int e = 0; e < 8; ++e) d += kf[e] * qf[e]; }
        d += __shfl_xor(d, 16); d += __shfl_xor(d, 32); S.cmi[qi] = d; }
    const int qrel0 = w * 32 + l15; S.qpos0 = ob * 256 + qrel0; S.qrel_hi = w * 32 + 31;
    S.cmi[0] += S.slope2i * (float)(S.qpos0 - 8 * gq); S.cmi[1] += S.slope2i * (float)(S.qpos0 + 16 - 8 * gq);
    { int z0 = 0; asm volatile("" : "+s"(z0));
#pragma unroll
      for (int e = 0; e < 8; ++e) S.kbs[e] = __builtin_bit_cast(float, __builtin_amdgcn_readfirstlane(__builtin_bit_cast(int, S.slope2i * (float)(e + z0)))); }
#pragma unroll
    for (int qi = 0; qi < 2; ++qi) { S.accl[qi] = (f32x4){0.f, 0.f, 0.f, 0.f};
#pragma unroll
        for (int v = 0; v < 8; ++v) S.acc[qi][v] = (f32x4){0.f, 0.f, 0.f, 0.f}; }
    { const short one = (l15 == 0) ? (short)0x3F80 : (short)0;
#pragma unroll
      for (int e = 0; e < 8; ++e) S.ones[e] = one; }
#pragma unroll
    for (int sub = 0; sub < 2; ++sub) { const int row = 8 * (l15 >> 2) + 4 * sub + (l15 & 3);
#pragma unroll
        for (int ks = 0; ks < 4; ++ks) { S.kptr[sub][ks] = S.hb + 256 * row + 16 * ((4 * ks + gq) ^ swz(row)); asm volatile("" : "+v"(S.kptr[sub][ks])); } }
    { const int q = l15 >> 2, pp = lane & 3;
#pragma unroll
      for (int t = 0; t < 2; ++t) { const int row = 8 * gq + 4 * t + q;
#pragma unroll
          for (int vt = 0; vt < 8; ++vt) { S.vptr[t][vt] = S.hb + 16384 + 256 * row + 16 * ((2 * vt + (pp >> 1)) ^ swz(row)) + 8 * (pp & 1); asm volatile("" : "+v"(S.vptr[t][vt])); } } }
#pragma unroll
    for (int i = 0; i < 2; ++i) { const int row = 4 * (w * 2 + i) + (lane >> 4), c = (lane & 15) ^ swz(row); S.voff[i] = (unsigned)(row * NPJ + c * 8) * 2u; }
    S.gK = (const char*)(F.P() + (size_t)b * SEQ * NPJ + h * 128 + C_MK);
    const int NT = ob * 4 + 4;
    int fast;
    { float q2 = 0.f;
#pragma unroll
      for (int qi = 0; qi < 2; ++qi) { float ss = 0.f;
#pragma unroll
          for (int ks = 0; ks < 4; ++ks) { float qf[8]; unpack8(__builtin_bit_cast(v4u, S.Q[qi][ks]), qf);
#pragma unroll
              for (int e = 0; e < 8; ++e) ss += qf[e] * qf[e]; }
          ss += __shfl_xor(ss, 16); ss += __shfl_xor(ss, 32); q2 = fmaxf(q2, ss); }
      q2 = fmaxf(q2, __shfl_xor(q2, 1)); q2 = fmaxf(q2, __shfl_xor(q2, 2)); q2 = fmaxf(q2, __shfl_xor(q2, 4)); q2 = fmaxf(q2, __shfl_xor(q2, 8));
      const float qn = sqrtf(q2) * 1.01f, kown = sqrtf(F.KMX()[bh * 16 + ob]) * 1.01f, kj = sqrtf(F.KMX()[bh * 16 + l15]) * 1.01f;
      const float dist = (float)(ob * 256 + w * 32 - (256 * l15 + 255));
      const bool zero = (l15 < ob) && (qn * (kj + kown) * S.scale2 - S.slope2 * dist < -138.0f);
      { float kall = (l15 <= ob) ? kj : 0.f; kall = fmaxf(kall, __shfl_xor(kall, 1)); kall = fmaxf(kall, __shfl_xor(kall, 2)); kall = fmaxf(kall, __shfl_xor(kall, 4)); kall = fmaxf(kall, __shfl_xor(kall, 8));
        fast = __builtin_amdgcn_readfirstlane((int)(qn * (kall + kown) * S.scale2 <= 100.0f)); }
      const unsigned zmask = (unsigned)(__ballot(zero) & 0xFFFFull);
      S.wm &= ~zmask;
      const int lead = __builtin_ctz(~zmask);
      if (lane == 0) ((volatile LAS int*)(F.lds + LDSCTL_OFF + 512))[w] = lead; }
    __syncthreads();
    int T0;
    { volatile LAS int* le = (volatile LAS int*)(F.lds + LDSCTL_OFF + 512); int m = le[0];
#pragma unroll
      for (int k = 1; k < 8; ++k) m = min(m, le[k]);
      T0 = 4 * __builtin_amdgcn_readfirstlane(m); }
    moba_dma(S, T0, 0);
    VM_WAIT(); __syncthreads();
    if (fast) {
        for (int tt = T0; tt < NT; tt += 2) {
            moba_dma(S, tt + 1, 32768);
            moba_tile<0, false>(S, tt);
            VM_WAIT(); __syncthreads();
            if (tt + 2 < NT) moba_dma(S, tt + 2, 0);
            moba_tile<32768, false>(S, tt + 1);
            VM_WAIT(); __syncthreads();
        }
    } else {
        for (int tt = T0; tt < NT; tt += 2) {
            moba_dma(S, tt + 1, 32768);
            moba_tile<0, true>(S, tt);
            VM_WAIT(); __syncthreads();
            if (tt + 2 < NT) moba_dma(S, tt + 2, 0);
            moba_tile<32768, true>(S, tt + 1);
            VM_WAIT(); __syncthreads();
        }
    }
#pragma unroll
    for (int qi = 0; qi < 2; ++qi) { const float lt = __shfl(S.accl[qi][0], l15); const float inv = 1.0f / lt; const size_t ti = tq + qi * 16 + l15;
        const bf16* Gp = F.P() + ti * NPJ + C_MG + h * 128; bf16* Yp = F.Y() + ti * DM + 1024 + h * 128;
#pragma unroll
        for (int vt = 0; vt < 8; ++vt) { const int v = 16 * vt + 4 * gq; const v2u gv = *(const v2u*)(Gp + v);
            const float y0 = S.acc[qi][vt][0] * inv * silu(bf_lo(gv.x)), y1 = S.acc[qi][vt][1] * inv * silu(bf_hi(gv.x)), y2 = S.acc[qi][vt][2] * inv * silu(bf_lo(gv.y)), y3 = S.acc[qi][vt][3] * inv * silu(bf_hi(gv.y));
            v2u o; o.x = pkbf(y0, y1); o.y = pkbf(y2, y3); *(v2u*)(Yp + v) = o; } }
}

DI void ssd_A(Frame& F, int l, int unit) {
    const int grp = unit & 3, bc = unit >> 2, c = bc & 15, b = bc >> 4, tid = F.tid(), lane = F.lane(), w = F.wave(), gq = lane >> 4;
    const size_t t0 = (size_t)b * SEQ + c * 256;
    LAS float* dtl = (LAS float*)F.lds; LAS float* dacs = dtl + 1024; LAS float* fac = dtl + 2048;
    LAS unsigned char* Bt = F.lds + 12288; LAS unsigned char* XWt = Bt + 64 * SB128;
    __syncthreads();
    for (int idx = tid; idx < 1024; idx += NTHR) { const int r = idx >> 8, t = idx & 255, head = 4 * grp + r;
        const float raw = F.DTRAW()[(t0 + t) * 16 + head] + F.in(6)[l * 16 + head]; const float dt = softplus(raw), a = -__expf(F.in(7)[l * 16 + head]);
        dtl[idx] = dt; dacs[idx] = dt * a; }
    __syncthreads();
    if (w < 4) { float x0 = dacs[w * 256 + 4 * lane], x1 = dacs[w * 256 + 4 * lane + 1], x2 = dacs[w * 256 + 4 * lane + 2], x3 = dacs[w * 256 + 4 * lane + 3];
        x1 += x0; x2 += x1; x3 += x2; float tot = x3;
#pragma unroll
        for (int o = 1; o < 64; o <<= 1) { const float y = __shfl_up(tot, o); if (lane >= o) tot += y; }
        const float ex = tot - x3;
        dacs[w * 256 + 4 * lane] = x0 + ex; dacs[w * 256 + 4 * lane + 1] = x1 + ex; dacs[w * 256 + 4 * lane + 2] = x2 + ex; dacs[w * 256 + 4 * lane + 3] = x3 + ex; }
    __syncthreads();
    for (int idx = tid; idx < 1024; idx += NTHR) { const int r = idx >> 8, t = idx & 255, head = 4 * grp + r; const float dc = dacs[idx], dt = dtl[idx];
        fac[idx] = __expf(dacs[r * 256 + 255] - dc) * dt; F.DT()[(t0 + t) * 16 + head] = dc * 1.4426950408889634f - __log2f(dt); F.DACS()[(t0 + t) * 16 + head] = dc * 1.4426950408889634f; }
    f32x4 acc[16];
#pragma unroll
    for (int v = 0; v < 16; ++v) acc[v] = (f32x4){0.f, 0.f, 0.f, 0.f};
    const int cc = tid & 63, tg = tid >> 6;
    const int chn = cc < 32 ? grp * 256 + cc * 8 : (cc < 48 ? 1024 + grp * 128 + (cc - 32) * 8 : 1536 + grp * 128 + (cc - 48) * 8);
    float cw[4][8], cb[8];
#pragma unroll
    for (int k = 0; k < 4; ++k) { const f32x4 a = *(const f32x4*)(F.in(4) + ((size_t)l * 4 + k) * 2048 + chn), bq = *(const f32x4*)(F.in(4) + ((size_t)l * 4 + k) * 2048 + chn + 4);
        cw[k][0] = a[0]; cw[k][1] = a[1]; cw[k][2] = a[2]; cw[k][3] = a[3]; cw[k][4] = bq[0]; cw[k][5] = bq[1]; cw[k][6] = bq[2]; cw[k][7] = bq[3]; }
    { const f32x4 a = *(const f32x4*)(F.in(5) + (size_t)l * 2048 + chn), bq = *(const f32x4*)(F.in(5) + (size_t)l * 2048 + chn + 4);
      cb[0] = a[0]; cb[1] = a[1]; cb[2] = a[2]; cb[3] = a[3]; cb[4] = bq[0]; cb[5] = bq[1]; cb[6] = bq[2]; cb[7] = bq[3]; }
    const bf16* Xp = F.P() + t0 * NPJ + C_SX + chn;
    for (int jt = 0; jt < 4; ++jt) {
        __syncthreads();
        { const int tl0 = jt * 64 + tg * 8; float h0[8], h1[8], h2[8];
          { const bool z = (c == 0 && tl0 < 3);
            if (z) {
#pragma unroll
                for (int e = 0; e < 8; ++e) { h0[e] = 0.f; h1[e] = 0.f; h2[e] = 0.f; }
            } else { unpack8(*(const v4u*)(Xp + ((long)tl0 - 3) * NPJ), h0); unpack8(*(const v4u*)(Xp + ((long)tl0 - 2) * NPJ), h1); unpack8(*(const v4u*)(Xp + ((long)tl0 - 1) * NPJ), h2); } }
          v4u xraw[8];
#pragma unroll
          for (int i = 0; i < 8; ++i) xraw[i] = *(const v4u*)(Xp + (size_t)(tl0 + i) * NPJ);
#pragma unroll
          for (int i = 0; i < 8; ++i) { const int tl = tl0 + i; float x[8], y[8]; unpack8(xraw[i], x);
#pragma unroll
              for (int e = 0; e < 8; ++e) { const float v = cb[e] + cw[0][e] * h0[e] + cw[1][e] * h1[e] + cw[2][e] * h2[e] + cw[3][e] * x[e]; y[e] = silu(v); h0[e] = h1[e]; h1[e] = h2[e]; h2[e] = x[e]; }
              *(v4u*)(F.XBC() + (t0 + tl) * 2048 + chn) = pack8(y);
              if (cc < 32) { const float f = fac[(cc >> 3) * 256 + tl];
#pragma unroll
                  for (int e = 0; e < 8; ++e) y[e] *= f;
                  *(LAS v4u*)(XWt + (tg * 8 + i) * SB256 + cc * 16) = pack8(y); }
              else if (cc < 48) *(LAS v4u*)(Bt + (tg * 8 + i) * SB128 + (cc - 32) * 16) = pack8(y); } }
        __syncthreads();
#pragma unroll
        for (int ks = 0; ks < 2; ++ks) { const int ra = 32 * ks + 8 * gq, rb = ra + 4; const bf16x8 A = frag_tr(Bt, SB128, ra, rb, 16 * w, lane);
#pragma unroll
            for (int pt = 0; pt < 16; ++pt) acc[pt] = mfma16(A, frag_tr(XWt, SB256, ra, rb, 16 * pt, lane), acc[pt]); }
    }
#pragma unroll
    for (int pt = 0; pt < 16; ++pt) { const int head = 4 * grp + (pt >> 2); float* S = F.SST() + ((size_t)bc * 16 + head) * 8192;
        *(f32x4*)(S + ((pt & 3) * 16 + (lane & 15)) * 128 + 16 * w + 4 * gq) = acc[pt]; }
}
DI void ssd_B(Frame& F) {
    for (int it = blockIdx.x * NTHR + F.tid(); it < 32 * 2048; it += F.G() * NTHR) { const int e4 = it & 2047, bhd = it >> 11, head = bhd & 15, b = bhd >> 4; f32x4 s = (f32x4){0.f, 0.f, 0.f, 0.f};
        const size_t o0 = ((size_t)(b * 16) * 16 + head) * 8192 + (size_t)e4 * 4; const float* __restrict__ st = F.SST() + o0; bf16* __restrict__ hp = F.SHP() + o0;
        f32x4 u[15]; float dec[15];
#pragma unroll
        for (int c = 0; c < 15; ++c) { u[c] = *(const f32x4*)(st + (size_t)c * 16 * 8192); dec[c] = F.DACS()[((size_t)b * SEQ + c * 256 + 255) * 16 + head]; }
#pragma unroll
        for (int c = 0; c < 16; ++c) { *(unsigned long long*)(hp + (size_t)c * 16 * 8192) = (unsigned long long)pkbf(s[0], s[1]) | ((unsigned long long)pkbf(s[2], s[3]) << 32);
            if (c < 15) s = s * __builtin_amdgcn_exp2f(dec[c]) + u[c]; } }
}
template <int NROWS> DI void dma_rows128(const bf16* src, unsigned gp, LAS unsigned char* dst, int w, int lane) {
    const char* sb = sbase(src);
#pragma unroll
    for (int i = 0; i < NROWS / 32; ++i) { const int idx = w * (NROWS / 32) + i, row = 4 * idx + (lane >> 4), c = (lane & 15) ^ swz(row);
        __builtin_amdgcn_global_load_lds((const unsigned*)(sb + ((unsigned)row * gp + (unsigned)c * 8u) * 2u), (LAS unsigned*)(dst + idx * 1024), 16, 0, 0); }
}
DI bf16x8 frag_row_sw256(const LAS unsigned char* t, int row, int ch) { return *(const LAS bf16x8*)(t + 256 * row + 16 * (ch ^ swz(row))); }
constexpr int SC_B = 0, SC_X = 16384, SC_DA = 49152, SC_DT = 50176;
DI void ssd_dma_tile(Frame& F, size_t trow, int grp, LAS unsigned char* buf, int w, int lane) {
    dma_rows128<64>(F.XBC() + trow * 2048 + 1024 + grp * 128, 2048, buf + SC_B, w, lane);
    dma_tile256(F.XBC() + trow * 2048 + grp * 256, 2048, buf + SC_X, w, lane);
    if (w == 1) __builtin_amdgcn_global_load_lds((const unsigned*)(F.DT() + (trow + lane) * 16 + 4 * grp), (LAS unsigned*)(buf + SC_DT), 16, 0, 0);
}
DI void ssd_C(Frame& F, int l, int unit2) {
    const int half = unit2 & 1, unit = unit2 >> 1, grp = unit & 3, bc = unit >> 2, c = bc & 15, b = bc >> 4, lane = F.lane(), w = F.wave(), gq = lane >> 4, l15 = lane & 15;
    const size_t t0 = (size_t)b * SEQ + c * 256; const int il = half * 128 + w * 16 + l15; const size_t ti = t0 + il;
    LAS unsigned char* B0 = F.lds; LAS unsigned char* B1 = F.lds + 65536;
    if (c > 0) dma_rows128<256>(F.SHP() + ((size_t)bc * 16 + 4 * grp) * 8192, 128, B0, w, lane); else ssd_dma_tile(F, t0, grp, B0, w, lane);
    bf16x8 Cf[4];
#pragma unroll
    for (int ks = 0; ks < 4; ++ks) Cf[ks] = *(const bf16x8*)(F.XBC() + ti * 2048 + 1536 + grp * 128 + 32 * ks + 8 * gq);
    f32x4 acc[4][4]; float dci[4];
    { const f32x4 d4 = *(const f32x4*)(F.DACS() + ti * 16 + 4 * grp); dci[0] = d4[0]; dci[1] = d4[1]; dci[2] = d4[2]; dci[3] = d4[3]; }
#pragma unroll
    for (int r = 0; r < 4; ++r)
#pragma unroll
        for (int pt = 0; pt < 4; ++pt) acc[r][pt] = (f32x4){0.f, 0.f, 0.f, 0.f};
    const int njt = 2 * (half + 1);
    unsigned kb0 = rowbase256(8 * (l15 >> 2) + (l15 & 3), gq), kb1 = rowbase256(8 * (l15 >> 2) + (l15 & 3) + 4, gq);
    unsigned xb0 = trbase512(8 * gq + (l15 >> 2), lane), xb1 = trbase512(8 * gq + 4 + (l15 >> 2), lane), sb0 = rowbase256(l15, gq);
    asm volatile("" : "+v"(kb0), "+v"(kb1), "+v"(xb0), "+v"(xb1), "+v"(sb0));
    const int il_lo = half * 128 + w * 16, jdw = il_lo >> 5;
    VM_WAIT(); __syncthreads();
    int par = 0;
    if (c > 0) {
        ssd_dma_tile(F, t0, grp, B1, w, lane);
        const unsigned sA = laddr(B0) + sb0;
#pragma unroll
        for (int r = 0; r < 4; ++r) {
#pragma unroll
            for (int ks = 0; ks < 4; ++ks)
#pragma unroll
                for (int pt = 0; pt < 4; ++pt) acc[r][pt] = mfma16(*(const LAS bf16x8*)(lptr(sA ^ (64 * ks)) + 256 * (r * 64 + 16 * pt)), Cf[ks], acc[r][pt]);
            const float ed = __builtin_amdgcn_exp2f(dci[r]);
#pragma unroll
            for (int pt = 0; pt < 4; ++pt) acc[r][pt] *= ed; }
        VM_WAIT(); __syncthreads();
        par = 1;
    }
    for (int jt = 0; jt < njt; ++jt) {
        LAS unsigned char* cur = ((jt + par) & 1) ? B1 : B0; LAS unsigned char* nxt = ((jt + par) & 1) ? B0 : B1;
        if (jt + 1 < njt) ssd_dma_tile(F, t0 + 64 * (jt + 1), grp, nxt, w, lane);
        if (2 * jt <= jdw) {
            const unsigned cb = laddr(cur), kA0 = cb + SC_B + kb0, kA1 = cb + SC_B + kb1, xA0 = cb + SC_X + xb0, xA1 = cb + SC_X + xb1;
            const LAS unsigned char* dA = cur + SC_DT + 8 * gq * 16;
#pragma unroll
            for (int js = 0; js < 2; ++js) {
                if (2 * jt + js > jdw) break;
                f32x4 s0 = (f32x4){0.f, 0.f, 0.f, 0.f}, s1 = s0, s0b = s0, s1b = s0;
#pragma unroll
                for (int ks = 0; ks < 4; ks += 2) { s0 = mfma16(*(const LAS bf16x8*)(lptr(kA0 ^ (64 * ks)) + 8192 * js), Cf[ks], s0); s1 = mfma16(*(const LAS bf16x8*)(lptr(kA1 ^ (64 * ks)) + 8192 * js), Cf[ks], s1);
                    s0b = mfma16(*(const LAS bf16x8*)(lptr(kA0 ^ (64 * ks + 64)) + 8192 * js), Cf[ks + 1], s0b); s1b = mfma16(*(const LAS bf16x8*)(lptr(kA1 ^ (64 * ks + 64)) + 8192 * js), Cf[ks + 1], s1b); }
                s0 += s0b; s1 += s1b;
                float ex[4][8];
#pragma unroll
                for (int e = 0; e < 8; ++e) { const f32x4 dj = *(const LAS f32x4*)(dA + (32 * js + e) * 16);
#pragma unroll
                    for (int r = 0; r < 4; ++r) ex[r][e] = dci[r] - dj[r]; }
                if (2 * jt + js == jdw) {
                    const int dq = il - (64 * jt + 32 * js + 8 * gq);
#pragma unroll
                    for (int e = 0; e < 8; ++e)
#pragma unroll
                        for (int r = 0; r < 4; ++r) ex[r][e] = (dq >= e) ? ex[r][e] : -INFINITY; }
#pragma unroll
                for (int r = 0; r < 4; ++r) { float p[8];
#pragma unroll
                    for (int e = 0; e < 8; ++e) { const float sv = (e < 4) ? s0[e & 3] : s1[e & 3]; p[e] = sv * __builtin_amdgcn_exp2f(ex[r][e]); }
                    const bf16x8 Pf = pack8f(p);
#pragma unroll
                    for (int pt = 0; pt < 4; ++pt) acc[r][pt] = mfma16(frag_tr2(xA0 ^ (2 * (r * 64 + 16 * pt)), xA1 ^ (2 * (r * 64 + 16 * pt)), 16384 * js), Pf, acc[r][pt]); }
            }
        }
        VM_WAIT(); __syncthreads();
    }
    float ss = 0.f;
    const bf16* xb = F.XBC() + ti * 2048 + grp * 256 + 4 * gq; const bf16* zb = F.P() + ti * NPJ + C_SZ + grp * 256 + 4 * gq;
#pragma unroll
    for (int r = 0; r < 4; ++r) { const float dsk = F.in(8)[l * 16 + 4 * grp + r];
#pragma unroll
        for (int pt = 0; pt < 4; ++pt) { const v2u xv = *(const v2u*)(xb + r * 64 + 16 * pt), zv = *(const v2u*)(zb + r * 64 + 16 * pt);
            f32x4 y = acc[r][pt]; y[0] = (y[0] + dsk * bf_lo(xv.x)) * silu(bf_lo(zv.x)); y[1] = (y[1] + dsk * bf_hi(xv.x)) * silu(bf_hi(zv.x)); y[2] = (y[2] + dsk * bf_lo(xv.y)) * silu(bf_lo(zv.y)); y[3] = (y[3] + dsk * bf_hi(xv.y)) * silu(bf_hi(zv.y));
            acc[r][pt] = y; ss += (y[0] * y[0] + y[1] * y[1]) + (y[2] * y[2] + y[3] * y[3]); }
        asm volatile("" ::: "memory"); }
    ss += __shfl_xor(ss, 16); ss += __shfl_xor(ss, 32);
    const float rms = rsqrtf(ss * (1.0f / 256.0f) + EPS);
    const float* nw = F.in(9) + (size_t)l * 1024 + grp * 256 + 4 * gq; bf16* yb = F.Y() + ti * DM + 2048 + grp * 256 + 4 * gq;
#pragma unroll
    for (int r = 0; r < 4; ++r)
#pragma unroll
        for (int pt = 0; pt < 4; ++pt) { const f32x4 w4 = *(const f32x4*)(nw + r * 64 + 16 * pt); const f32x4 y = acc[r][pt] * rms * w4;
            v2u o; o.x = pkbf(y[0], y[1]); o.y = pkbf(y[2], y[3]); *(v2u*)(yb + r * 64 + 16 * pt) = o; }
}

DI void lru_A(Frame& F, int l, int unit) {
    const int nb = unit & 7, bc = unit >> 3, c256 = bc & 15, b = bc >> 4, tid = F.tid(), lane = F.lane(), w = F.wave(), gq = lane >> 4;
    const int chn0 = nb * 128;
    LAS float* xcf = (LAS float*)F.lds; LAS float* al = xcf + 8192; LAS unsigned char* xcb = F.lds + 65536;
    LAS float* sh = (LAS float*)(F.lds + 65536 + 64 * SB128); LAS float* sa = sh + 512;
    const int ch8 = tid & 15, tg = tid >> 4, chn = chn0 + ch8 * 8, tl0 = tg * 2; float cw[4][8], cb[8];
#pragma unroll
    for (int k = 0; k < 4; ++k) { const f32x4 a = *(const f32x4*)(F.in(10) + ((size_t)l * 4 + k) * 1024 + chn), bq = *(const f32x4*)(F.in(10) + ((size_t)l * 4 + k) * 1024 + chn + 4);
        cw[k][0] = a[0]; cw[k][1] = a[1]; cw[k][2] = a[2]; cw[k][3] = a[3]; cw[k][4] = bq[0]; cw[k][5] = bq[1]; cw[k][6] = bq[2]; cw[k][7] = bq[3]; }
    { const f32x4 a = *(const f32x4*)(F.in(11) + (size_t)l * 1024 + chn), bq = *(const f32x4*)(F.in(11) + (size_t)l * 1024 + chn + 4);
      cb[0] = a[0]; cb[1] = a[1]; cb[2] = a[2]; cb[3] = a[3]; cb[4] = bq[0]; cb[5] = bq[1]; cb[6] = bq[2]; cb[7] = bq[3]; }
    const int eg = 16 * w + (lane & 15), chg = chn0 + eg;
    bf16x8 Ba[4], Bx[4];
    { const bf16* WTa = F.LRUW() + ((((size_t)l * 2 + 0) * 8 + nb) * 128 + eg) * 128; const bf16* WTx = F.LRUW() + ((((size_t)l * 2 + 1) * 8 + nb) * 128 + eg) * 128;
#pragma unroll
      for (int ks = 0; ks < 4; ++ks) { Ba[ks] = *(const bf16x8*)(WTa + 32 * ks + 8 * gq); Bx[ks] = *(const bf16x8*)(WTx + 32 * ks + 8 * gq); } }
    const float ba = F.in(13)[l * 1024 + chg], bx = F.in(15)[l * 1024 + chg], spl = softplus(-F.in(16)[l * 1024 + chg]);
    const size_t tu = (size_t)b * SEQ + c256 * 256;
    const bf16* Xp0 = F.P() + tu * NPJ + C_LX + chn;
    v4u raw[5];
#pragma unroll
    for (int k = 0; k < 5; ++k) { const int tl = tl0 - 3 + k; raw[k] = (c256 == 0 && tl < 0) ? (v4u){0u, 0u, 0u, 0u} : *(const v4u*)(Xp0 + (long)tl * NPJ); }
    for (int sc = 0; sc < 4; ++sc) {
        const int cc = c256 * 4 + sc, bcc = b * 64 + cc; const size_t t0 = tu + sc * 64;
        float xr[5][8];
#pragma unroll
        for (int k = 0; k < 5; ++k) unpack8(raw[k], xr[k]);
        if (sc < 3) {
#pragma unroll
            for (int k = 0; k < 5; ++k) raw[k] = *(const v4u*)(Xp0 + (long)((sc + 1) * 64 + tl0 - 3 + k) * NPJ); }
        __syncthreads();
#pragma unroll
        for (int i = 0; i < 2; ++i) { float y[8];
#pragma unroll
            for (int e = 0; e < 8; ++e) y[e] = cb[e] + cw[0][e] * xr[i][e] + cw[1][e] * xr[i + 1][e] + cw[2][e] * xr[i + 2][e] + cw[3][e] * xr[i + 3][e];
            *(LAS f32x4*)(xcf + (tl0 + i) * 128 + ch8 * 8) = (f32x4){y[0], y[1], y[2], y[3]}; *(LAS f32x4*)(xcf + (tl0 + i) * 128 + ch8 * 8 + 4) = (f32x4){y[4], y[5], y[6], y[7]};
            *(LAS v4u*)(xcb + (tl0 + i) * SB128 + ch8 * 16) = pack8(y); }
        __syncthreads();
#pragma unroll
        for (int mt = 0; mt < 4; ++mt) { f32x4 ra = (f32x4){0.f, 0.f, 0.f, 0.f}, rx = ra;
#pragma unroll
            for (int ks = 0; ks < 4; ++ks) { const bf16x8 A = frag_row(xcb, SB128, 16 * mt, 32 * ks, lane); ra = mfma16(A, Ba[ks], ra); rx = mfma16(A, Bx[ks], rx); }
#pragma unroll
            for (int reg = 0; reg < 4; ++reg) { const int t = 16 * mt + 4 * gq + reg; const float r_ = sigm(ra[reg] + ba), i_ = sigm(rx[reg] + bx), la = -8.0f * r_ * spl;
                const float a = __expf(la), u = __builtin_amdgcn_sqrtf(one_minus_exp(2.0f * la)) * i_ * xcf[t * 128 + eg]; al[t * 128 + eg] = a; xcf[t * 128 + eg] = u; } }
        __syncthreads();
        { const int e = tid & 127, seg = tid >> 7, ch = chn0 + e; float hv[16], av[16]; float hh = 0.f, ap = 1.f;
#pragma unroll
          for (int t = 0; t < 16; ++t) { const float a = al[(seg * 16 + t) * 128 + e], u = xcf[(seg * 16 + t) * 128 + e]; hh = a * hh + u; ap *= a; hv[t] = hh; av[t] = ap; }
          sh[seg * 128 + e] = hh; sa[seg * 128 + e] = ap;
          __syncthreads();
          float cin = 0.f, ain = 1.f;
#pragma unroll
          for (int k = 0; k < 3; ++k) if (k < seg) { cin = sa[k * 128 + e] * cin + sh[k * 128 + e]; ain *= sa[k * 128 + e]; }
#pragma unroll
          for (int t = 0; t < 16; ++t) { const size_t o = (t0 + seg * 16 + t) * 1024 + ch; F.HLOC()[o] = (bf16)f2bf(hv[t] + av[t] * cin); F.ACUM()[o] = (bf16)f2bf(av[t] * ain); }
          if (seg == 3) { F.HEND()[(size_t)bcc * 1024 + ch] = hv[15] + av[15] * cin; F.AEND()[(size_t)bcc * 1024 + ch] = av[15] * ain; } }
    }
}
DI void lru_B(Frame& F) {
    for (int it = blockIdx.x * NTHR + F.tid(); it < 2048; it += F.G() * NTHR) { const int ch = it & 1023, b = it >> 10; float carry = 0.f;
        const float* __restrict__ ae = F.AEND() + (size_t)(b * 64) * 1024 + ch; const float* __restrict__ he = F.HEND() + (size_t)(b * 64) * 1024 + ch; float* __restrict__ cr = F.CARRY() + (size_t)(b * 64) * 1024 + ch;
        float a[64], hh[64];
#pragma unroll
        for (int k = 0; k < 64; ++k) { a[k] = ae[(size_t)k * 1024]; hh[k] = he[(size_t)k * 1024]; }
#pragma unroll
        for (int k = 0; k < 64; ++k) { cr[(size_t)k * 1024] = carry; carry = a[k] * carry + hh[k]; } }
}
DI void lru_C(Frame& F, int unit) {
    const size_t tb = (size_t)unit * 32;
#pragma unroll 4
    for (int idx = F.tid(); idx < 32 * 128; idx += NTHR) { const size_t t = tb + (idx >> 7); const int ch = (idx & 127) * 8; const int b = (int)(t / SEQ), cc = (int)(t % SEQ) >> 6;
        const float* cr = F.CARRY() + (size_t)(b * 64 + cc) * 1024 + ch;
        float hl[8], ac[8], g[8]; unpack8(*(const v4u*)(F.HLOC() + t * 1024 + ch), hl); unpack8(*(const v4u*)(F.ACUM() + t * 1024 + ch), ac); unpack8(*(const v4u*)(F.P() + t * NPJ + C_LG + ch), g);
        const f32x4 c0 = *(const f32x4*)cr, c1 = *(const f32x4*)(cr + 4);
        float y[8];
#pragma unroll
        for (int e = 0; e < 8; ++e) { const float cv = e < 4 ? c0[e & 3] : c1[e & 3]; y[e] = (hl[e] + ac[e] * cv) * silu(g[e]); }
        *(v4u*)(F.Y() + t * DM + 3072 + ch) = pack8(y); }
}

__global__ void __launch_bounds__(NTHR, 2) hymba_fwd(Args args) {
    extern __shared__ __attribute__((aligned(16))) unsigned char lds[];
    Frame F = mk_frame((LAS unsigned char*)lds, &args);
    for (int u = F.tid(); u < (LDS_BYTES - LDSCTL_OFF) / 4; u += NTHR) ((LAS unsigned*)(F.lds + LDSCTL_OFF))[u] = 0u;
    __syncthreads();
    const int lo = args.ph_lo, hi = args.ph_hi;
    XcdBarrier bar; bar.bar = F.ctl() + CW_BAR; bar.x = 0; bar.st = nullptr;
    if (hi - lo > 1) bar = xcd_barrier_post(F.ctl() + CW_BAR, F.MISC() + 8);
#define IN(k) (lo <= (k) && (k) < hi)
#define SEAM(k) do { if (IN(k) && IN((k) + 1)) xcd_barrier(bar); } while (0)

    if (IN(0)) { p0_prologue(F);
#ifdef PROBE_PRO2
        xcd_barrier(bar); p0_prologue(F);
#endif
        SEAM(0); }
    for (int l = 0; l < DEPTH; ++l) {
        const int pb = 1 + 5 * l;
        if (IN(pb)) { F = mk_frame((LAS unsigned char*)lds, &args);
            pg8::Gemm g{F.XB(), F.WIN() + (size_t)l * NPJ * DM, MTOK, 12288, DM}; pg8::RemapOrder S; S.init(MTOK, 12288, F.G(), (int)blockIdx.x);
            pg8::Unit u0; S.next(0, u0); const int fm = u0.pm & ~7; LAS float* rtab = (LAS float*)(F.lds + LDSCTL_OFF + 1024);
            { const float* sq = F.SSQ() + (size_t)fm * 256 * 16;
              for (int r = F.tid(); r < 2048; r += NTHR) { const f32x4* p = (const f32x4*)(sq + (size_t)r * 16); const f32x4 a = p[0], b4 = p[1], c4 = p[2], d4 = p[3];
                  const float ssum = ((a[0] + a[1]) + (a[2] + a[3])) + ((b4[0] + b4[1]) + (b4[2] + b4[3])) + ((c4[0] + c4[1]) + (c4[2] + c4[3])) + ((d4[0] + d4[1]) + (d4[2] + d4[3]));
                  rtab[r] = rsqrtf(ssum * (1.0f / 4096.0f) + EPS); }
              __syncthreads(); }
            pg8::EpiProj E{F.P(), F.DTRAW(), F.SSQ(), rtab, fm};
#ifdef PROBE_IN2
            for (int rep2 = 0; rep2 < 2; ++rep2) { pg8::gemm_phase<pg8::EpiProj, pg8::RemapOrder, true, true>(F.lds, g, S, E); if (rep2 == 0) xcd_barrier(bar); }
#else
            pg8::gemm_phase<pg8::EpiProj, pg8::RemapOrder, true, true>(F.lds, g, S, E);
#endif
            SEAM(pb);
        }
#ifdef PROBE_MIX2
        for (int rep = 0; rep < 2; ++rep) {
#else
        { constexpr int rep = 0;
#endif
        if (IN(pb + 1)) { F = mk_frame((LAS unsigned char*)lds, &args);
#ifndef NO_STAGE_A
            for (int u = (int)blockIdx.x;; u = F.G() + next_unit(F, l * 4 + 0 + 2 * rep)) { F = mk_frame((LAS unsigned char*)lds, &args);
                if (u < 160) { const int t = u >> 5; pg8::Gemm g{F.XB(), F.WIN() + (size_t)l * NPJ * DM, MTOK, NPJ, DM}; pg8::OneUnit S1{u & 31, t == 0 ? 35 : 47 + t}; pg8::EpiProj E{F.P(), F.DTRAW(), F.SSQ(), nullptr, 0};
                    pg8::gemm_phase<pg8::EpiProj, pg8::OneUnit, true, true>(F.lds, g, S1, E); }
                else if (u < 288) ssd_A(F, l, u - 160);
                else if (u < 544) lru_A(F, l, u - 288);
                else if (u < 672) ret_A(F, u - 544);
                else if (u < 928) moba_kmean(F, u - 672);
                else if (u < 928 + 512) tr_unit(F, l, TR_I_IN + 2 * (u - 928), 2);
                else if (u < 1440 + 840 && l + 1 < DEPTH) tr_unit(F, l + 1, 2 * (u - 1440), 2);
                else break; }
#endif
            SEAM(pb + 1);
        }
        if (IN(pb + 2)) { F = mk_frame((LAS unsigned char*)lds, &args);
#ifndef NO_STAGE_B
            ret_B(F); ssd_B(F); lru_B(F);
#endif
            SEAM(pb + 2);
        }
        if (IN(pb + 3)) { F = mk_frame((LAS unsigned char*)lds, &args);
#ifndef NO_STAGE_C
            for (int u = (int)blockIdx.x;; u = F.G() + next_unit(F, l * 4 + 1 + 2 * rep)) { F = mk_frame((LAS unsigned char*)lds, &args);
                if (u < 256) moba_attn(F, 15 - (u >> 4), u & 15);
                else if (u < 512) ret_C(F, l, u - 256);
                else if (u < 768) ssd_C(F, l, u - 512);
                else if (u < 1024) lru_C(F, u - 768);
                else if (u < 1024 + 840 && l + 1 < DEPTH) tr_unit(F, l + 1, 1680 + 2 * (u - 1024), 2);
                else break; }
#endif
            SEAM(pb + 3);
        }
        }
        if (IN(pb + 4)) { F = mk_frame((LAS unsigned char*)lds, &args);
            pg8::Gemm g{F.Y(), F.WOUT() + (size_t)l * DM * DM, MTOK, DM, DM}; pg8::StaticOrder S; S.init(MTOK, DM, F.G(), (int)blockIdx.x);
            pg8::EpiOut E{F.XB(), F.SSQ(), (LAS float*)(F.lds + LDSCTL_OFF + 1024)};
            pg8::gemm_phase<pg8::EpiOut, pg8::StaticOrder, true, true>(F.lds, g, S, E);
            SEAM(pb + 4);
        }
    }
    if (IN(NPHASE - 1)) { F = mk_frame((LAS unsigned char*)lds, &args); p_final(F); }
#undef IN
#undef SEAM
}

#ifndef MK_ONE_LAUNCH
#define MK_ONE_LAUNCH 1
#endif
extern "C" void kernel_launch(void* const* d_in, const int* in_sizes, int n_in, void* d_out, int out_size, void* d_ws, size_t ws_size, hipStream_t stream) {
    static int grid = 0;
    if (grid == 0) {
        if (n_in != 19 || out_size != MTOK * DM || ws_size < WS_END) { fprintf(stderr, "kernel_launch: unexpected shapes (n_in %d, out %d, ws %zu)\n", n_in, out_size, ws_size); grid = -1; return; }
        int dev = 0, cus = 0, per_cu = 0;
        if (hipGetDevice(&dev) != hipSuccess || hipDeviceGetAttribute(&cus, hipDeviceAttributeMultiprocessorCount, dev) != hipSuccess) { grid = -1; return; }
        if (hipFuncSetAttribute((const void*)hymba_fwd, hipFuncAttributeMaxDynamicSharedMemorySize, LDS_BYTES) != hipSuccess) { fprintf(stderr, "kernel_launch: hipFuncSetAttribute failed\n"); grid = -1; return; }
        if (hipOccupancyMaxActiveBlocksPerMultiprocessor(&per_cu, (const void*)hymba_fwd, NTHR, LDS_BYTES) != hipSuccess || per_cu < 1) { fprintf(stderr, "kernel_launch: occupancy query says %d\n", per_cu); }
        (void)hipGetLastError();
        grid = cus;
    }
    if (grid < 0) return;
    (void)hipMemsetAsync((char*)d_ws + WS_CTL, 0, CTL_ZERO_BYTES, stream);
    Args a{};
    for (int i = 0; i < 19; ++i) a.in[i] = (const float*)d_in[i];
    a.out = (float*)d_out; a.ws = (unsigned char*)d_ws;
#if MK_ONE_LAUNCH
    a.ph_lo = 0; a.ph_hi = NPHASE;
    hipLaunchKernelGGL(hymba_fwd, dim3(grid), dim3(NTHR), LDS_BYTES, stream, a);
#else
    for (int p = 0; p < NPHASE; ++p) { a.ph_lo = p; a.ph_hi = p + 1; hipLaunchKernelGGL(hymba_fwd, dim3(grid), dim3(NTHR), LDS_BYTES, stream, a); }
#endif
}
```
